# Optimizing an MI355X kernel written in HIP

```python
import jax, jax.numpy as jnp
from jax import lax
import numpy as np

D_MODEL = 1024
BATCH = 4
SEQ = 4096
DEPTH = 2

GRID_W = 64
CTX_LEN = 256

N_Q_HEADS = 8
N_KV_HEADS = 2
HEAD_DIM = 64
Q_GROUP = N_Q_HEADS // N_KV_HEADS
ATTN_W = N_Q_HEADS * HEAD_DIM
KV_W = N_KV_HEADS * HEAD_DIM
ROPE_THETA = 10000.0
Q_BLOCK = 128
LRU_W = D_MODEL // 4
LRU_BLOCKS = 4
LRU_BW = LRU_W // LRU_BLOCKS
CONV_W = 4
LRU_C = 8.0
POOL_W = D_MODEL // 4
POOL_GROUPS = 4
POOL_GW = POOL_W // POOL_GROUPS
POOL_WINDOWS = (2, 4, 8, 16)
MIX_W = ATTN_W + LRU_W + POOL_W
IN_W = ATTN_W + 2 * KV_W + 2 * LRU_W + POOL_W
SPLITS = (ATTN_W, ATTN_W + KV_W, ATTN_W + 2 * KV_W, ATTN_W + 2 * KV_W + LRU_W,
          ATTN_W + 2 * KV_W + 2 * LRU_W)
FFN_HIDDEN = -(-8 * D_MODEL // 768) * 256
RMS_EPS = 1e-6

kernel_name = "hybrid_headgroup_diffusion_block"


def rmsnorm(x, g):
    xf = x.astype(jnp.float32)
    y = xf * lax.rsqrt(jnp.mean(xf * xf, axis=-1, keepdims=True) + RMS_EPS)
    return (y * g.astype(jnp.float32)).astype(x.dtype)


def modulate(h, shift, scale):
    return h * (1 + scale) + shift


def rope_1d(x, pos):
    half = x.shape[-1] // 2
    freq = ROPE_THETA ** (-jnp.arange(half, dtype=jnp.float32) / half)
    ang = pos.astype(jnp.float32)[:, None] * freq
    cos = jnp.cos(ang)[:, None, :]
    sin = jnp.sin(ang)[:, None, :]
    xf = x.astype(jnp.float32)
    x1, x2 = xf[..., :half], xf[..., half:]
    return jnp.concatenate([x1 * cos - x2 * sin, x2 * cos + x1 * sin], axis=-1).astype(x.dtype)


def axial_rope(x):
    L = x.shape[1]
    rows = L // GRID_W
    row = jnp.repeat(jnp.arange(rows), GRID_W)
    col = jnp.tile(jnp.arange(GRID_W), rows)
    h = HEAD_DIM // 2
    return jnp.concatenate([rope_1d(x[..., :h], row), rope_1d(x[..., h:], col)], axis=-1)


def attend(q, k, v):
    s = jnp.einsum('bqkgd,bskd->bkgqs', q, k).astype(jnp.float32) * (HEAD_DIM ** -0.5)
    p = jax.nn.softmax(s, axis=-1).astype(v.dtype)
    return jnp.einsum('bkgqs,bskd->bqkgd', p, v)


def centred_dwconv(x, w, b):
    L = x.shape[1]
    left = CONV_W // 2
    right = CONV_W - 1 - left
    xp = jnp.pad(x, ((0, 0), (left, right), (0, 0)))
    return b + sum(xp[:, k:k + L] * w[k] for k in range(CONV_W))


def rglru(x, w, b, lam, h0):
    B_, L, W = x.shape
    xb = x.reshape(B_, L, LRU_BLOCKS, LRU_BW)
    g = jnp.einsum('blnc,gncd->gblnd', xb, w).reshape(2, B_, L, W) + b[:, None, None, :]
    g = jax.nn.sigmoid(g.astype(jnp.float32))
    r, i = g[0], g[1]
    log_a = -LRU_C * r * jax.nn.softplus(-lam.astype(jnp.float32))
    a = jnp.exp(log_a)
    u = jnp.sqrt(-jnp.expm1(2.0 * log_a)) * (i * x.astype(jnp.float32))
    u = u.at[:, 0].add(a[:, 0] * h0)

    def comb(e1, e2):
        return (e1[0] * e2[0], e2[0] * e1[1] + e2[1])

    _, h = lax.associative_scan(comb, (a, u), axis=1)
    return h


def bi_rglru(x, w, b, lam, h0_f, h0_b):
    hf = rglru(x, w[0], b[0], lam[0], h0_f)
    hb = jnp.flip(rglru(jnp.flip(x, axis=1), w[1], b[1], lam[1], h0_b), axis=1)
    return hf, hb


def pool_mix(px, w, b, scale):
    B_, L, C = px.shape
    t = jnp.arange(L)
    cs = jnp.pad(jnp.cumsum(px.astype(jnp.float32), axis=1), ((0, 0), (1, 0), (0, 0)))
    outs = []
    for gi, win in enumerate(POOL_WINDOWS):
        lo = jnp.clip(t - win // 2, 0, L)
        hi = jnp.clip(t + win // 2, 0, L)
        csg = cs[..., gi * POOL_GW:(gi + 1) * POOL_GW]
        mean = (csg[:, hi] - csg[:, lo]) / (hi - lo).astype(jnp.float32)[:, None]
        outs.append(mean.astype(px.dtype) - px[..., gi * POOL_GW:(gi + 1) * POOL_GW])
    d = jnp.stack(outs, axis=2)
    y = jnp.einsum('blgc,gcd->blgd', d, w).reshape(B_, L, C) + b
    return y * scale


def swiglu(h, w_in, w_out):
    g, u = jnp.split(h @ w_in, 2, axis=-1)
    return (jax.nn.silu(g) * u) @ w_out


def setup_inputs(seed: int = 0) -> dict:
    key = jax.random.key(seed)
    ks = jax.random.split(key, 22)
    nrm = jax.random.normal
    D = D_MODEL
    a0 = jax.random.uniform(ks[14], (DEPTH, 2, LRU_W), minval=0.9, maxval=0.999)
    s0 = a0 ** (1.0 / LRU_C)
    return {
        "x": nrm(ks[0], (BATCH, SEQ, D)),
        "c": nrm(ks[1], (BATCH, D)),
        "ctx": nrm(ks[2], (BATCH, CTX_LEN, D)),
        "c_ctx": nrm(ks[3], (D,)),
        "w_mod": nrm(ks[4], (DEPTH, D, 6 * D)) * (0.5 * D ** -0.5),
        "b_mod": 0.01 * nrm(ks[5], (DEPTH, 6 * D)),
        "norm_g": 1.0 + 0.1 * nrm(ks[6], (DEPTH, 4, D)),
        "w_in": nrm(ks[7], (DEPTH, D, IN_W)) * D ** -0.5,
        "q_norm_g": 1.0 + 0.1 * nrm(ks[8], (DEPTH, HEAD_DIM)),
        "k_norm_g": 1.0 + 0.1 * nrm(ks[9], (DEPTH, HEAD_DIM)),
        "lru_conv_w": nrm(ks[10], (DEPTH, CONV_W, LRU_W)) * CONV_W ** -0.5,
        "lru_conv_b": 0.01 * nrm(ks[11], (DEPTH, LRU_W)),
        "lru_gate_w": nrm(ks[12], (DEPTH, 2, 2, LRU_BLOCKS, LRU_BW, LRU_BW)) * LRU_BW ** -0.5,
        "lru_gate_b": 0.01 * nrm(ks[13], (DEPTH, 2, 2, LRU_W)),
        "lru_lambda": jnp.log(s0) - jnp.log1p(-s0),
        "pool_w": nrm(ks[15], (DEPTH, POOL_GROUPS, POOL_GW, POOL_GW)) * POOL_GW ** -0.5,
        "pool_b": 0.01 * nrm(ks[16], (DEPTH, POOL_W)),
        "pool_scale": 1.0 + 0.1 * nrm(ks[17], (DEPTH, POOL_W)),
        "w_out": nrm(ks[18], (DEPTH, MIX_W, D)) * MIX_W ** -0.5,
        "w_ffn_in": nrm(ks[19], (DEPTH, D, 2 * FFN_HIDDEN)) * D ** -0.5,
        "w_ffn_out": nrm(ks[20], (DEPTH, FFN_HIDDEN, D)) * FFN_HIDDEN ** -0.5,
    }


def reference(x, c, ctx, c_ctx, w_mod, b_mod, norm_g, w_in, q_norm_g, k_norm_g,
              lru_conv_w, lru_conv_b, lru_gate_w, lru_gate_b, lru_lambda,
              pool_w, pool_b, pool_scale, w_out, w_ffn_in, w_ffn_out):
    B, L, _ = x.shape
    Lc = ctx.shape[1]
    nb = L // Q_BLOCK
    for l in range(DEPTH):
        last = l == DEPTH - 1
        mod_x = jnp.split((jax.nn.silu(c) @ w_mod[l] + b_mod[l])[:, None, :], 6, axis=-1)
        mod_c = jnp.split(jax.nn.silu(c_ctx) @ w_mod[l] + b_mod[l], 6, axis=-1)

        hc = modulate(rmsnorm(ctx, norm_g[l, 0]), mod_c[0], mod_c[1])
        if last:
            kc, vc, lxc = jnp.split(hc @ w_in[l][:, ATTN_W:ATTN_W + 2 * KV_W + LRU_W],
                                    [KV_W, 2 * KV_W], axis=-1)
        else:
            qc, kc, vc, lxc, lgc, pxc = jnp.split(hc @ w_in[l], SPLITS, axis=-1)
        kc_h = rmsnorm(kc.reshape(B, Lc, N_KV_HEADS, HEAD_DIM), k_norm_g[l])
        vc_h = vc.reshape(B, Lc, N_KV_HEADS, HEAD_DIM)
        uc = centred_dwconv(lxc, lru_conv_w[l], lru_conv_b[l])
        zeros = jnp.zeros((B, LRU_W), jnp.float32)
        hcf, hcb = bi_rglru(uc, lru_gate_w[l], lru_gate_b[l], lru_lambda[l], zeros, zeros)
        if not last:
            qc_h = rmsnorm(qc.reshape(B, Lc, N_KV_HEADS, Q_GROUP, HEAD_DIM), q_norm_g[l])
            att_c = attend(qc_h, kc_h, vc_h).reshape(B, Lc, ATTN_W)
            rec_c = jax.nn.gelu(lgc) * (hcf + hcb).astype(ctx.dtype)
            pl_c = pool_mix(pxc, pool_w[l], pool_b[l], pool_scale[l])
            yc = jnp.concatenate([att_c, rec_c, pl_c], axis=-1) @ w_out[l]
            ctx_mid = ctx + mod_c[2] * rmsnorm(yc, norm_g[l, 1])
            fc = swiglu(modulate(rmsnorm(ctx_mid, norm_g[l, 2]), mod_c[3], mod_c[4]),
                        w_ffn_in[l], w_ffn_out[l])
            ctx_next = ctx_mid + mod_c[5] * rmsnorm(fc, norm_g[l, 3])

        hx = modulate(rmsnorm(x, norm_g[l, 0]), mod_x[0], mod_x[1])
        qx, kx, vx, lxx, lgx, pxx = jnp.split(hx @ w_in[l], SPLITS, axis=-1)
        qx_h = axial_rope(rmsnorm(qx.reshape(B, L, N_Q_HEADS, HEAD_DIM), q_norm_g[l]))
        kx_h = axial_rope(rmsnorm(kx.reshape(B, L, N_KV_HEADS, HEAD_DIM), k_norm_g[l]))
        k_all = jnp.concatenate([kc_h, kx_h], axis=1)
        v_all = jnp.concatenate([vc_h, vx.reshape(B, L, N_KV_HEADS, HEAD_DIM)], axis=1)
        qb = qx_h.reshape(B, nb, Q_BLOCK, N_KV_HEADS, Q_GROUP, HEAD_DIM).transpose(1, 0, 2, 3, 4, 5)
        ob = lax.map(lambda blk: attend(blk, k_all, v_all), qb)
        att_x = ob.transpose(1, 0, 2, 3, 4, 5).reshape(B, L, ATTN_W)
        ux = centred_dwconv(lxx, lru_conv_w[l], lru_conv_b[l])
        hxf, hxb = bi_rglru(ux, lru_gate_w[l], lru_gate_b[l], lru_lambda[l], hcf[:, -1], hcb[:, 0])
        rec_x = jax.nn.gelu(lgx) * (hxf + hxb).astype(x.dtype)
        pl_x = pool_mix(pxx, pool_w[l], pool_b[l], pool_scale[l])
        yx = jnp.concatenate([att_x, rec_x, pl_x], axis=-1) @ w_out[l]
        x = x + mod_x[2] * rmsnorm(yx, norm_g[l, 1])
        fx = swiglu(modulate(rmsnorm(x, norm_g[l, 2]), mod_x[3], mod_x[4]), w_ffn_in[l], w_ffn_out[l])
        x = x + mod_x[5] * rmsnorm(fx, norm_g[l, 3])

        if not last:
            ctx = ctx_next
    return x
```

```cpp
#include <hip/hip_runtime.h>
#include <hip/hip_cooperative_groups.h>
#include <hip/hip_bf16.h>
#include <cstdio>
#include <cstdint>
#include <cmath>
namespace cg = cooperative_groups;
__device__ __forceinline__ float shx(float v, int mask, int lane_) { return __int_as_float(__builtin_amdgcn_ds_bpermute((lane_ ^ mask) << 2, __float_as_int(v))); }
__device__ __forceinline__ int hw_lane() { int l; asm volatile("v_mbcnt_lo_u32_b32 %0, -1, 0\n\tv_mbcnt_hi_u32_b32 %0, -1, %0" : "=v"(l)); return l; }
namespace pg8 {
#define PG8_LAS __attribute__((address_space(3)))
typedef unsigned short bf16_t;
typedef short bf16x8 __attribute__((ext_vector_type(8)));
typedef float f32x4 __attribute__((ext_vector_type(4)));
typedef unsigned u32x4 __attribute__((ext_vector_type(4)));
typedef unsigned u32x2 __attribute__((ext_vector_type(2)));
constexpr int BM = 256, BK = 64, HALF = 128, HTB = HALF * BK * 2  , STAGE_BYTES = 8 * HTB, NXCD = 8, WGM = 8;

__host__ __device__ __forceinline__ int lds_byte(int r, int c) { const int st = (r >> 4) * 2 + (c >> 5), rr = r & 15, cc = c & 31, ob = rr * 64 + cc * 2; return st * 1024 + (ob ^ (((ob >> 9) & 1) << 5)); }
__host__ __device__ __forceinline__ void stage_rc(int b, int& R, int& C) { const int st = b / 1024, sb = b % 1024, swz = sb ^ (((sb >> 9) & 1) << 5); R = (st >> 1) * 16 + swz / 64; C = (st & 1) * 32 + (swz % 64) / 2; }
__host__ __device__ __forceinline__ int perm32(int rho) { const int n = rho >> 4, i = rho & 15; return 8 * (i >> 2) + 4 * n + (i & 3); }

struct Unit { int pm, pn, kb, ks; };
struct Gemm { const bf16_t* A; const bf16_t* Bt; int M, N, K, ld; };

struct StaticOrder {
    int nM, nN, nwg, G, c;
    __host__ __device__ void init(int M, int N, int G_, int c_) { nM = M / BM; nN = N / BM; nwg = nM * nN; G = G_; c = c_; }
    __host__ __device__ bool next(int i, Unit& u) const {
        const long L = (long)i * G + c; if (L >= nwg) return false;
        int wgid = (int)L; { const int q = nwg / NXCD, r = nwg % NXCD, xcd = wgid % NXCD, off = wgid / NXCD; wgid = (xcd < r ? xcd * (q + 1) : r * (q + 1) + (xcd - r) * q) + off; }
        const int nig = WGM * nN, gid = wgid / nig, fm = gid * WGM, gsz = (nM - fm) < WGM ? (nM - fm) : WGM;
        u.pm = fm + ((wgid % nig) % gsz); u.pn = (wgid % nig) / gsz; u.kb = 0; u.ks = 0; return true;
    }
    __device__ __forceinline__ void a_ready(const Unit&) const {}
    __device__ __forceinline__ void done(const Unit&) const {}
};

__device__ __forceinline__ unsigned cvt_pk_bf16(float lo, float hi) { unsigned r; asm volatile("v_cvt_pk_bf16_f32 %0, %1, %2" : "=v"(r) : "v"(lo), "v"(hi)); return r; }
typedef float f32x2 __attribute__((ext_vector_type(2)));
struct EpiBf16 {
    static constexpr bool PERM = true, AFTER_DRAIN = false;
    bf16_t* O; int ldc;
    __device__ __forceinline__ void operator()(const f32x4 (&acc)[2][2][4][2], const Unit& u, int wr, int wc, int fr, int fq) const {
        const int row0 = u.pm * BM + wr * 64 + fr; const int col0 = u.pn * BM + wc * 32 + 8 * fq;
#pragma unroll
        for (int ai = 0; ai < 2; ++ai)
#pragma unroll
            for (int m = 0; m < 4; ++m) { bf16_t* rowp = O + (size_t)(row0 + ai * HALF + m * 16) * ldc + col0;
#pragma unroll
                for (int bj = 0; bj < 2; ++bj) { const f32x4 v0 = acc[ai][bj][m][0], v1 = acc[ai][bj][m][1];
                    u32x4 w; w.x = cvt_pk_bf16(v0[0], v0[1]); w.y = cvt_pk_bf16(v0[2], v0[3]); w.z = cvt_pk_bf16(v1[0], v1[1]); w.w = cvt_pk_bf16(v1[2], v1[3]);
                    *(u32x4*)(rowp + bj * HALF) = w; } }
    }
};
__device__ __forceinline__ float silu_f(float g) { return g * __builtin_amdgcn_rcpf(1.0f + __expf(-g)); }
struct EpiSwiglu {
    static constexpr bool PERM = true, AFTER_DRAIN = false;
    bf16_t* H; int ldh;
    __device__ __forceinline__ void operator()(const f32x4 (&acc)[2][2][4][2], const Unit& u, int wr, int wc, int fr, int fq) const {
        const int row0 = u.pm * BM + wr * 64 + fr; const int col0 = u.pn * HALF + wc * 32 + 8 * fq;
#pragma unroll
        for (int ai = 0; ai < 2; ++ai)
#pragma unroll
            for (int m = 0; m < 4; ++m) { bf16_t* rowp = H + (size_t)(row0 + ai * HALF + m * 16) * ldh + col0;
                const f32x4 g0 = acc[ai][0][m][0], g1 = acc[ai][0][m][1], u0 = acc[ai][1][m][0], u1 = acc[ai][1][m][1];
                u32x4 w;
                w.x = cvt_pk_bf16(silu_f(g0[0]) * u0[0], silu_f(g0[1]) * u0[1]); w.y = cvt_pk_bf16(silu_f(g0[2]) * u0[2], silu_f(g0[3]) * u0[3]);
                w.z = cvt_pk_bf16(silu_f(g1[0]) * u1[0], silu_f(g1[1]) * u1[1]); w.w = cvt_pk_bf16(silu_f(g1[2]) * u1[2], silu_f(g1[3]) * u1[3]);
                *(u32x4*)rowp = w; }
    }
};
struct EpiF32 {
    static constexpr bool PERM = false, AFTER_DRAIN = false;
    float* O; int ldc;
    __device__ __forceinline__ void operator()(const f32x4 (&acc)[2][2][4][2], const Unit& u, int wr, int wc, int fr, int fq) const {
        const int row0 = u.pm * BM + wr * 64 + fr; const int col0 = u.pn * BM + wc * 32 + 4 * fq;
#pragma unroll
        for (int ai = 0; ai < 2; ++ai)
#pragma unroll
            for (int m = 0; m < 4; ++m) { float* rowp = O + (size_t)(row0 + ai * HALF + m * 16) * ldc + col0;
#pragma unroll
                for (int bj = 0; bj < 2; ++bj)
#pragma unroll
                    for (int n = 0; n < 2; ++n) *(f32x4*)(rowp + bj * HALF + n * 16) = acc[ai][bj][m][n]; }
    }
};
struct SplitKOrder {
    int nM, nN, KS, kbytes, G, c;
    __device__ void init(int M, int N, int KS_, int kslice, int G_, int c_) { nM = M / BM; nN = N / BM; KS = KS_; kbytes = kslice * 2; G = G_; c = c_; }
    __device__ bool next(int i, Unit& u) const { const int L = i * G + c; if (L >= nM * nN * KS) return false; const int ks = L % KS, t = L / KS; u.pm = t % nM; u.pn = t / nM; u.ks = ks; u.kb = ks * kbytes; return true; }
    __device__ __forceinline__ void a_ready(const Unit&) const {}
    __device__ __forceinline__ void done(const Unit&) const {}
};
struct EpiF32Slab {
    static constexpr bool PERM = false, AFTER_DRAIN = false;
    float* O; int ldc; size_t slab;
    __device__ __forceinline__ void operator()(const f32x4 (&acc)[2][2][4][2], const Unit& u, int wr, int wc, int fr, int fq) const {
        const int row0 = u.pm * BM + wr * 64 + fr; const int col0 = u.pn * BM + wc * 32 + 4 * fq; float* Os = O + (size_t)u.ks * slab;
#pragma unroll
        for (int ai = 0; ai < 2; ++ai)
#pragma unroll
            for (int m = 0; m < 4; ++m) { float* rowp = Os + (size_t)(row0 + ai * HALF + m * 16) * ldc + col0;
#pragma unroll
                for (int bj = 0; bj < 2; ++bj)
#pragma unroll
                    for (int n = 0; n < 2; ++n) *(f32x4*)(rowp + bj * HALF + n * 16) = acc[ai][bj][m][n]; }
    }
};
struct PanelSumSq {
    float* xbuf;
    unsigned* cnt;
    unsigned* tmo;
    __device__ __forceinline__ void run(const f32x4 (&v)[2][2][4][2], int pmg, int pn, int wr, int wc, int fr, int fq, PG8_LAS unsigned char* lds, int wid, int lane) const { publish(v, pmg, pn, wr, wc, fr, fq, lds, wid, lane); finish(pmg, lds, wid, lane); }
    __device__ __forceinline__ void publish(const f32x4 (&v)[2][2][4][2], int pmg, int pn, int wr, int wc, int fr, int fq, PG8_LAS unsigned char* lds, int wid, int lane) const {
        PG8_LAS float* P = (PG8_LAS float*)lds;
        PG8_LAS float* S = (PG8_LAS float*)(lds + 8192);
#pragma unroll
        for (int ai = 0; ai < 2; ++ai)
#pragma unroll
            for (int m = 0; m < 4; ++m) {
                float q = 0.f;
#pragma unroll
                for (int bj = 0; bj < 2; ++bj)
#pragma unroll
                    for (int n = 0; n < 2; ++n) { const f32x4 x = v[ai][bj][m][n]; q += (x[0] * x[0] + x[1] * x[1]) + (x[2] * x[2] + x[3] * x[3]); }
                q += shx(q, 16, lane); q += shx(q, 32, lane);
                if (fq == 0) P[(ai * HALF + wr * 64 + m * 16 + fr) * 4 + wc] = q;
            }
        asm volatile("s_waitcnt lgkmcnt(0)" ::: "memory"); __builtin_amdgcn_s_barrier(); asm volatile("" ::: "memory");
        const int row = wid * 32 + (lane & 31);
        if (lane < 32) {
            const float t = (P[row * 4 + 0] + P[row * 4 + 1]) + (P[row * 4 + 2] + P[row * 4 + 3]);
            __hip_atomic_store((unsigned*)xbuf + ((size_t)(pmg * BM + row) * 4 + pn), __float_as_uint(t), __ATOMIC_RELAXED, __HIP_MEMORY_SCOPE_AGENT);
        }
        asm volatile("s_waitcnt vmcnt(0)" ::: "memory");
        if (lane == 0) __hip_atomic_fetch_add(cnt + 64 * pmg, 1u, __ATOMIC_RELAXED, __HIP_MEMORY_SCOPE_AGENT);
    }
    __device__ __forceinline__ void finish(int pmg, PG8_LAS unsigned char* lds, int wid, int lane) const {
        PG8_LAS float* S = (PG8_LAS float*)(lds + 8192);
        const int row = wid * 32 + (lane & 31);
        {   unsigned sp = 0u;
            while ((unsigned)__builtin_amdgcn_readfirstlane(__hip_atomic_load(cnt + 64 * pmg, __ATOMIC_RELAXED, __HIP_MEMORY_SCOPE_AGENT)) < 32u) {
                __builtin_amdgcn_s_sleep(1);
                if (++sp > (1u << 18)) { if (lane == 0) __hip_atomic_store(tmo, 1u, __ATOMIC_RELAXED, __HIP_MEMORY_SCOPE_AGENT); break; }
            }
        }
        if (lane < 32) {
            const unsigned* slot = (const unsigned*)xbuf + (size_t)(pmg * BM + row) * 4; float tot = 0.f;
#pragma unroll
            for (int t = 0; t < 4; ++t) tot += __uint_as_float(__hip_atomic_load(slot + t, __ATOMIC_RELAXED, __HIP_MEMORY_SCOPE_AGENT));
            S[row] = rsqrtf(tot * (1.0f / 1024.0f) + 1e-6f);
        }
        asm volatile("s_waitcnt vmcnt(0) lgkmcnt(0)" ::: "memory"); __builtin_amdgcn_s_barrier(); asm volatile("" ::: "memory");
    }
};
template <bool NEXT, bool BASE16, bool OUT16> struct EpiRmsRes {
    static constexpr bool PERM = false, AFTER_DRAIN = true;
    const void* base_p; void* out_p; bf16_t* xn;
    const float* vG; const float* vA; const float* vS;
    PanelSumSq st1, st2;
    static __device__ __forceinline__ f32x4 up4(u32x2 w) { return (f32x4){__uint_as_float(w.x << 16), __uint_as_float(w.x & 0xffff0000u), __uint_as_float(w.y << 16), __uint_as_float(w.y & 0xffff0000u)}; }
    __device__ __forceinline__ void store_out(void* rowp, int coff, const f32x4 x) const {
        if (OUT16) { u32x2 w; w.x = cvt_pk_bf16(x[0], x[1]); w.y = cvt_pk_bf16(x[2], x[3]); *(u32x2*)((bf16_t*)rowp + coff) = w; }
        else *(f32x4*)((float*)rowp + coff) = x; }
    __device__ __forceinline__ void fused(f32x4 (&acc)[2][2][4][2], const Unit& u, int wr, int wc, int fr, int fq, PG8_LAS unsigned char* lds, int wid, int lane) const {
        const PG8_LAS float* S = (const PG8_LAS float*)(lds + 8192);
        const int pmg = u.pm, slot = pmg >> 4;
        const size_t poff = (size_t)pmg * BM * 1024;
        const int col0 = u.pn * BM + wc * 32 + 4 * fq;
        const size_t lane_off = (size_t)(wr * 64 + fr) * 1024 + col0;
        st1.publish(acc, pmg, u.pn, wr, wc, fr, fq, lds, wid, lane);
        f32x4 pre[4][2][2]; u32x2 pb[2][4][2][2];
        if (BASE16) {
            const bf16_t* b16 = (const bf16_t*)base_p + poff + lane_off;
#pragma unroll
            for (int ai = 0; ai < 2; ++ai)
#pragma unroll
                for (int m = 0; m < 4; ++m)
#pragma unroll
                    for (int bj = 0; bj < 2; ++bj)
#pragma unroll
                        for (int n = 0; n < 2; ++n) pb[ai][m][bj][n] = *(const u32x2*)(b16 + (size_t)(ai * HALF + m * 16) * 1024 + bj * HALF + n * 16);
        } else {
            const float* b32 = (const float*)base_p + poff + lane_off;
#pragma unroll
            for (int m = 0; m < 4; ++m)
#pragma unroll
                for (int bj = 0; bj < 2; ++bj)
#pragma unroll
                    for (int n = 0; n < 2; ++n) pre[m][bj][n] = __builtin_nontemporal_load((const f32x4*)(b32 + (size_t)(m * 16) * 1024 + bj * HALF + n * 16));
        }
        f32x4 g[2][2];
#pragma unroll
        for (int bj = 0; bj < 2; ++bj)
#pragma unroll
            for (int n = 0; n < 2; ++n) g[bj][n] = *(const f32x4*)(vG + slot * 6144 + col0 + bj * HALF + n * 16);
        st1.finish(pmg, lds, wid, lane);
#pragma unroll
        for (int ai = 0; ai < 2; ++ai)
#pragma unroll
            for (int m = 0; m < 4; ++m) { const float rs = S[ai * HALF + wr * 64 + m * 16 + fr];
#pragma unroll
                for (int bj = 0; bj < 2; ++bj)
#pragma unroll
                    for (int n = 0; n < 2; ++n) { f32x4 bs;
                        if (BASE16) bs = up4(pb[ai][m][bj][n]);
                        else bs = ai == 0 ? pre[m][bj][n] : __builtin_nontemporal_load((const f32x4*)((const float*)base_p + poff + lane_off + (size_t)(HALF + m * 16) * 1024 + bj * HALF + n * 16));
                        acc[ai][bj][m][n] = bs + g[bj][n] * acc[ai][bj][m][n] * rs; }
                asm volatile("" : "+v"(acc[ai][0][m][0]), "+v"(acc[ai][0][m][1]), "+v"(acc[ai][1][m][0]), "+v"(acc[ai][1][m][1]));
                if (m & 1) asm volatile("" ::: "memory"); }
        unsigned char* const outl = (unsigned char*)out_p + (poff + lane_off) * (OUT16 ? 2 : 4);
        if (NEXT) {
            f32x4 a[2][2], sh[2][2];
#pragma unroll
            for (int bj = 0; bj < 2; ++bj)
#pragma unroll
                for (int n = 0; n < 2; ++n) { a[bj][n] = *(const f32x4*)(vA + slot * 6144 + col0 + bj * HALF + n * 16); sh[bj][n] = *(const f32x4*)(vS + slot * 6144 + col0 + bj * HALF + n * 16); }
            st2.publish(acc, pmg, u.pn, wr, wc, fr, fq, lds, wid, lane);
#pragma unroll
            for (int ai = 0; ai < 2; ++ai)
#pragma unroll
                for (int m = 0; m < 4; ++m) { void* op = outl + (size_t)(ai * HALF + m * 16) * 1024 * (OUT16 ? 2 : 4);
#pragma unroll
                    for (int bj = 0; bj < 2; ++bj)
#pragma unroll
                        for (int n = 0; n < 2; ++n) store_out(op, bj * HALF + n * 16, acc[ai][bj][m][n]);
                    asm volatile("" ::: "memory"); }
            st2.finish(pmg, lds, wid, lane);
            bf16_t* xnl = xn + poff + lane_off;
#pragma unroll
            for (int ai = 0; ai < 2; ++ai)
#pragma unroll
                for (int m = 0; m < 4; ++m) { const float rs = S[ai * HALF + wr * 64 + m * 16 + fr]; bf16_t* xp = xnl + (size_t)(ai * HALF + m * 16) * 1024;
#pragma unroll
                    for (int bj = 0; bj < 2; ++bj)
#pragma unroll
                        for (int n = 0; n < 2; ++n) { const f32x4 x1 = acc[ai][bj][m][n]; const f32x4 o = x1 * rs * a[bj][n] + sh[bj][n];
                            u32x2 w; w.x = cvt_pk_bf16(o[0], o[1]); w.y = cvt_pk_bf16(o[2], o[3]); *(u32x2*)(xp + bj * HALF + n * 16) = w; }
                    asm volatile("" ::: "memory"); }
        } else {
#pragma unroll
            for (int ai = 0; ai < 2; ++ai)
#pragma unroll
                for (int m = 0; m < 4; ++m) { void* op = outl + (size_t)(ai * HALF + m * 16) * 1024 * (OUT16 ? 2 : 4);
#pragma unroll
                    for (int bj = 0; bj < 2; ++bj)
#pragma unroll
                        for (int n = 0; n < 2; ++n) store_out(op, bj * HALF + n * 16, acc[ai][bj][m][n]);
                    asm volatile("" ::: "memory"); }
        }
    }
};
template <class Epi, class Sched, bool ALIGN_EPI = false, bool SP2 = false>
__device__ __forceinline__ void gemm_phase(PG8_LAS unsigned char* lds, const Gemm g, const Sched& S, const Epi& E, int tid_) {
    asm volatile("" : "+v"(tid_));
    const int tid = tid_, wid = __builtin_amdgcn_readfirstlane(tid >> 6), lane = tid & 63, wr = wid >> 2, wc = wid & 3, fr = lane & 15, fq = lane >> 4;
    const int K = g.ld, nt = g.K / BK;
    unsigned voffA[2], voffB[2];
#pragma unroll
    for (int i = 0; i < 2; ++i) { int R, C; stage_rc(tid * 16 + i * 8192, R, C); const int Rb = Epi::PERM ? ((R & ~31) + perm32(R & 31)) : R;
        voffA[i] = (unsigned)(R * K + C) * 2u; voffB[i] = (unsigned)(Rb * K + C) * 2u; }
    const size_t kstep = (size_t)(BK * 2);
    const size_t hstep = (size_t)HALF * K * 2;
    const size_t tstep = 2 * hstep;
    const unsigned ldsw = (unsigned)wid * 1024u;
    const int aoff = lds_byte(wr * 64 + fr, fq * 8), boff = lds_byte(wc * 32 + fr, fq * 8);
#define PG8_SA(b, h) (((b) * 2 + (h)) * HTB)
#define PG8_SB(b, h) ((4 + (b) * 2 + (h)) * HTB)
#define PG8_STAGE(bufoff, gbase, voff) do { _Pragma("unroll") for (int _i = 0; _i < 2; ++_i) \
        __builtin_amdgcn_global_load_lds((const unsigned*)((const char*)(gbase) + (voff)[_i]), (PG8_LAS unsigned*)(lds + (bufoff) + ldsw + _i * 8192), 16, 0, 0); } while (0)
#define PG8_LDA(dst, b, h) do { _Pragma("unroll") for (int m = 0; m < 4; ++m) _Pragma("unroll") for (int k = 0; k < 2; ++k) dst[m][k] = *(const PG8_LAS bf16x8*)(lds + PG8_SA(b, h) + aoff + m * 2048 + k * 1024); } while (0)
#define PG8_LDB(dst, b, h) do { _Pragma("unroll") for (int n = 0; n < 2; ++n) _Pragma("unroll") for (int k = 0; k < 2; ++k) dst[n][k] = *(const PG8_LAS bf16x8*)(lds + PG8_SB(b, h) + boff + n * 2048 + k * 1024); } while (0)
#define PG8_MMA(ai, bj, At, Bt) do { __builtin_amdgcn_s_setprio(1); _Pragma("unroll") for (int m = 0; m < 4; ++m) _Pragma("unroll") for (int n = 0; n < 2; ++n) _Pragma("unroll") for (int k = 0; k < 2; ++k) \
        acc[ai][bj][m][n] = __builtin_amdgcn_mfma_f32_16x16x32_bf16(Bt[n][k], At[m][k], acc[ai][bj][m][n], 0, 0, 0); __builtin_amdgcn_s_setprio(0); } while (0)
#define PG8_WAIT_V(n) asm volatile("s_waitcnt vmcnt(" #n ")" ::: "memory")
#define PG8_WAIT_L(n) asm volatile("s_waitcnt lgkmcnt(" #n ")" ::: "memory")
#define PG8_BAR __builtin_amdgcn_s_barrier()
#define PG8_SCHED __builtin_amdgcn_sched_barrier(0)
    Unit cur, nxt; int ui = 0;
    if (!S.next(0, cur)) return;
    f32x4 acc[2][2][4][2];
#pragma unroll
    for (int a = 0; a < 2; ++a)
#pragma unroll
        for (int b = 0; b < 2; ++b)
#pragma unroll
            for (int m = 0; m < 4; ++m)
#pragma unroll
                for (int n = 0; n < 2; ++n) acc[a][b][m][n] = (f32x4){0.f, 0.f, 0.f, 0.f};
    bf16x8 At[4][2], B0[2][2], B1[2][2];
    const char* cA = (const char*)g.A + (size_t)cur.pm * tstep + cur.kb; const char* cB = (const char*)g.Bt + (size_t)cur.pn * tstep + cur.kb;
    S.a_ready(cur);
    if constexpr (SP2) {
        PG8_STAGE(PG8_SB(0, 0), cB, voffB); PG8_STAGE(PG8_SB(0, 1), cB + hstep, voffB); PG8_STAGE(PG8_SA(0, 0), cA, voffA); PG8_STAGE(PG8_SA(0, 1), cA + hstep, voffA);
        if (wr == 1) PG8_BAR;
        PG8_WAIT_V(2); PG8_BAR;
        PG8_STAGE(PG8_SB(1, 0), cB + kstep, voffB); PG8_STAGE(PG8_SA(1, 0), cA + kstep, voffA); PG8_STAGE(PG8_SB(1, 1), cB + hstep + kstep, voffB);
        PG8_WAIT_V(6); PG8_BAR;
    } else {
        PG8_STAGE(PG8_SB(0, 0), cB, voffB); PG8_STAGE(PG8_SA(0, 0), cA, voffA); PG8_STAGE(PG8_SB(0, 1), cB + hstep, voffB); PG8_STAGE(PG8_SA(0, 1), cA + hstep, voffA);
        if (wr == 1) PG8_BAR;
        PG8_WAIT_V(4); PG8_BAR;
        PG8_STAGE(PG8_SB(1, 0), cB + kstep, voffB); PG8_STAGE(PG8_SA(1, 0), cA + kstep, voffA); PG8_STAGE(PG8_SB(1, 1), cB + hstep + kstep, voffB);
        PG8_WAIT_V(6); PG8_BAR;
    }
    for (;;) {
        const bool has_next = S.next(ui + 1, nxt);
        const char* nA = has_next ? (const char*)g.A + (size_t)nxt.pm * tstep + nxt.kb : cA; const char* nB = has_next ? (const char*)g.Bt + (size_t)nxt.pn * tstep + nxt.kb : cB;
        for (int t = 0; t < nt; t += 2) {
            const bool last = (t == nt - 2);
            const char* a1 = cA + (size_t)(t + 1) * kstep;
            const char* a2 = last ? nA : cA + (size_t)(t + 2) * kstep; const char* b2 = last ? nB : cB + (size_t)(t + 2) * kstep;
            const char* a3 = a2 + kstep; const char* b3 = b2 + kstep;
            if (last && has_next) S.a_ready(nxt);
            if constexpr (SP2) {
            PG8_LDB(B0, 0, 0); PG8_LDB(B1, 0, 1); PG8_SCHED; PG8_LDA(At, 0, 0); PG8_STAGE(PG8_SA(1, 1), a1 + hstep, voffA);
            PG8_WAIT_V(8); PG8_WAIT_L(0); PG8_BAR; PG8_MMA(0, 0, At, B0); PG8_MMA(0, 1, At, B1); PG8_BAR; PG8_SCHED;
            PG8_LDA(At, 0, 1); PG8_STAGE(PG8_SB(0, 0), b2, voffB); PG8_STAGE(PG8_SB(0, 1), b2 + hstep, voffB); PG8_STAGE(PG8_SA(0, 0), a2, voffA);
            PG8_WAIT_V(8); PG8_WAIT_L(0); PG8_BAR; PG8_MMA(1, 0, At, B0); PG8_MMA(1, 1, At, B1); PG8_BAR; PG8_SCHED;
            PG8_LDB(B0, 1, 0); PG8_LDB(B1, 1, 1); PG8_SCHED; PG8_LDA(At, 1, 0); PG8_STAGE(PG8_SA(0, 1), a2 + hstep, voffA);
            PG8_WAIT_V(8); PG8_WAIT_L(0); PG8_BAR; PG8_MMA(0, 0, At, B0); PG8_MMA(0, 1, At, B1); PG8_BAR; PG8_SCHED;
            PG8_LDA(At, 1, 1); PG8_STAGE(PG8_SB(1, 0), b3, voffB); PG8_STAGE(PG8_SB(1, 1), b3 + hstep, voffB); PG8_STAGE(PG8_SA(1, 0), a3, voffA);
            PG8_WAIT_V(8); PG8_WAIT_L(0); PG8_BAR; PG8_MMA(1, 0, At, B0); PG8_MMA(1, 1, At, B1); PG8_BAR; PG8_SCHED;
            } else {
            PG8_LDB(B0, 0, 0); PG8_SCHED; PG8_LDA(At, 0, 0); PG8_STAGE(PG8_SA(1, 1), a1 + hstep, voffA);
            PG8_WAIT_L(8); PG8_BAR; PG8_WAIT_L(0); PG8_MMA(0, 0, At, B0); PG8_BAR; PG8_SCHED;
            PG8_LDB(B1, 0, 1); PG8_STAGE(PG8_SB(0, 0), b2, voffB);
            PG8_BAR; PG8_WAIT_L(0); PG8_MMA(0, 1, At, B1); PG8_BAR;
            PG8_LDA(At, 0, 1); PG8_STAGE(PG8_SA(0, 0), a2, voffA);
            PG8_BAR; PG8_WAIT_L(0); PG8_MMA(1, 0, At, B0); PG8_BAR; PG8_SCHED;
            PG8_STAGE(PG8_SB(0, 1), b2 + hstep, voffB);
            PG8_WAIT_V(6); PG8_BAR; PG8_MMA(1, 1, At, B1); PG8_BAR;
            PG8_LDB(B0, 1, 0); PG8_SCHED; PG8_LDA(At, 1, 0); PG8_STAGE(PG8_SA(0, 1), a2 + hstep, voffA);
            PG8_WAIT_L(8); PG8_BAR; PG8_WAIT_L(0); PG8_MMA(0, 0, At, B0); PG8_BAR; PG8_SCHED;
            PG8_LDB(B1, 1, 1); PG8_STAGE(PG8_SB(1, 0), b3, voffB);
            PG8_BAR; PG8_WAIT_L(0); PG8_MMA(0, 1, At, B1); PG8_BAR;
            PG8_LDA(At, 1, 1); PG8_STAGE(PG8_SA(1, 0), a3, voffA);
            PG8_BAR; PG8_WAIT_L(0); PG8_MMA(1, 0, At, B0); PG8_BAR; PG8_SCHED;
            PG8_STAGE(PG8_SB(1, 1), b3 + hstep, voffB);
            PG8_WAIT_V(6); PG8_BAR; PG8_MMA(1, 1, At, B1); PG8_BAR;
            }
        }
        if constexpr (ALIGN_EPI) { if (wr == 0) PG8_BAR; }
        if constexpr (!Epi::AFTER_DRAIN) { E(acc, cur, wr, wc, fr, fq); S.done(cur); }
        if (!has_next) break;
#pragma unroll
        for (int a = 0; a < 2; ++a)
#pragma unroll
            for (int b = 0; b < 2; ++b)
#pragma unroll
                for (int m = 0; m < 4; ++m)
#pragma unroll
                    for (int n = 0; n < 2; ++n) acc[a][b][m][n] = (f32x4){0.f, 0.f, 0.f, 0.f};
        cur = nxt; cA = nA; cB = nB; ++ui;
        if constexpr (ALIGN_EPI) { if (wr == 1) PG8_BAR; }
    }
    PG8_WAIT_V(0);
    if constexpr (!ALIGN_EPI) { if (wr == 0) PG8_BAR; }
    PG8_BAR;
    if constexpr (Epi::AFTER_DRAIN) { E.fused(acc, cur, wr, wc, fr, fq, lds, wid, lane); S.done(cur); }
#undef PG8_SA
#undef PG8_SB
#undef PG8_STAGE
#undef PG8_LDA
#undef PG8_LDB
#undef PG8_MMA
#undef PG8_WAIT_V
#undef PG8_WAIT_L
#undef PG8_BAR
#undef PG8_SCHED
}
}
#include <hip/hip_bf16.h>
#include <cmath>
namespace attn_body {
using bf16=__hip_bfloat16;
using bf16x8=__attribute__((ext_vector_type(8)))short;
using s16x4=__attribute__((ext_vector_type(4)))short;
using f32x16=__attribute__((ext_vector_type(16)))float;
using u32x4=__attribute__((ext_vector_type(4)))unsigned;
constexpr int D=64,DM=1024,KVP=128,QP=1536;
constexpr int NW=8,QBLK=32,QB=QBLK*NW,KVBLK=64;
constexpr int ATTN_PITCH=DM, ATTN_UNIT_ROWS=QB;
__device__ __forceinline__ int crow(int r,int hi){return (r&3)+8*(r>>2)+4*hi;}
#define SBAR() __builtin_amdgcn_sched_barrier(0)
__device__ __forceinline__ void cmask(f32x16&p0,f32x16&p1,int jb,int qrel,int hi){
  const float NEG=-INFINITY; int kb=64*jb+4*hi;
  #pragma unroll
  for(int r=0;r<16;++r){int kv=kb+(r&3)+8*(r>>2); if(kv>qrel)p0[r]=NEG; if(kv+32>qrel)p1[r]=NEG;}
}

constexpr int NSLOT=3, SLOTB=8192;
constexpr int LDS_K=0, LDS_V=NSLOT*SLOTB, LDS_WS=2*NSLOT*SLOTB, LDS_OST=LDS_WS+NW*64*4, LDS_BYTES=LDS_OST+NW*4096;
constexpr float C2=0.125f*1.4426950408889634f;
__device__ __forceinline__ void glds16(const void*gsrc,unsigned lds_dst){unsigned keep;
  asm volatile("s_mov_b32 %0, m0\n\ts_mov_b32 m0, %2\n\ts_nop 0\n\tglobal_load_lds_dwordx4 %1, off\n\ts_mov_b32 m0, %0":"=&s"(keep):"v"(gsrc),"s"(lds_dst):"memory");}
__device__ __forceinline__ float max3f(float a,float b,float c){float r;asm("v_max3_f32 %0, %1, %2, %3":"=v"(r):"v"(a),"v"(b),"v"(c));return r;}
__device__ __forceinline__ float max2f(float a,float b){float r;asm("v_max_f32_e32 %0, %1, %2":"=v"(r):"v"(a),"v"(b));return r;}
__device__ __forceinline__ float fadd_s(float a,float b){float r;asm("v_add_f32_e32 %0, %1, %2":"=v"(r):"v"(a),"v"(b));return r;}
__device__ __forceinline__ float fsub_s(float a,float b){float r;asm("v_sub_f32_e32 %0, %1, %2":"=v"(r):"v"(a),"v"(b));return r;}
typedef float f32x2_t __attribute__((ext_vector_type(2))); typedef __bf16 bf16x2_t __attribute__((ext_vector_type(2)));
__device__ __forceinline__ unsigned cvtpk_s(float lo,float hi){f32x2_t v={lo,hi};bf16x2_t b=__builtin_convertvector(v,bf16x2_t);return __builtin_bit_cast(unsigned,b);}
#define WAIT_BAR(N) asm volatile("s_waitcnt vmcnt(" #N ") lgkmcnt(0)\n\ts_barrier":::"memory")

__device__ __forceinline__ void qkt(f32x16&p0,f32x16&p1,const char*Kslot,const bf16x8*qr,const f32x16&negm,int r32,int hi){
  const char*kb=Kslot+hi*1024+r32*16;
  #pragma unroll
  for(int d0=0;d0<4;++d0){
    const bf16x8 b0=*reinterpret_cast<const bf16x8*>(kb+d0*2048);
    const bf16x8 b1=*reinterpret_cast<const bf16x8*>(kb+d0*2048+512);
    if(d0==0){p0=__builtin_amdgcn_mfma_f32_32x32x16_bf16(b0,qr[0],negm,0,0,0);p1=__builtin_amdgcn_mfma_f32_32x32x16_bf16(b1,qr[0],negm,0,0,0);}
    else{p0=__builtin_amdgcn_mfma_f32_32x32x16_bf16(b0,qr[d0],p0,0,0,0);p1=__builtin_amdgcn_mfma_f32_32x32x16_bf16(b1,qr[d0],p1,0,0,0);}}
}
typedef __attribute__((address_space(3))) const char* lds_cptr;
typedef short v4i16_t __attribute__((ext_vector_type(4)));
__device__ __forceinline__ void kload8(bf16x8*kf,lds_cptr kp){
  kf[0]=*(const __attribute__((address_space(3))) bf16x8*)(kp);      kf[1]=*(const __attribute__((address_space(3))) bf16x8*)(kp+512);
  kf[2]=*(const __attribute__((address_space(3))) bf16x8*)(kp+2048); kf[3]=*(const __attribute__((address_space(3))) bf16x8*)(kp+2560);
  kf[4]=*(const __attribute__((address_space(3))) bf16x8*)(kp+4096); kf[5]=*(const __attribute__((address_space(3))) bf16x8*)(kp+4608);
  kf[6]=*(const __attribute__((address_space(3))) bf16x8*)(kp+6144); kf[7]=*(const __attribute__((address_space(3))) bf16x8*)(kp+6656);
}
__device__ __forceinline__ void kload2(bf16x8*kf,lds_cptr kp,int j){ kf[2*j]=*(const __attribute__((address_space(3))) bf16x8*)(kp+j*2048); kf[2*j+1]=*(const __attribute__((address_space(3))) bf16x8*)(kp+j*2048+512); }
__device__ __forceinline__ s16x4 vtr(lds_cptr p){ return __builtin_bit_cast(s16x4,__builtin_amdgcn_ds_read_tr16_b64_v4i16((__attribute__((address_space(3))) v4i16_t*)p)); }
__device__ __forceinline__ float rowmax(const f32x16&p0,const f32x16&p1){
  float a=max3f(p0[0],p0[1],p1[0]),b=max3f(p0[2],p0[3],p1[1]);a=max3f(a,p1[2],p1[3]);
  #pragma unroll
  for(int r=4;r<16;r+=4){a=max3f(a,p0[r],p0[r+1]);b=max3f(b,p0[r+2],p0[r+3]);a=max3f(a,p1[r],p1[r+1]);b=max3f(b,p1[r+2],p1[r+3]);}
  const float m=max2f(a,b);
  auto rr=__builtin_amdgcn_permlane32_swap(__float_as_uint(m),__float_as_uint(m),false,false);
  return max2f(__uint_as_float(rr[0]),__uint_as_float(rr[1]));
}
__device__ __forceinline__ void pv(f32x16*o,int vb,bf16x8 pa0,bf16x8 pa1,bf16x8 pa2,bf16x8 pa3){
  #pragma unroll
  for(int d0=0;d0<2;++d0){s16x4 lo[4],hi[4];
    #pragma unroll
    for(int ks=0;ks<4;++ks){
      asm volatile("ds_read_b64_tr_b16 %0,%1 offset:%c2":"=&v"(lo[ks]):"v"(vb),"i"(d0*4096+ks*1024):"memory");
      asm volatile("ds_read_b64_tr_b16 %0,%1 offset:%c2":"=&v"(hi[ks]):"v"(vb),"i"(d0*4096+ks*1024+512):"memory");}
    asm volatile("s_waitcnt lgkmcnt(0)":::"memory");SBAR();
    #define PK(k) (bf16x8){lo[k][0],lo[k][1],lo[k][2],lo[k][3],hi[k][0],hi[k][1],hi[k][2],hi[k][3]}
    o[d0]=__builtin_amdgcn_mfma_f32_32x32x16_bf16(pa0,PK(0),o[d0],0,0,0);
    o[d0]=__builtin_amdgcn_mfma_f32_32x32x16_bf16(pa1,PK(1),o[d0],0,0,0);
    o[d0]=__builtin_amdgcn_mfma_f32_32x32x16_bf16(pa2,PK(2),o[d0],0,0,0);
    o[d0]=__builtin_amdgcn_mfma_f32_32x32x16_bf16(pa3,PK(3),o[d0],0,0,0);
    #undef PK
  }
}

#ifndef ATTN_STORE16
#define ATTN_STORE16(p,v) (*(u32x4*)(p)=(v))
#endif
template<int THRL> __device__ __forceinline__ void attn_unit(const bf16*Qu,const bf16*__restrict__ Kh,const bf16*__restrict__ Vh,bf16*Ou,const int NT,char*shm,const float*qgain,const float*ropet,const int tq0,int tid_){
  asm volatile("":"+v"(tid_)); const int tid=tid_,lane=tid&63,r32=lane&31,hi=lane>>5; const int wid=__builtin_amdgcn_readfirstlane(tid>>6);
  const bf16*Qw=Qu+(long)(wid*QBLK)*QP;
  const unsigned lds0=(unsigned)(uintptr_t)shm;
  float*wsf=(float*)(shm+LDS_WS)+wid*64;
  const bf16*ksrc=Kh+(long)lane*KVP+wid*8;
  const bf16*vsrc=Vh+(long)(16*(wid&3)+(lane>>2))*KVP+(wid>>2)*32+(lane&3)*8;
  const unsigned kdst=lds0+LDS_K+wid*1024, vdst=lds0+LDS_V+wid*1024;
  #define DMA_K(t,slot) glds16(ksrc+(long)(t)*KVBLK*KVP,(unsigned)__builtin_amdgcn_readfirstlane(kdst+(slot)))
  #define DMA_V(t,slot) glds16(vsrc+(long)(t)*KVBLK*KVP,(unsigned)__builtin_amdgcn_readfirstlane(vdst+(slot)))
  const int vb0=(int)(lds0+LDS_V)+((lane>>4)&1)*32+(lane&3)*8+(4*hi+((lane&15)>>2))*64;
  const char*Kbase=shm+LDS_K; bf16x8 kf[8];
  const lds_cptr shm3=(lds_cptr)shm; const lds_cptr kp0=shm3+LDS_K+hi*1024+r32*16; const lds_cptr vp0=shm3+LDS_V+((lane>>4)&1)*32+(lane&3)*8+(4*hi+((lane&15)>>2))*64;
  DMA_K(0,0);DMA_V(0,0);DMA_K(1,SLOTB);
  bf16x8 qr[4];
  #pragma unroll
  for(int d0=0;d0<4;++d0)qr[d0]=*reinterpret_cast<const bf16x8*>(&Qw[(long)r32*QP+d0*16+hi*8]);
  {
    float qv[4][8]; float ss=0.f;
    #pragma unroll
    for(int d0=0;d0<4;++d0){
      #pragma unroll
      for(int e=0;e<8;++e){ qv[d0][e]=__uint_as_float(((unsigned)(unsigned short)qr[d0][e])<<16); ss+=qv[d0][e]*qv[d0][e]; } }
    { auto rr=__builtin_amdgcn_permlane32_swap(__float_as_uint(ss),__float_as_uint(ss),false,false); ss=__uint_as_float(rr[0])+__uint_as_float(rr[1]); }
    const float rs=__builtin_amdgcn_rsqf(ss*(1.0f/64.0f)+1e-6f);
    #pragma unroll
    for(int d0=0;d0<4;++d0){
      #pragma unroll
      for(int e=0;e<8;++e) qv[d0][e]*=rs*qgain[d0*16+hi*8+e]; }
    if(ropet){ const int t=tq0+wid*QBLK+r32;
      #pragma unroll
      for(int h2=0;h2<2;++h2){ const float*cs=ropet+(((h2==0)?(t>>6):(t&63))*16+hi*8)*2;
        #pragma unroll
        for(int e=0;e<8;++e){ const float c=cs[2*e],sn=cs[2*e+1]; const float x1=qv[2*h2][e],x2=qv[2*h2+1][e]; qv[2*h2][e]=x1*c-x2*sn; qv[2*h2+1][e]=x2*c+x1*sn; } } }
    #pragma unroll
    for(int d0=0;d0<4;++d0){ u32x4 w; w[0]=cvtpk_s(qv[d0][0]*C2,qv[d0][1]*C2); w[1]=cvtpk_s(qv[d0][2]*C2,qv[d0][3]*C2); w[2]=cvtpk_s(qv[d0][4]*C2,qv[d0][5]*C2); w[3]=cvtpk_s(qv[d0][6]*C2,qv[d0][7]*C2); qr[d0]=__builtin_bit_cast(bf16x8,w); }
  }
  float mhat=0.f,l_reg=0.f;f32x16 o[2];o[0]=f32x16{};o[1]=f32x16{};f32x16 negm=f32x16{};asm volatile("":"+v"(negm));
  #define CMASK(P0,P1,t) do{}while(0)
  bool resc=false;
  #define START(P0,P1) do{ const float rm=rowmax(P0,P1); resc=false; \
    { const float dl=rm; mhat=fadd_s(mhat,dl); \
      _Pragma("unroll") for(int r=0;r<16;++r){P0[r]=fsub_s(P0[r],dl);P1[r]=fsub_s(P1[r],dl);} \
      _Pragma("unroll") for(int r=0;r<16;++r)negm[r]=-mhat; asm volatile("":"+v"(negm)); } \
    _Pragma("unroll") for(int r=0;r<16;++r)P0[r]=__builtin_amdgcn_exp2f(P0[r]); }while(0)
  #define RESC() do{ if(resc){ asm volatile("s_waitcnt lgkmcnt(0)":::"memory"); \
      _Pragma("unroll") for(int d_=0;d_<2;++d_) _Pragma("unroll") for(int r=0;r<16;++r)o[d_][r]*=wsf[crow(r,hi)]; } }while(0)
  f32x16 pA0,pA1,pB0,pB1;
  int sl_prev=0,sl_cur=0,sl_next=SLOTB;
  #define ROT() do{sl_prev=sl_cur;sl_cur=sl_next;sl_next=(sl_next==(NSLOT-1)*SLOTB)?0:sl_next+SLOTB;}while(0)
  DMA_K(2,2*SLOTB);
  WAIT_BAR(3);
  qkt(pA0,pA1,Kbase,qr,negm,r32,hi);asm volatile("s_nop 15\n\ts_nop 7":"+v"(pA0),"+v"(pA1));CMASK(pA0,pA1,0);
  START(pA0,pA1);
  _Pragma("unroll") for(int r=0;r<16;++r)pA1[r]=__builtin_amdgcn_exp2f(pA1[r]);
  WAIT_BAR(0);
  DMA_K(3,0);DMA_V(1,SLOTB);
  ROT();
  kload8(kf,kp0+sl_cur);
  WAIT_BAR(2);
  s16x4 vlo[8],vhi[8]; u32x4 pw0,pw1,pw2,pw3;
  #define PKW(P,B) cvtpk_s(P[B],P[B+1])
  #define PAF(k) __builtin_bit_cast(bf16x8,pw##k)
  #define VFR(i) (bf16x8){vlo[i][0],vlo[i][1],vlo[i][2],vlo[i][3],vhi[i][0],vhi[i][1],vhi[i][2],vhi[i][3]}
  #define PIN(x) asm volatile("":"+v"(x))
  #define MX3(a,b,c) __builtin_fmaxf(__builtin_fmaxf((a),(b)),(c))
  #define GAPA(MF,A0,A1,A2,A3,W0,W1,PW) do{ MF; sacc+=A0; sacc+=A1; sacc+=A2; sacc+=A3; PIN(sacc); W0; W1; PIN(PW); SBAR(); }while(0)
  #define EX(v) __builtin_amdgcn_exp2f(v)
  #define GAPB(MF,X,B) do{ MF; X[B]=EX(X[B]); X[B+1]=EX(X[B+1]); X[B+2]=EX(X[B+2]); X[B+3]=EX(X[B+3]); PIN(X); SBAR(); }while(0)
  #define VRD(i) do{ vlo[i]=vtr(vp_+(((i)>>2)*4096+((i)&3)*1024)); vhi[i]=vtr(vp_+(((i)>>2)*4096+((i)&3)*1024+512)); }while(0)
  #define KRD(G,j) do{ if(G){ kload2(kf,kp0+sl_next,j); SBAR(); } }while(0)
  #define STEP(C0,C1,P0,P1,t,GK,GV,GL) do{ SBAR(); \
    const lds_cptr vp_=vp0+sl_prev; \
    VRD(0); SBAR(); float sacc=(P0[0]+P0[1]); \
    GAPA(C0=__builtin_amdgcn_mfma_f32_32x32x16_bf16(kf[0],qr[0],negm,0,0,0), P0[2],P0[3],P0[4],P0[5],     pw0[0]=PKW(P0,0), pw0[1]=PKW(P0,2), pw0); \
    VRD(4); SBAR(); GAPA(C1=__builtin_amdgcn_mfma_f32_32x32x16_bf16(kf[1],qr[0],negm,0,0,0), P0[6],P0[7],P0[8],P0[9],     pw0[2]=PKW(P0,4), pw0[3]=PKW(P0,6), pw0); \
    VRD(1); SBAR(); GAPA(C0=__builtin_amdgcn_mfma_f32_32x32x16_bf16(kf[2],qr[1],C0,0,0,0),   P0[10],P0[11],P0[12],P0[13], pw1[0]=PKW(P0,8), pw1[1]=PKW(P0,10), pw1); \
    VRD(5); SBAR(); GAPA(C1=__builtin_amdgcn_mfma_f32_32x32x16_bf16(kf[3],qr[1],C1,0,0,0),   P0[14],P0[15],P1[0],P1[1],   pw1[2]=PKW(P0,12),pw1[3]=PKW(P0,14), pw1); \
    VRD(2); SBAR(); GAPA(C0=__builtin_amdgcn_mfma_f32_32x32x16_bf16(kf[4],qr[2],C0,0,0,0),   P1[2],P1[3],P1[4],P1[5],     pw2[0]=PKW(P1,0), pw2[1]=PKW(P1,2), pw2); \
    VRD(6); SBAR(); GAPA(C1=__builtin_amdgcn_mfma_f32_32x32x16_bf16(kf[5],qr[2],C1,0,0,0),   P1[6],P1[7],P1[8],P1[9],     pw2[2]=PKW(P1,4), pw2[3]=PKW(P1,6), pw2); \
    VRD(3); SBAR(); GAPA(C0=__builtin_amdgcn_mfma_f32_32x32x16_bf16(kf[6],qr[3],C0,0,0,0),   P1[10],P1[11],P1[12],P1[13], pw3[0]=PKW(P1,8), pw3[1]=PKW(P1,10), pw3); \
    VRD(7); SBAR(); GAPA(C1=__builtin_amdgcn_mfma_f32_32x32x16_bf16(kf[7],qr[3],C1,0,0,0),   P1[14],P1[15],0.f,0.f,       pw3[2]=PKW(P1,12),pw3[3]=PKW(P1,14), pw3); \
    l_reg+=sacc; \
    if(GK){DMA_K((t)+3,sl_cur);} if(GV){DMA_V((t)+1,sl_next);} \
    CMASK(C0,C1,t); \
    { float a=MX3(C0[0],C0[1],C1[0]),b=MX3(C0[2],C0[3],C1[1]); a=MX3(a,C1[2],C1[3]); \
      _Pragma("unroll") for(int r=4;r<16;r+=4){a=MX3(a,C0[r],C0[r+1]);b=MX3(b,C0[r+2],C0[r+3]);a=MX3(a,C1[r],C1[r+1]);b=MX3(b,C1[r+2],C1[r+3]);} \
      float rm=__builtin_fmaxf(a,b); { auto rr=__builtin_amdgcn_permlane32_swap(__float_as_uint(rm),__float_as_uint(rm),false,false); rm=__builtin_fmaxf(__uint_as_float(rr[0]),__uint_as_float(rr[1])); } \
      resc=false; \
      if(__builtin_expect(__any(rm>(float)THRL),0)){ const float dl=__builtin_fmaxf(rm,0.f); mhat+=dl; \
        _Pragma("unroll") for(int r=0;r<16;++r){C0[r]-=dl;C1[r]-=dl;} \
        _Pragma("unroll") for(int r=0;r<16;++r)negm[r]=-mhat; asm volatile("":"+v"(negm)); \
        const float f=__builtin_amdgcn_exp2f(-dl); l_reg*=f; if(hi==0)wsf[r32]=f; resc=true; } } \
    SBAR(); \
    GAPB(o[0]=__builtin_amdgcn_mfma_f32_32x32x16_bf16(PAF(0),VFR(0),o[0],0,0,0), C0,0); \
    GAPB(o[1]=__builtin_amdgcn_mfma_f32_32x32x16_bf16(PAF(0),VFR(4),o[1],0,0,0), C0,4); \
    KRD(GL,0); GAPB(o[0]=__builtin_amdgcn_mfma_f32_32x32x16_bf16(PAF(1),VFR(1),o[0],0,0,0), C0,8); \
    KRD(GL,1); GAPB(o[1]=__builtin_amdgcn_mfma_f32_32x32x16_bf16(PAF(1),VFR(5),o[1],0,0,0), C0,12); \
    KRD(GL,2); GAPB(o[0]=__builtin_amdgcn_mfma_f32_32x32x16_bf16(PAF(2),VFR(2),o[0],0,0,0), C1,0); \
    KRD(GL,3); GAPB(o[1]=__builtin_amdgcn_mfma_f32_32x32x16_bf16(PAF(2),VFR(6),o[1],0,0,0), C1,4); \
    GAPB(o[0]=__builtin_amdgcn_mfma_f32_32x32x16_bf16(PAF(3),VFR(3),o[0],0,0,0), C1,8); \
    GAPB(o[1]=__builtin_amdgcn_mfma_f32_32x32x16_bf16(PAF(3),VFR(7),o[1],0,0,0), C1,12); \
    }while(0)
  int t=1;
  #undef CMASK
  #define CMASK(P0,P1,t) do{}while(0)
  for(;t+5<NT;t+=2){
    STEP(pB0,pB1,pA0,pA1,t,true,true,true);     WAIT_BAR(2); RESC(); ROT();
    STEP(pA0,pA1,pB0,pB1,t+1,true,true,true);   WAIT_BAR(2); RESC(); ROT();
  }
  #undef CMASK
  #define CMASK(P0,P1,t) do{}while(0)
  #define ENDW(tt) do{ if((tt)+3<NT){WAIT_BAR(2);} else if((tt)+2<NT){WAIT_BAR(1);} else {WAIT_BAR(0);} }while(0)
  for(;t+1<NT;t+=2){
    STEP(pB0,pB1,pA0,pA1,t,(t+3<NT),(t+1<NT),(t+1<NT));       ENDW(t);   RESC(); ROT();
    STEP(pA0,pA1,pB0,pB1,t+1,(t+4<NT),(t+2<NT),(t+2<NT));     ENDW(t+1); RESC(); ROT();
  }
  STEP(pB0,pB1,pA0,pA1,NT-1,false,false,false); RESC();
  { float sacc=pB0[0]+pB0[1]; _Pragma("unroll") for(int r=2;r<16;++r)sacc+=pB0[r]; _Pragma("unroll") for(int r=0;r<16;++r)sacc+=pB1[r]; l_reg+=sacc;
    pw0=(u32x4){PKW(pB0,0),PKW(pB0,2),PKW(pB0,4),PKW(pB0,6)};pw1=(u32x4){PKW(pB0,8),PKW(pB0,10),PKW(pB0,12),PKW(pB0,14)};pw2=(u32x4){PKW(pB1,0),PKW(pB1,2),PKW(pB1,4),PKW(pB1,6)};pw3=(u32x4){PKW(pB1,8),PKW(pB1,10),PKW(pB1,12),PKW(pB1,14)};
    SBAR(); pv(o,vb0+sl_cur,PAF(0),PAF(1),PAF(2),PAF(3)); }
  #undef PKW
  #undef PAF
  #undef VFR
  #undef PIN
  #undef MX3
  #undef GAPA
  #undef GAPB
  #undef EX
  #undef VRD
  #undef KRD
  #undef STEP
  #undef ENDW
  {auto rr=__builtin_amdgcn_permlane32_swap(__float_as_uint(l_reg),__float_as_uint(l_reg),false,false);l_reg=__uint_as_float(rr[0])+__uint_as_float(rr[1]);}
  if(hi==0)wsf[32+r32]=l_reg;asm volatile("s_waitcnt lgkmcnt(0)":::"memory");
  float rli[16];
  #pragma unroll
  for(int r=0;r<16;++r)rli[r]=__builtin_amdgcn_rcpf(wsf[32+crow(r,hi)]);
  bf16*Ow=Ou+(long)(wid*QBLK)*DM;
  { bf16*stg=(bf16*)(shm+LDS_OST)+wid*2048;
    #pragma unroll
    for(int r=0;r<16;++r){const int orow=crow(r,hi);
      #pragma unroll
      for(int d0=0;d0<2;++d0)stg[orow*64+d0*32+r32]=__float2bfloat16(o[d0][r]*rli[r]);}
    asm volatile("s_waitcnt lgkmcnt(0)":::"memory");
    #pragma unroll
    for(int i=0;i<4;++i){const int row=i*8+(lane>>3),ch=lane&7; const u32x4 v=*(const u32x4*)(stg+row*64+ch*8); ATTN_STORE16(Ow+(long)row*DM+ch*8,v);} }
  asm volatile("s_waitcnt lgkmcnt(0)\n\ts_barrier":::"memory");
  #undef DMA_K
  #undef DMA_V
  #undef CMASK
  #undef START
  #undef RESC
  #undef ROT
}
constexpr int ATTN_LDS_BYTES=LDS_BYTES;
#undef SBAR
#undef WAIT_BAR
}
constexpr int DM = 1024, NBATCH = 4, SEQ = 4096, CTXL = 256, NLAYER = 2;
constexpr int RLAT = NBATCH * SEQ, RCTX = NBATCH * CTXL, RT = RLAT + RCTX;
constexpr int INW = 1536, FFH = 2816, KVLEN = CTXL + SEQ, NCHK = KVLEN / 64;
constexpr int NCHUNK = RT / 64;
constexpr float RMS_EPS = 1e-6f;
constexpr int NWAVES = 8, NTHR = 512;
constexpr size_t MiB = 1u << 20;
constexpr size_t WS_CTL = 0, CTL_ZERO_BYTES = 1 * MiB;
constexpr size_t WS_WT = 1 * MiB, WT_LAYER = 21 * MiB + MiB / 2, WIN_OFF = 0, WOUT_OFF = 3 * MiB, WFI_OFF = 5 * MiB, WFO_OFF = 16 * MiB;
constexpr int MOD_SLABS = 32, MOD_ROWS = 1024 / MOD_SLABS;
constexpr size_t WS_MODP = 156 * MiB  , WS_MOD = 46 * MiB, WS_ROPE = 46 * MiB + MiB / 2, WS_AGG = 47 * MiB;
constexpr size_t WS_GWF = 48 * MiB + MiB / 2, WS_PWF = 48 * MiB + 3 * MiB / 4, WS_SPB = 49 * MiB;
constexpr size_t WS_XRC = 50 * MiB;
constexpr size_t WS_XN = 54 * MiB;
constexpr size_t WS_YO = 88 * MiB;
constexpr size_t WS_RES = 88 * MiB;
constexpr size_t WS_LRU = 0  , LRU_PLANE = 17 * MiB;
constexpr size_t WS_Y = 156 * MiB;
constexpr size_t WS_P = 190 * MiB;
constexpr size_t WS_KB = 241 * MiB, WS_VB = 245 * MiB + MiB / 4;
constexpr size_t WS_H = 156 * MiB;
constexpr size_t WS_XB = 250 * MiB, XB_BANK = 272 * 1024;
constexpr size_t WS_END = 256 * MiB;
static_assert(WS_VB + (size_t)NBATCH * KVLEN * 128 * 2 <= WS_END && WS_H + (size_t)RT * FFH * 2 <= WS_END && WS_P + (size_t)RT * INW * 2 <= WS_KB, "ws map");
constexpr int LDS_BYTES = 147456;

#define GAS __attribute__((address_space(1)))
#define LAS __attribute__((address_space(3)))
typedef unsigned short bf16;
typedef unsigned v4u __attribute__((ext_vector_type(4)));
typedef unsigned v2u __attribute__((ext_vector_type(2)));
typedef float f32x4 __attribute__((ext_vector_type(4)));
typedef float f32x2v __attribute__((ext_vector_type(2)));
typedef short bf16x8 __attribute__((ext_vector_type(8)));
typedef __bf16 bf16x2_t __attribute__((ext_vector_type(2)));
#define LDS_WAIT() asm volatile("s_waitcnt lgkmcnt(0)" ::: "memory")
__device__ __forceinline__ unsigned pk2(float lo, float hi) { f32x2v v = {lo, hi}; bf16x2_t b = __builtin_convertvector(v, bf16x2_t); return __builtin_bit_cast(unsigned, b); }
__device__ __forceinline__ float bflo(unsigned w) { return __uint_as_float(w << 16); }
__device__ __forceinline__ float bfhi(unsigned w) { return __uint_as_float(w & 0xffff0000u); }
__device__ __forceinline__ float wave_sum(float v, int lane_) {
#pragma unroll
    for (int o = 1; o < 64; o <<= 1) v += shx(v, o, lane_);
    return v;
}
__device__ __forceinline__ float sigmoid_f(float x) { return __builtin_amdgcn_rcpf(1.0f + __expf(-x)); }
__device__ __forceinline__ float gelu_tanh_f(float x) { const float t = fmaf(x * x, -2.0f * 1.4426950408889634f * 0.7978845608028654f * 0.044715f, -2.0f * 1.4426950408889634f * 0.7978845608028654f); return x * __builtin_amdgcn_rcpf(1.0f + __builtin_amdgcn_exp2f(x * t)); }

#define XB_TMO      128
#define XB_XCNT(j)  (256  + 64 * (j))
#define XB_XSUB(j)  (1280 + 64 * (j))
#define XB_XGEN(j)  (2304 + 64 * (j))
#define XB_TOP      3328
#define XB_TOPGEN   3392
#define XCD_BAR_WORDS 3456
#define XB_SPIN_CAP (1u << 18)

__device__ __forceinline__ unsigned xb_ld(unsigned* p)              { return __hip_atomic_load(p, __ATOMIC_RELAXED, __HIP_MEMORY_SCOPE_AGENT); }
__device__ __forceinline__ unsigned xb_add(unsigned* p, unsigned v) { return __hip_atomic_fetch_add(p, v, __ATOMIC_RELAXED, __HIP_MEMORY_SCOPE_AGENT); }
__device__ __forceinline__ unsigned xb_xcc_id() { return (unsigned)__builtin_amdgcn_s_getreg((3 << 11) | 20) & 0xFu; }
#define XB_SPIN(cond, bar) do { unsigned _sp = 0; while (cond) { __builtin_amdgcn_s_sleep(1); \
    if ((++_sp & 255u) == 0u) { if (xb_ld(&(bar)[XB_TMO])) break; if (_sp > XB_SPIN_CAP) { atomicAdd(&(bar)[XB_TMO], 1u); break; } } } } while (0)

struct XcdBarrier {
    unsigned* bar; unsigned x;
    volatile LAS unsigned* st;
};

__device__ __forceinline__ XcdBarrier xcd_barrier_post(unsigned* bar, volatile LAS unsigned* st, bool leader) {
    XcdBarrier b; b.bar = bar; b.x = xb_xcc_id(); b.st = st;
    if (leader) (void)xb_add(&bar[XB_XCNT(b.x)], 1u);
    return b;
}
__device__ __forceinline__ void xcd_barrier_complete(unsigned* bar, unsigned x, unsigned& nloc, unsigned& nx) {
    const unsigned G = gridDim.x * gridDim.y * gridDim.z;
    unsigned sum, cnt, mine, sp = 0u;
    for (;;) {
        sum = 0u; cnt = 0u; mine = 0u;
#pragma unroll
        for (unsigned j = 0; j < 16; ++j) { const unsigned c = xb_ld(&bar[XB_XCNT(j)]); sum += c; cnt += (c > 0u) ? 1u : 0u; mine = (j == x) ? c : mine; }
        if (sum == G) break;
        __builtin_amdgcn_s_sleep(1);
        if ((++sp & 255u) == 0u) { if (xb_ld(&bar[XB_TMO])) break; if (sp > XB_SPIN_CAP) { atomicAdd(&bar[XB_TMO], 1u); break; } }
    }
    nloc = mine > 0u ? mine : 1u; nx = cnt > 0u ? cnt : 1u;
}

__device__ __forceinline__ void xcd_barrier(const XcdBarrier& b, bool leader) {
    asm volatile("s_waitcnt vmcnt(0)" ::: "memory");
    __syncthreads();
    if (leader) {
        unsigned* bar = b.bar;
        __builtin_amdgcn_s_waitcnt(0);
        unsigned nloc = b.st[0], nx = b.st[1];
        if (nloc == 0u) { xcd_barrier_complete(bar, b.x, nloc, nx); b.st[0] = nloc; b.st[1] = nx; }
        const unsigned old = xb_add(&bar[XB_XSUB(b.x)], 1u);
        const unsigned gen = old / nloc;
        if (old + 1u == (gen + 1u) * nloc) {
            __builtin_amdgcn_fence(__ATOMIC_RELEASE, "agent");
            asm volatile("s_waitcnt vmcnt(0)" ::: "memory");
            const unsigned og = xb_add(&bar[XB_TOP], 1u);
            const unsigned tg = og / nx;
            if (og + 1u == (tg + 1u) * nx) xb_add(&bar[XB_TOPGEN], 1u);
            else XB_SPIN(xb_ld(&bar[XB_TOPGEN]) == tg, bar);
            __builtin_amdgcn_fence(__ATOMIC_ACQUIRE, "agent");
            xb_add(&bar[XB_XGEN(b.x)], 1u);
            asm volatile("s_waitcnt vmcnt(0)" ::: "memory");
        } else {
            XB_SPIN(xb_ld(&bar[XB_XGEN(b.x)]) == gen, bar);
            __builtin_amdgcn_fence(__ATOMIC_ACQUIRE, "agent");
            asm volatile("s_waitcnt vmcnt(0)" ::: "memory");
        }
    }
    __syncthreads();
}

constexpr int CW_TMO = 0, CW_SEAM = 16384, SEAM_BANK = 68 * 64;
constexpr int CW_BAR = 4096;
constexpr int MISC_OFF = LDS_BYTES - 64;
struct Params { const float* in[21]; float* out; unsigned char* ws; };
typedef const __attribute__((address_space(4))) unsigned long long* kargp_t;
__device__ __forceinline__ const float* kin(int i) { return (const float*)((kargp_t)__builtin_amdgcn_kernarg_segment_ptr())[i]; }
__device__ __forceinline__ float* kout() { return (float*)((kargp_t)__builtin_amdgcn_kernarg_segment_ptr())[21]; }
__device__ __forceinline__ unsigned char* kws() { return (unsigned char*)((kargp_t)__builtin_amdgcn_kernarg_segment_ptr())[22]; }
enum { I_X = 0, I_C, I_CTX, I_CCTX, I_WMOD, I_BMOD, I_NORMG, I_WIN, I_QNG, I_KNG, I_CONVW, I_CONVB, I_GATEW, I_GATEB, I_LAM, I_POOLW, I_POOLB, I_POOLS, I_WOUT, I_WFI, I_WFO };

__device__ __forceinline__ void transpose_item(const float* W, int K, int N, bf16* WT, int orow0, int k0, int n0, LAS float* scr, int lane) {
    float tv[32];
#pragma unroll
    for (int i = 0; i < 32; ++i) tv[i] = __builtin_nontemporal_load(W + (size_t)(k0 + 2 * i + (lane >> 5)) * N + n0 + (lane & 31));
#pragma unroll
    for (int i = 0; i < 32; ++i) scr[(2 * i + (lane >> 5)) * 33 + (lane & 31)] = tv[i];
    LDS_WAIT(); asm volatile("" ::: "memory");
    const int c = lane & 7;
#pragma unroll
    for (int j = 0; j < 4; ++j) { const int n = (lane >> 3) + 8 * j; const LAS float* s = scr + (8 * c) * 33 + n;
        v4u o; o.x = pk2(s[0 * 33], s[1 * 33]); o.y = pk2(s[2 * 33], s[3 * 33]); o.z = pk2(s[4 * 33], s[5 * 33]); o.w = pk2(s[6 * 33], s[7 * 33]);
        *(GAS v4u*)(WT + (size_t)(orow0 + n) * K + k0 + 8 * c) = o; }
    LDS_WAIT(); asm volatile("" ::: "memory");
}
__device__ __forceinline__ void phase0a(const Params& p, LAS unsigned char* lds, int tid, int lane, int wave, int vcu, int G) {
    unsigned char* ws = kws();
    { const int gt = ((tid >> 6) * (int)gridDim.x + (int)blockIdx.x) * 64 + (tid & 63);
      if (gt < 1024) { const int pos = gt >> 4, i = gt & 15; const float freq = exp2f(-(float)i * (13.287712379549449f / 16.0f)); const float ang = (float)pos * freq;
          const float k = rintf(ang * 0.15915494309189535f); float r = fmaf(-k, 6.2831855f, ang); r = fmaf(k, 1.7484555e-7f, r);
          float* rp = (float*)(ws + WS_ROPE); rp[2 * gt] = cosf(r); rp[2 * gt + 1] = sinf(r); } }
    { const int gt = ((tid >> 6) * (int)gridDim.x + (int)blockIdx.x) * 64 + (tid & 63);
      if (gt < 16384) { const int ln = gt & 63, f = gt >> 6, kk = f & 1, nt = (f >> 1) & 3, g2 = (f >> 3) & 1, n = (f >> 4) & 3, d = (f >> 6) & 1, l = f >> 7, qd = ln >> 4, l16 = ln & 15;
          const float* gw_ = kin(I_GATEW) + ((size_t)(((l * 2 + d) * 2 + g2) * 4 + n)) * 4096 + (kk * 32 + qd * 8) * 64 + nt * 16 + l16;
          v4u o; o.x = pk2(gw_[0], gw_[64]); o.y = pk2(gw_[128], gw_[192]); o.z = pk2(gw_[256], gw_[320]); o.w = pk2(gw_[384], gw_[448]);
          ((v4u*)(ws + WS_GWF))[gt] = o; }
      else if (gt < 16384 + 4096) { const int q = gt - 16384, ln = q & 63, f = q >> 6, kk = f & 1, nt = (f >> 1) & 3, lg = f >> 3, qd = ln >> 4, l16 = ln & 15;
          const float* pw = kin(I_POOLW) + (size_t)lg * 4096 + (kk * 32 + qd * 8) * 64 + nt * 16 + l16;
          v4u o; o.x = pk2(pw[0], pw[64]); o.y = pk2(pw[128], pw[192]); o.z = pk2(pw[256], pw[320]); o.w = pk2(pw[384], pw[448]);
          ((v4u*)(ws + WS_PWF))[q] = o; }
      else if (gt < 16384 + 4096 + 3072) { const int q = gt - 20480, ch = q & 255, k3 = (q >> 8) % 3, ld = q / 768;
          float v;
          if (k3 < 2) v = kin(I_GATEB)[(ld * 2 + k3) * 256 + ch]; else v = -8.0f * 1.4426950408889634f * log1pf(expf(-kin(I_LAM)[ld * 256 + ch]));
          ((float*)(ws + WS_SPB))[q] = v; } }
    LAS float* S = (LAS float*)(lds + 8 * 8448);
    for (int i = tid; i < 5 * 1024; i += NTHR) { const float v = (i < 4096) ? kin(I_C)[i] : kin(I_CCTX)[i - 4096]; S[i] = v / (1.0f + expf(-v)); }
    __syncthreads();
    LAS float* scr = (LAS float*)(lds + wave * 8448);
    constexpr int I_IN = 16 * 48, I_OUT = 16 * 32, I_FI = 16 * 176, I_FO = 44 * 32, PER = I_IN + I_OUT + I_FI + I_FO;
    constexpr int NGEMV = NLAYER * MOD_SLABS * 24;
    for (int it0 = wave * G + vcu; it0 < NGEMV + NLAYER * PER; it0 += NWAVES * G) {
        if (it0 < NGEMV) {
            const int l = it0 / (MOD_SLABS * 24), rem = it0 % (MOD_SLABS * 24), slab = rem / 24, cb = rem % 24, col = cb * 256 + lane * 4;
            f32x4 a0 = {0.f, 0.f, 0.f, 0.f}, a1 = a0, a2 = a0, a3 = a0, a4 = a0;
            const float* wp = kin(I_WMOD) + ((size_t)(l * 1024 + slab * MOD_ROWS)) * 6144 + col;
#pragma unroll 8
            for (int k = 0; k < MOD_ROWS; ++k) { const f32x4 w = __builtin_nontemporal_load((const GAS f32x4*)(wp + (size_t)k * 6144)); const int kk = slab * MOD_ROWS + k;
                a0 += S[kk] * w; a1 += S[1024 + kk] * w; a2 += S[2048 + kk] * w; a3 += S[3072 + kk] * w; a4 += S[4096 + kk] * w; }
            float* o = (float*)(ws + WS_MODP) + ((size_t)((l * MOD_SLABS + slab) * 5)) * 6144 + col;
            *(f32x4*)(o) = a0; *(f32x4*)(o + 6144) = a1; *(f32x4*)(o + 2 * 6144) = a2; *(f32x4*)(o + 3 * 6144) = a3; *(f32x4*)(o + 4 * 6144) = a4;
            continue;
        }
        const int it = it0 - NGEMV;
        const int l = it / PER; int r = it % PER; unsigned char* wl = ws + WS_WT + (size_t)l * WT_LAYER;
        if (r < I_IN) { const int kb = r / 48, nb = r % 48; transpose_item(kin(I_WIN) + (size_t)l * 1024 * 1536, 1024, 1536, (bf16*)(wl + WIN_OFF), 32 * nb, 64 * kb, 32 * nb, scr, lane); continue; } r -= I_IN;
        if (r < I_OUT) { const int kb = r / 32, nb = r % 32; transpose_item(kin(I_WOUT) + (size_t)l * 1024 * 1024, 1024, 1024, (bf16*)(wl + WOUT_OFF), 32 * nb, 64 * kb, 32 * nb, scr, lane); continue; } r -= I_OUT;
        if (r < I_FI) { const int kb = r / 176, nb = r % 176; const int n0 = 32 * nb; const int j = n0 < FFH ? n0 : n0 - FFH; const int orow0 = 256 * (j / 128) + (j % 128) + (n0 < FFH ? 0 : 128);
            transpose_item(kin(I_WFI) + (size_t)l * 1024 * 5632, 1024, 5632, (bf16*)(wl + WFI_OFF), orow0, 64 * kb, n0, scr, lane); continue; } r -= I_FI;
        { const int kb = r / 32, nb = r % 32; transpose_item(kin(I_WFO) + (size_t)l * FFH * 1024, FFH, 1024, (bf16*)(wl + WFO_OFF), 32 * nb, 64 * kb, 32 * nb, scr, lane); }
    }
}
__device__ __forceinline__ void phase0b(const Params& p, int tid) {
    const int gt = ((tid >> 6) * (int)gridDim.x + (int)blockIdx.x) * 64 + (tid & 63);
    if (gt < NLAYER * 5 * 6144) {
        const int l = gt / 30720, rem = gt % 30720, r = rem / 6144, j = rem % 6144, c = j >> 10, col = j & 1023;
        const float* modp = (const float*)(kws() + WS_MODP);
        float raw = kin(I_BMOD)[l * 6144 + j];
#pragma unroll
        for (int s = 0; s < MOD_SLABS; ++s) raw += modp[((size_t)((l * MOD_SLABS + s) * 5 + r)) * 6144 + j];
        const float* ng = kin(I_NORMG) + l * 4096;
        float val = raw;
        if (c == 1) val = ng[col] * (1.0f + raw); else if (c == 2) val = raw * ng[1024 + col]; else if (c == 4) val = ng[2048 + col] * (1.0f + raw); else if (c == 5) val = raw * ng[3072 + col];
        ((float*)(kws() + WS_MOD))[gt] = val;
    }
}
template <bool HAS_YO, bool HAS_NEXT>
__device__ __forceinline__ void norm_phase(const float* yo, const float* src_lat, const float* src_ctx, float* dst_lat, float* dst_ctx,
                                           const float* modG, const float* modA, const float* modS, bf16* XN, int nrows, int gw, int NGW, int lane) {
    asm volatile("" : "+v"(lane));
    for (int m = gw; m < nrows; m += NGW) {
        const int r = m < RLAT ? (m >> 12) : 4;
        const float* src = m < RLAT ? src_lat + (size_t)m * DM : src_ctx + (size_t)(m - RLAT) * DM;
        f32x4 v[4];
#pragma unroll
        for (int j = 0; j < 4; ++j) v[j] = __builtin_nontemporal_load((const GAS f32x4*)(src + 4 * lane + 256 * j));
        if (HAS_YO) {
            f32x4 y[4]; float ss = 0.f;
#pragma unroll
            for (int j = 0; j < 4; ++j) { y[j] = *(const GAS f32x4*)(yo + (size_t)m * DM + 4 * lane + 256 * j); ss += (y[j].x * y[j].x + y[j].y * y[j].y) + (y[j].z * y[j].z + y[j].w * y[j].w); }
            const float rs = rsqrtf(wave_sum(ss, lane) * (1.0f / DM) + RMS_EPS);
            float* dst = m < RLAT ? dst_lat + (size_t)m * DM : dst_ctx + (size_t)(m - RLAT) * DM;
#pragma unroll
            for (int j = 0; j < 4; ++j) { const f32x4 g = *(const GAS f32x4*)(modG + r * 6144 + 4 * lane + 256 * j); v[j] += g * y[j] * rs; *(GAS f32x4*)(dst + 4 * lane + 256 * j) = v[j]; }
        }
        if (HAS_NEXT) {
            float ss = 0.f;
#pragma unroll
            for (int j = 0; j < 4; ++j) ss += (v[j].x * v[j].x + v[j].y * v[j].y) + (v[j].z * v[j].z + v[j].w * v[j].w);
            const float rs = rsqrtf(wave_sum(ss, lane) * (1.0f / DM) + RMS_EPS);
#pragma unroll
            for (int j = 0; j < 4; ++j) { const f32x4 a = *(const GAS f32x4*)(modA + r * 6144 + 4 * lane + 256 * j), s = *(const GAS f32x4*)(modS + r * 6144 + 4 * lane + 256 * j);
                const f32x4 o = v[j] * rs * a + s; v2u w; w.x = pk2(o.x, o.y); w.y = pk2(o.z, o.w); *(GAS v2u*)(XN + (size_t)m * DM + 4 * lane + 256 * j) = w; }
        }
    }
}
__device__ __forceinline__ void xn0_slot_phase(LAS unsigned char* lds, int tid, int wave, int vcu) {
    asm volatile("" : "+v"(tid)); const int lane = tid & 63;
    const bool lat = vcu < 240; const int slot = lat ? vcu / 60 : 4, w = lat ? vcu % 60 : vcu - 240, nw = lat ? 60 : 16, nrows = lat ? SEQ : RCTX;
    LAS float* AS = (LAS float*)lds;
    {   const float* modp = (const float*)(kws() + WS_MODP);
        for (int col = tid; col < 1024; col += NTHR) {
            float r0 = kin(I_BMOD)[col], r1 = kin(I_BMOD)[1024 + col];
#pragma unroll 16
            for (int s = 0; s < MOD_SLABS; ++s) { const float* q = modp + ((size_t)(s * 5 + slot)) * 6144 + col; r0 += q[0]; r1 += q[1024]; }
            AS[col] = kin(I_NORMG)[col] * (1.0f + r1); AS[1024 + col] = r0; } }
    __syncthreads();
    const float* src = lat ? kin(I_X) + (size_t)slot * SEQ * DM : kin(I_CTX);
    bf16* dstn = (bf16*)(kws() + WS_XN) + (size_t)(lat ? slot * SEQ : RLAT) * DM;
    f32x4 a[4], sh[4];
#pragma unroll
    for (int j = 0; j < 4; ++j) { a[j] = *(const LAS f32x4*)(AS + 4 * lane + 256 * j); sh[j] = *(const LAS f32x4*)(AS + 1024 + 4 * lane + 256 * j); }
    for (int i = w + nw * wave; i < nrows; i += nw * NWAVES) {
        f32x4 v[4]; float ss = 0.f;
#pragma unroll
        for (int j = 0; j < 4; ++j) v[j] = *(const GAS f32x4*)(src + (size_t)i * DM + 4 * lane + 256 * j);
#pragma unroll
        for (int j = 0; j < 4; ++j) ss += (v[j].x * v[j].x + v[j].y * v[j].y) + (v[j].z * v[j].z + v[j].w * v[j].w);
        const float rs = rsqrtf(wave_sum(ss, lane) * (1.0f / DM) + RMS_EPS);
#pragma unroll
        for (int j = 0; j < 4; ++j) { const f32x4 o = v[j] * rs * a[j] + sh[j]; v2u wv; wv.x = pk2(o.x, o.y); wv.y = pk2(o.z, o.w); *(GAS v2u*)(dstn + (size_t)i * DM + 4 * lane + 256 * j) = wv; }
    }
    __syncthreads();
}
__device__ __forceinline__ void ctx_norm(const float* slabs, int nslab, const float* src, float* dst, const float* vG, const float* vA, const float* vS, bf16* XNc, int gw, int NGW, int lane) {
    asm volatile("" : "+v"(lane));
    for (int m = gw; m < RCTX; m += NGW) {
        f32x4 v[4], g[4], a[4], sh[4];
#pragma unroll
        for (int j = 0; j < 4; ++j) { v[j] = __builtin_nontemporal_load((const GAS f32x4*)(src + (size_t)m * DM + 4 * lane + 256 * j)); g[j] = *(const GAS f32x4*)(vG + 4 * lane + 256 * j);
            a[j] = *(const GAS f32x4*)(vA + 4 * lane + 256 * j); sh[j] = *(const GAS f32x4*)(vS + 4 * lane + 256 * j); }
        f32x4 y[4] = {{0.f, 0.f, 0.f, 0.f}, {0.f, 0.f, 0.f, 0.f}, {0.f, 0.f, 0.f, 0.f}, {0.f, 0.f, 0.f, 0.f}};
        const float* sp = slabs + (size_t)m * DM + 4 * lane;
        for (int s0 = 0; s0 < nslab; s0 += 6) {
            f32x4 t[6][4];
#pragma unroll
            for (int s = 0; s < 6; ++s)
#pragma unroll
                for (int j = 0; j < 4; ++j) t[s][j] = (s0 + s < nslab) ? __builtin_nontemporal_load((const GAS f32x4*)(sp + (size_t)(s0 + s) * RCTX * DM + 256 * j)) : (f32x4){0.f, 0.f, 0.f, 0.f};
#pragma unroll
            for (int s = 0; s < 6; ++s)
#pragma unroll
                for (int j = 0; j < 4; ++j) y[j] += t[s][j]; }
        float ss = 0.f;
#pragma unroll
        for (int j = 0; j < 4; ++j) ss += (y[j].x * y[j].x + y[j].y * y[j].y) + (y[j].z * y[j].z + y[j].w * y[j].w);
        const float rs = rsqrtf(wave_sum(ss, lane) * (1.0f / DM) + RMS_EPS);
        float s2 = 0.f;
#pragma unroll
        for (int j = 0; j < 4; ++j) { v[j] += g[j] * y[j] * rs;
            *(GAS f32x4*)(dst + (size_t)m * DM + 4 * lane + 256 * j) = v[j]; s2 += (v[j].x * v[j].x + v[j].y * v[j].y) + (v[j].z * v[j].z + v[j].w * v[j].w); }
        const float rs2 = rsqrtf(wave_sum(s2, lane) * (1.0f / DM) + RMS_EPS);
#pragma unroll
        for (int j = 0; j < 4; ++j) { const f32x4 o = v[j] * rs2 * a[j] + sh[j]; v2u w; w.x = pk2(o.x, o.y); w.y = pk2(o.z, o.w); *(GAS v2u*)(XNc + (size_t)m * DM + 4 * lane + 256 * j) = w; }
    }
}
struct ChunkInfo { int row0, t0, L, b, isctx, cpos; };
__device__ __forceinline__ ChunkInfo chunk_info(int c) {
    ChunkInfo ci;
    if (c < RLAT / 64) { ci.b = c >> 6; const int j = c & 63; ci.t0 = j * 64; ci.row0 = ci.b * SEQ + ci.t0; ci.L = SEQ; ci.isctx = 0; ci.cpos = 4 + j; }
    else { const int cc = c - RLAT / 64; ci.b = cc >> 2; const int j = cc & 3; ci.t0 = j * 64; ci.row0 = RLAT + ci.b * CTXL + ci.t0; ci.L = CTXL; ci.isctx = 1; ci.cpos = j; }
    return ci;
}
constexpr int LROW = 264;
__device__ __forceinline__ void qk_norm_rope(float (&v)[8], const float* gain8, const float* rope, int s, int t, bool do_rope, int lane_) {
    float ss = 0.f;
#pragma unroll
    for (int e = 0; e < 8; ++e) ss += v[e] * v[e];
    ss += shx(ss, 1, lane_); ss += shx(ss, 2, lane_); ss += shx(ss, 4, lane_);
    const float rs = __builtin_amdgcn_rsqf(ss * (1.0f / 64.0f) + RMS_EPS);
#pragma unroll
    for (int e = 0; e < 8; ++e) v[e] *= rs * gain8[e];
    const int pos = (s < 4) ? (t >> 6) : (t & 63);
    const float* cs = rope + (pos * 16 + (s & 1) * 8) * 2;
    float pv[8];
#pragma unroll
    for (int e = 0; e < 8; ++e) pv[e] = shx(v[e], 2, lane_);
    if (do_rope) {
#pragma unroll
        for (int e4 = 0; e4 < 4; ++e4) { const f32x4 q = *(const GAS f32x4*)(cs + 4 * e4);
            const int e = 2 * e4;
            if (s & 2) { v[e] = v[e] * q.x + pv[e] * q.y; v[e + 1] = v[e + 1] * q.z + pv[e + 1] * q.w; }
            else       { v[e] = v[e] * q.x - pv[e] * q.y; v[e + 1] = v[e + 1] * q.z - pv[e + 1] * q.w; } }
    }
}
__device__ __forceinline__ void unpack8(const v4u w, float (&v)[8]) { v[0] = bflo(w.x); v[1] = bfhi(w.x); v[2] = bflo(w.y); v[3] = bfhi(w.y); v[4] = bflo(w.z); v[5] = bfhi(w.z); v[6] = bflo(w.w); v[7] = bfhi(w.w); }
__device__ __forceinline__ v4u pack8(const float (&v)[8]) { v4u w; w.x = pk2(v[0], v[1]); w.y = pk2(v[2], v[3]); w.z = pk2(v[4], v[5]); w.w = pk2(v[6], v[7]); return w; }

__device__ __forceinline__ void mixprep_chunk(const Params& p, int layer, int c, int smask, LAS unsigned char* lds, int tid, int lane, int wave) {
    asm volatile("" : "+v"(tid)); lane = tid & 63;
    const ChunkInfo ci = chunk_info(c);
    unsigned char* ws = kws();
    const bf16* P = (const bf16*)(ws + WS_P); bf16* Y = (bf16*)(ws + WS_Y);
    const float* rope = (const float*)(ws + WS_ROPE);
    const int quad = lane >> 4, l16 = lane & 15;
    v4u wB[5], wC[5], kraw[2], vraw[2];
    if (smask & 2) {
#pragma unroll
        for (int i = 0; i < 5; ++i) { const int idx = tid + i * NTHR, rr = idx >> 5, c8 = idx & 31; const int t = ci.t0 - 8 + rr;
            wB[i] = (v4u){0u, 0u, 0u, 0u};
            if (t >= 0 && t < ci.L) wB[i] = __builtin_nontemporal_load((const GAS v4u*)(P + ((size_t)ci.row0 - 8 + rr) * INW + 1280 + c8 * 8)); } }
    if (smask & 4) {
#pragma unroll
        for (int i = 0; i < 5; ++i) { const int idx = tid + i * NTHR, rr = idx >> 5, c8 = idx & 31; const int t = ci.t0 - 2 + rr;
            wC[i] = (v4u){0u, 0u, 0u, 0u};
            if (idx < 67 * 32 && t >= 0 && t < ci.L) wC[i] = __builtin_nontemporal_load((const GAS v4u*)(P + ((size_t)ci.row0 - 2 + rr) * INW + 768 + c8 * 8)); } }
    if (smask & 1) {   const int s = lane & 7;
#pragma unroll
        for (int ps = 0; ps < 2; ++ps) { const int idx = ps * NTHR + tid, tok = idx >> 4, s16 = idx & 15; const size_t row = (size_t)ci.row0 + tok;
            kraw[ps] = __builtin_nontemporal_load((const GAS v4u*)(P + row * INW + 512 + s16 * 8)); vraw[ps] = __builtin_nontemporal_load((const GAS v4u*)(P + row * INW + 640 + s16 * 8)); }
        float gk[8];
#pragma unroll
        for (int e = 0; e < 8; ++e) gk[e] = kin(I_KNG)[layer * 64 + s * 8 + e];
#pragma unroll
        for (int ps = 0; ps < 2; ++ps) { const int idx = ps * NTHR + tid, tok = idx >> 4; const int t = ci.t0 + tok;
            float v[8]; unpack8(kraw[ps], v);
            qk_norm_rope(v, gk, rope, s, t, !ci.isctx, lane);
            kraw[ps] = pack8(v); }
        bf16* KB = (bf16*)(ws + WS_KB); bf16* VB = (bf16*)(ws + WS_VB);
#pragma unroll
        for (int ps = 0; ps < 2; ++ps) { const int idx = ps * NTHR + tid, tok = idx >> 4, s16 = idx & 15; const int t = ci.t0 + tok;
            const size_t krow = (size_t)ci.b * KVLEN + (ci.isctx ? t : CTXL + t);
            *(GAS v4u*)(KB + krow * 128 + s16 * 8) = kraw[ps]; *(GAS v4u*)(VB + krow * 128 + s16 * 8) = vraw[ps]; }
    }
    if (smask & 2) {   LAS bf16* PX = (LAS bf16*)lds;
        LAS bf16* DB = (LAS bf16*)(lds + 45056);
#pragma unroll
        for (int i = 0; i < 5; ++i) { const int idx = tid + i * NTHR, rr = idx >> 5, c8 = idx & 31; *(LAS v4u*)(PX + rr * LROW + c8 * 8) = wB[i]; }
        __syncthreads();
        {   const int cp = tid & 127, tg = tid >> 7, g = cp >> 5, half = 1 << g;
            const LAS unsigned* PXw = (const LAS unsigned*)PX;
            float s0 = 0.f, s1 = 0.f;
            for (int rr = tg * 16 - half + 8; rr < tg * 16 + half + 8; ++rr) { const unsigned w = PXw[rr * (LROW / 2) + cp]; s0 += bflo(w); s1 += bfhi(w); }
#pragma unroll 4
            for (int i = 0; i < 16; ++i) { const int tok = tg * 16 + i, t = ci.t0 + tok;
                const int lo = max(t - half, 0), hi = min(t + half, ci.L); const float icnt = __builtin_amdgcn_rcpf((float)(hi - lo));
                const unsigned w = PXw[(tok + 8) * (LROW / 2) + cp];
                const float d0 = s0 * icnt - bflo(w), d1 = s1 * icnt - bfhi(w);
                ((LAS unsigned*)DB)[tok * (LROW / 2) + cp] = pk2(d0, d1);
                const unsigned wa = PXw[(tok + half + 8) * (LROW / 2) + cp], wr_ = PXw[(tok - half + 8) * (LROW / 2) + cp];
                s0 += bflo(wa) - bflo(wr_); s1 += bfhi(wa) - bfhi(wr_); }
        }
        __syncthreads();
        {   const int g = wave & 3, th = wave >> 2;
            const GAS v4u* pwf = (const GAS v4u*)(ws + WS_PWF) + (size_t)((layer * 4 + g) * 8) * 64 + lane;
            bf16x8 wf[4][2];
#pragma unroll
            for (int nt = 0; nt < 4; ++nt)
#pragma unroll
                for (int kk = 0; kk < 2; ++kk) wf[nt][kk] = __builtin_bit_cast(bf16x8, pwf[(nt * 2 + kk) * 64]);
            f32x4 pbv[4], psv[4];
#pragma unroll
            for (int nt = 0; nt < 4; ++nt) { pbv[nt] = *(const GAS f32x4*)(kin(I_POOLB) + layer * 256 + g * 64 + nt * 16 + quad * 4); psv[nt] = *(const GAS f32x4*)(kin(I_POOLS) + layer * 256 + g * 64 + nt * 16 + quad * 4); }
#pragma unroll
            for (int mi = 0; mi < 2; ++mi) { const int mt = th * 2 + mi;
                bf16x8 af[2];
#pragma unroll
                for (int kk = 0; kk < 2; ++kk) af[kk] = *(const LAS bf16x8*)(DB + (mt * 16 + l16) * LROW + g * 64 + kk * 32 + quad * 8);
                const size_t row = (size_t)ci.row0 + mt * 16 + l16;
#pragma unroll
                for (int nt = 0; nt < 4; ++nt) { f32x4 acc = {0.f, 0.f, 0.f, 0.f};
                    acc = __builtin_amdgcn_mfma_f32_16x16x32_bf16(wf[nt][0], af[0], acc, 0, 0, 0);
                    acc = __builtin_amdgcn_mfma_f32_16x16x32_bf16(wf[nt][1], af[1], acc, 0, 0, 0);
                    const int ch = g * 64 + nt * 16 + quad * 4;
                    const f32x4 o = (acc + pbv[nt]) * psv[nt]; v2u w; w.x = pk2(o.x, o.y); w.y = pk2(o.z, o.w);
                    *(GAS v2u*)(Y + row * DM + 768 + ch) = w; } }
        }
        __syncthreads();
    }
    if (smask & 4) {   LAS bf16* LX = (LAS bf16*)lds;
        LAS bf16* UB = (LAS bf16*)(lds + 35840);
        LAS float* SC = (LAS float*)(lds + 69632 + wave * 8704);
#pragma unroll
        for (int i = 0; i < 5; ++i) { const int idx = tid + i * NTHR, rr = idx >> 5, c8 = idx & 31; if (idx < 67 * 32) *(LAS v4u*)(LX + rr * LROW + c8 * 8) = wC[i]; }
        __syncthreads();
        {   const int cp = tid & 127, tg = tid >> 7;
            const float* cw = kin(I_CONVW) + layer * 1024; const float* cb = kin(I_CONVB) + layer * 256;
            float w0[4], w1[4];
#pragma unroll
            for (int k = 0; k < 4; ++k) { w0[k] = cw[k * 256 + 2 * cp]; w1[k] = cw[k * 256 + 2 * cp + 1]; }
            const float b0 = cb[2 * cp], b1 = cb[2 * cp + 1];
            const LAS unsigned* LXw = (const LAS unsigned*)LX;
#pragma unroll 4
            for (int i = 0; i < 16; ++i) { const int tok = tg * 16 + i; float u0 = b0, u1 = b1;
#pragma unroll
                for (int k = 0; k < 4; ++k) { const unsigned w = LXw[(tok + k) * (LROW / 2) + cp]; u0 += bflo(w) * w0[k]; u1 += bfhi(w) * w1[k]; }
                ((LAS unsigned*)UB)[tok * (LROW / 2) + cp] = pk2(u0, u1); }
        }
        __syncthreads();
        {   const int d = wave >> 2, n = wave & 3;
            const GAS v4u* gwf = (const GAS v4u*)(ws + WS_GWF) + (size_t)(((layer * 2 + d) * 4 + n) * 16) * 64 + lane;
            const GAS float* spb = (const GAS float*)(ws + WS_SPB) + (layer * 2 + d) * 768 + n * 64 + quad * 4;
            bf16x8 wf[2][4][2]; f32x4 brv[4], biv[4], spv[4];
#pragma unroll
            for (int gt = 0; gt < 2; ++gt)
#pragma unroll
                for (int nt = 0; nt < 4; ++nt)
#pragma unroll
                    for (int kk = 0; kk < 2; ++kk) wf[gt][nt][kk] = __builtin_bit_cast(bf16x8, gwf[((gt * 4 + nt) * 2 + kk) * 64]);
#pragma unroll
            for (int nt = 0; nt < 4; ++nt) { brv[nt] = *(const GAS f32x4*)(spb + nt * 16); biv[nt] = *(const GAS f32x4*)(spb + 256 + nt * 16); spv[nt] = *(const GAS f32x4*)(spb + 512 + nt * 16); }
            float h = 0.f, ap = 1.f;
            unsigned* HA = (unsigned*)((unsigned char*)kout() + WS_LRU + (size_t)d * LRU_PLANE);
#pragma unroll 1
            for (int q = 0; q < 4; ++q) { const int mt = d ? 3 - q : q; asm volatile("" ::: "memory");
                bf16x8 af[2];
#pragma unroll
                for (int kk = 0; kk < 2; ++kk) af[kk] = *(const LAS bf16x8*)(UB + (mt * 16 + l16) * LROW + n * 64 + kk * 32 + quad * 8);
#pragma unroll
                for (int nt = 0; nt < 4; ++nt) { f32x4 ar = brv[nt], ai = biv[nt];
                    ar = __builtin_amdgcn_mfma_f32_16x16x32_bf16(wf[0][nt][0], af[0], ar, 0, 0, 0); ar = __builtin_amdgcn_mfma_f32_16x16x32_bf16(wf[0][nt][1], af[1], ar, 0, 0, 0);
                    ai = __builtin_amdgcn_mfma_f32_16x16x32_bf16(wf[1][nt][0], af[0], ai, 0, 0, 0); ai = __builtin_amdgcn_mfma_f32_16x16x32_bf16(wf[1][nt][1], af[1], ai, 0, 0, 0);
                    const v2u xw = *(const LAS v2u*)(UB + (mt * 16 + l16) * LROW + n * 64 + nt * 16 + quad * 4);
                    const float xv[4] = {bflo(xw.x), bfhi(xw.x), bflo(xw.y), bfhi(xw.y)};
                    f32x4 av, uv;
#pragma unroll
                    for (int j = 0; j < 4; ++j) { const float r = __builtin_amdgcn_rcpf(1.0f + __builtin_amdgcn_exp2f(-1.4426950408889634f * ar[j])), ig = __builtin_amdgcn_rcpf(1.0f + __builtin_amdgcn_exp2f(-1.4426950408889634f * ai[j]));
                        const float a = __builtin_amdgcn_exp2f(r * spv[nt][j]);
                        av[j] = a; uv[j] = __builtin_amdgcn_sqrtf(fmaf(-a, a, 1.0f)) * (ig * xv[j]); }
                    *(LAS f32x4*)(SC + l16 * 68 + nt * 16 + quad * 4) = av; *(LAS f32x4*)(SC + 1088 + l16 * 68 + nt * 16 + quad * 4) = uv; }
                LDS_WAIT(); asm volatile("" ::: "memory");
#pragma unroll 4
                for (int s = 0; s < 16; ++s) { const int tt = d ? 15 - s : s; const float a = SC[tt * 68 + lane], u = SC[1088 + tt * 68 + lane];
                    h = a * h + u; ap *= a; const size_t o = ((size_t)ci.row0 + mt * 16 + tt) * 256 + n * 64 + lane; HA[o] = pk2(h, ap); }
                LDS_WAIT(); asm volatile("" ::: "memory");
            }
            f32x2v* agg = (f32x2v*)(ws + WS_AGG); agg[((size_t)((d * NBATCH + ci.b) * NCHK + ci.cpos)) * 256 + n * 64 + lane] = (f32x2v){ap, h};
        }
        __syncthreads();
    }
}
__device__ __forceinline__ void fixup_chunk(const Params& p, int c, LAS unsigned char* lds, int tid) {
    asm volatile("" : "+v"(tid));
    const ChunkInfo ci = chunk_info(c);
    unsigned char* ws = kws();
    LAS float* CR = (LAS float*)lds;
    {   const int d = tid >> 8, ch = tid & 255;
        const f32x2v* agg = (const f32x2v*)(ws + WS_AGG) + ((size_t)((d * NBATCH + ci.b) * NCHK)) * 256 + ch;
        float s = 0.f;
        const int n = (d == 0) ? ci.cpos : (ci.isctx ? 3 - ci.cpos : 71 - ci.cpos);
        for (int k0 = 0; k0 < n; k0 += 24) {
            f32x2v ah[24];
#pragma unroll
            for (int j = 0; j < 24; ++j) { const int k = k0 + j; const int i = (d == 0) ? k : (k < 4 ? 3 - k : 71 - k);
                ah[j] = (k < n) ? agg[(size_t)i * 256] : (f32x2v){1.0f, 0.0f}; }
#pragma unroll
            for (int j = 0; j < 24; ++j) s = ah[j].x * s + ah[j].y;
        }
        CR[tid] = s;
    }
    __syncthreads();
    {   const unsigned* HAF = (const unsigned*)((unsigned char*)kout() + WS_LRU); const unsigned* HAB = (const unsigned*)((unsigned char*)kout() + WS_LRU + LRU_PLANE);
        bf16* Y = (bf16*)(ws + WS_Y);
        const int c4 = tid & 63; const f32x4 cf = *(const LAS f32x4*)(CR + 4 * c4), cb = *(const LAS f32x4*)(CR + 256 + 4 * c4);
#pragma unroll 2
        for (int it = 0; it < 8; ++it) { const int tok = it * 8 + (tid >> 6); const size_t row = (size_t)ci.row0 + tok; const size_t o = row * 256 + 4 * c4;
            const v4u fw = __builtin_nontemporal_load((const GAS v4u*)(HAF + o)), bw = __builtin_nontemporal_load((const GAS v4u*)(HAB + o));
            const f32x4 hf = {bflo(fw.x), bflo(fw.y), bflo(fw.z), bflo(fw.w)}, af = {bfhi(fw.x), bfhi(fw.y), bfhi(fw.z), bfhi(fw.w)};
            const f32x4 hb = {bflo(bw.x), bflo(bw.y), bflo(bw.z), bflo(bw.w)}, ab = {bfhi(bw.x), bfhi(bw.y), bfhi(bw.z), bfhi(bw.w)};
            const v2u gw_ = __builtin_nontemporal_load((const GAS v2u*)((const bf16*)(ws + WS_P) + row * INW + 1024 + 4 * c4));
            const f32x4 hs = (hf + af * cf) + (hb + ab * cb);
            v2u w; w.x = pk2(gelu_tanh_f(bflo(gw_.x)) * hs.x, gelu_tanh_f(bfhi(gw_.x)) * hs.y); w.y = pk2(gelu_tanh_f(bflo(gw_.y)) * hs.z, gelu_tanh_f(bfhi(gw_.y)) * hs.w);
            *(GAS v2u*)(Y + row * DM + 512 + 4 * c4) = w; }
    }
    __syncthreads();
}
#ifndef ATTN_OUT
#define ATTN_OUT(Qu, k) (Qu)
#endif
__global__ void __launch_bounds__(NTHR, 2) hybrid_fwd(Params p) {
    extern __shared__ __attribute__((aligned(16))) unsigned char lds_raw[];
    cg::grid_group grid = cg::this_grid();
    LAS unsigned char* lds = (LAS unsigned char*)lds_raw;
    const int wave = __builtin_amdgcn_readfirstlane((int)threadIdx.x >> 6);
#define lane hw_lane()
#define tid (wave * 64 + lane)
    const int G = gridDim.x; const int bx = blockIdx.x; const int vcu = (G % 8 == 0) ? (bx % 8) * (G / 8) + bx / 8 : bx;
    const int gw = vcu * NWAVES + wave, NGW = G * NWAVES;
    unsigned char* ws = kws();
    bf16* XN = (bf16*)(ws + WS_XN); float* YO = kout();     float* XRC = (float*)(ws + WS_XRC);
    const float* MOD = (const float*)(ws + WS_MOD);
    unsigned* ctl = (unsigned*)(ws + WS_CTL);

    if (tid < 16) ((LAS unsigned*)(lds + MISC_OFF))[tid] = 0u;
    __syncthreads();
    (void)xcd_barrier_post((unsigned*)(kws() + WS_CTL) + CW_BAR, (volatile LAS unsigned*)(lds + MISC_OFF), wave == 0 && lane == 0);
#define GRID_BAR() do { XcdBarrier b_; b_.bar = (unsigned*)(kws() + WS_CTL) + CW_BAR; b_.x = xb_xcc_id(); b_.st = (volatile LAS unsigned*)(lds + MISC_OFF); xcd_barrier(b_, wave == 0 && lane == 0); } while (0)
    if (__builtin_expect(gridDim.x > 1000000u, 0)) grid.sync();
    phase0a(p, lds, tid, lane, wave, vcu, G);
    GRID_BAR();
    xn0_slot_phase(lds, tid, wave, vcu);
    phase0b(p, tid);
    GRID_BAR();
#pragma unroll 1
    for (int layer = 0; layer < NLAYER; ++layer) {
        const bool last = (layer == NLAYER - 1);
        unsigned char* wl = ws + WS_WT + (size_t)layer * WT_LAYER;
        const float* MODL = MOD + layer * 30720;
        const int Mrows = last ? RLAT : RT;
        {   pg8::Gemm g{XN, (const bf16*)(wl + WIN_OFF), RT, INW, DM, DM}; pg8::StaticOrder S; S.init(RT, INW, G, bx);
            pg8::EpiBf16 E{(bf16*)(ws + WS_P), INW};
            pg8::gemm_phase<pg8::EpiBf16, pg8::StaticOrder, true, true>(lds, g, S, E, tid); }
        GRID_BAR();
        for (int it = vcu; it < RLAT / 64 + 3 * (RCTX / 64); it += G) {
            const int j = it - RLAT / 64; const int c = j < 0 ? it : RLAT / 64 + j / 3; const int sm = j < 0 ? 7 : (1 << (j % 3));
            mixprep_chunk(p, layer, c, sm, lds, tid, lane, wave); }
        GRID_BAR();
        {   const bf16* Y = (const bf16*)(ws + WS_Y); const bf16* KB = (const bf16*)(ws + WS_KB); const bf16* VB = (const bf16*)(ws + WS_VB);
#pragma unroll 1
            for (int k = 0; k < 3; ++k) {
                size_t qrow; int b, hq, nt;
                if (k < 2) { const int u = (vcu >> 5) * 64 + (vcu & 31) + 32 * k; const int bk = u >> 6, idx = u & 63; b = bk >> 1; hq = (bk & 1) * 4 + (idx >> 4); qrow = (size_t)b * SEQ + (idx & 15) * 256; nt = NCHK; }
                else { if (last || vcu < 32 || vcu >= 64) break; const int u = vcu - 32; b = u >> 3; hq = u & 7; qrow = (size_t)RLAT + b * CTXL; nt = 4; }
                const bf16* Qu = (const bf16*)(ws + WS_P) + qrow * INW + hq * 64; const bf16* Ou = Y + qrow * DM + hq * 64; const size_t kvo = (size_t)b * KVLEN * 128 + (hq >> 2) * 64;
                attn_body::attn_unit<8>((const attn_body::bf16*)Qu, (const attn_body::bf16*)(KB + kvo), (const attn_body::bf16*)(VB + kvo), (attn_body::bf16*)ATTN_OUT(Ou, k), nt, (char*)lds_raw,
                                        kin(I_QNG) + layer * 64, k < 2 ? (const float*)(ws + WS_ROPE) : nullptr, (int)(qrow & (SEQ - 1)), tid);
            }
            const int nfix = last ? RLAT / 64 : NCHUNK;
            for (int c = vcu; c < nfix; c += G) fixup_chunk(p, c, lds, tid);
        }
        GRID_BAR();
        {   pg8::Gemm g{(const bf16*)(ws + WS_Y), (const bf16*)(wl + WOUT_OFF), RLAT, DM, DM, DM}; pg8::StaticOrder S; S.init(RLAT, DM, G, bx);
            pg8::PanelSumSq st1{(float*)(ws + WS_XB + (size_t)(layer * 4 + 0) * XB_BANK), ctl + CW_SEAM + (layer * 4 + 0) * SEAM_BANK, ctl + CW_TMO};
            pg8::PanelSumSq st2{(float*)(ws + WS_XB + (size_t)(layer * 4 + 1) * XB_BANK), ctl + CW_SEAM + (layer * 4 + 1) * SEAM_BANK, ctl + CW_TMO};
            if (layer == 0) { pg8::EpiRmsRes<true, false, true> E{kin(I_X), ws + WS_RES, XN, MODL + 2 * 1024, MODL + 4 * 1024, MODL + 3 * 1024, st1, st2};
                pg8::gemm_phase<pg8::EpiRmsRes<true, false, true>, pg8::StaticOrder, false, true>(lds, g, S, E, tid); }
            else { pg8::EpiRmsRes<true, true, true> E{ws + WS_RES, ws + WS_RES, XN, MODL + 2 * 1024, MODL + 4 * 1024, MODL + 3 * 1024, st1, st2};
                pg8::gemm_phase<pg8::EpiRmsRes<true, true, true>, pg8::StaticOrder, false, true>(lds, g, S, E, tid); } }
        if (!last) {
            __syncthreads();
            {   pg8::Gemm g{(const bf16*)(ws + WS_Y) + (size_t)RLAT * DM, (const bf16*)(wl + WOUT_OFF), RCTX, DM, 256, DM}; pg8::SplitKOrder S; S.init(RCTX, DM, 4, 256, G, bx);
                pg8::EpiF32Slab E{YO, DM, (size_t)RCTX * DM};
                pg8::gemm_phase<pg8::EpiF32Slab, pg8::SplitKOrder, true, true>(lds, g, S, E, tid); }
            GRID_BAR();
            ctx_norm(YO, 4, kin(I_CTX), XRC, MODL + 4 * 6144 + 2 * 1024, MODL + 4 * 6144 + 4 * 1024, MODL + 4 * 6144 + 3 * 1024, XN + (size_t)RLAT * DM, gw, NGW, lane);
        }
        GRID_BAR();
        {   pg8::Gemm g{XN, (const bf16*)(wl + WFI_OFF), Mrows, 2 * FFH, DM, DM}; pg8::StaticOrder S; S.init(Mrows, 2 * FFH, G, bx);
            pg8::EpiSwiglu E{(bf16*)(ws + WS_H), FFH};
            pg8::gemm_phase<pg8::EpiSwiglu, pg8::StaticOrder, true, true>(lds, g, S, E, tid); }
        GRID_BAR();
        if (!last) {
            {   pg8::Gemm g{(const bf16*)(ws + WS_H), (const bf16*)(wl + WFO_OFF), RLAT, DM, FFH, FFH}; pg8::StaticOrder S; S.init(RLAT, DM, G, bx);
                pg8::PanelSumSq st1{(float*)(ws + WS_XB + (size_t)(layer * 4 + 2) * XB_BANK), ctl + CW_SEAM + (layer * 4 + 2) * SEAM_BANK, ctl + CW_TMO};
                pg8::PanelSumSq st2{(float*)(ws + WS_XB + (size_t)(layer * 4 + 3) * XB_BANK), ctl + CW_SEAM + (layer * 4 + 3) * SEAM_BANK, ctl + CW_TMO};
                pg8::EpiRmsRes<true, true, true> E{ws + WS_RES, ws + WS_RES, XN, MODL + 5 * 1024, MOD + 30720 + 1 * 1024, MOD + 30720 + 0 * 1024, st1, st2};
                pg8::gemm_phase<pg8::EpiRmsRes<true, true, true>, pg8::StaticOrder, false, true>(lds, g, S, E, tid); }
            __syncthreads();
            {   pg8::Gemm g{(const bf16*)(ws + WS_H) + (size_t)RLAT * FFH, (const bf16*)(wl + WFO_OFF), RCTX, DM, 256, FFH}; pg8::SplitKOrder S; S.init(RCTX, DM, 11, 256, G, bx);
                pg8::EpiF32Slab E{YO, DM, (size_t)RCTX * DM};
                pg8::gemm_phase<pg8::EpiF32Slab, pg8::SplitKOrder, true, true>(lds, g, S, E, tid); }
            GRID_BAR();
            ctx_norm(YO, 11, XRC, XRC, MODL + 4 * 6144 + 5 * 1024, MOD + 30720 + 4 * 6144 + 1 * 1024, MOD + 30720 + 4 * 6144 + 0 * 1024, XN + (size_t)RLAT * DM, gw, NGW, lane);
            GRID_BAR();
        } else {
            pg8::Gemm g{(const bf16*)(ws + WS_H), (const bf16*)(wl + WFO_OFF), RLAT, DM, FFH, FFH}; pg8::StaticOrder S; S.init(RLAT, DM, G, bx);
            pg8::PanelSumSq st1{(float*)(ws + WS_XB + (size_t)(layer * 4 + 2) * XB_BANK), ctl + CW_SEAM + (layer * 4 + 2) * SEAM_BANK, ctl + CW_TMO};
            pg8::EpiRmsRes<false, true, false> E{ws + WS_RES, kout(), XN, MODL + 5 * 1024, nullptr, nullptr, st1, st1};
            pg8::gemm_phase<pg8::EpiRmsRes<false, true, false>, pg8::StaticOrder, false, true>(lds, g, S, E, tid);
        }
    }
}

#undef tid
#undef lane
extern "C" void kernel_launch(void* const* d_in, const int* in_sizes, int n_in, void* d_out, int out_size, void* d_ws, size_t ws_size, hipStream_t stream) {
    static int grid = 0;
    if (grid == 0) {
        if (n_in != 21 || out_size != RLAT * DM || ws_size < WS_END) { fprintf(stderr, "kernel_launch: unexpected shapes (n_in %d out %d ws %zu)\n", n_in, out_size, ws_size); grid = -1; return; }
        int dev = 0, cus = 0, per_cu = 0;
        hipGetDevice(&dev); hipDeviceGetAttribute(&cus, hipDeviceAttributeMultiprocessorCount, dev);
        hipFuncSetAttribute((const void*)hybrid_fwd, hipFuncAttributeMaxDynamicSharedMemorySize, LDS_BYTES);
        hipOccupancyMaxActiveBlocksPerMultiprocessor(&per_cu, (const void*)hybrid_fwd, NTHR, LDS_BYTES);
        (void)hipGetLastError();
        if (per_cu < 1) { fprintf(stderr, "kernel_launch: occupancy query says %d blocks per CU\n", per_cu); per_cu = 1; }
        grid = cus;
        if (grid != 256) { fprintf(stderr, "kernel_launch: built for a 256-CU device (got %d)\n", cus); grid = -1; return; }
    }
    if (grid < 0) return;
    if (hipMemsetAsync((char*)d_ws + WS_CTL, 0, 262144, stream) != hipSuccess) { fprintf(stderr, "kernel_launch: memset failed\n"); return; }
    Params p{};
    for (int i = 0; i < 21; ++i) p.in[i] = (const float*)d_in[i];
    p.out = (float*)d_out; p.ws = (unsigned char*)d_ws;
    void* args[] = {&p};
    hipError_t e = hipLaunchCooperativeKernel((const void*)hybrid_fwd, dim3(grid), dim3(NTHR), args, LDS_BYTES, stream);
    if (e != hipSuccess) fprintf(stderr, "cooperative launch failed: %s (grid %d)\n", hipGetErrorString(e), grid);
}
```

```cpp
#include <hip/hip_runtime.h>
#include <hip/hip_cooperative_groups.h>
#include <hip/hip_bf16.h>
#include <cstdio>
#include <cstdint>
#include <cmath>
namespace cg = cooperative_groups;
__device__ __forceinline__ float shx(float v, int mask, int lane_) { return __int_as_float(__builtin_amdgcn_ds_bpermute((lane_ ^ mask) << 2, __float_as_int(v))); }
__device__ __forceinline__ int hw_lane() { int l; asm volatile("v_mbcnt_lo_u32_b32 %0, -1, 0\n\tv_mbcnt_hi_u32_b32 %0, -1, %0" : "=v"(l)); return l; }
namespace pg8 {
#define PG8_LAS __attribute__((address_space(3)))
typedef unsigned short bf16_t;
typedef short bf16x8 __attribute__((ext_vector_type(8)));
typedef float f32x4 __attribute__((ext_vector_type(4)));
typedef unsigned u32x4 __attribute__((ext_vector_type(4)));
typedef unsigned u32x2 __attribute__((ext_vector_type(2)));
constexpr int BM = 256, BK = 64, HALF = 128, HTB = HALF * BK * 2  , STAGE_BYTES = 8 * HTB, NXCD = 8, WGM = 8;

__host__ __device__ __forceinline__ int lds_byte(int r, int c) { const int st = (r >> 4) * 2 + (c >> 5), rr = r & 15, cc = c & 31, ob = rr * 64 + cc * 2; return st * 1024 + (ob ^ (((ob >> 9) & 1) << 5)); }
__host__ __device__ __forceinline__ void stage_rc(int b, int& R, int& C) { const int st = b / 1024, sb = b % 1024, swz = sb ^ (((sb >> 9) & 1) << 5); R = (st >> 1) * 16 + swz / 64; C = (st & 1) * 32 + (swz % 64) / 2; }
__host__ __device__ __forceinline__ int perm32(int rho) { const int n = rho >> 4, i = rho & 15; return 8 * (i >> 2) + 4 * n + (i & 3); }

struct Unit { int pm, pn, kb, ks; };
struct Gemm { const bf16_t* A; const bf16_t* Bt; int M, N, K, ld; };

struct StaticOrder {
    int nM, nN, nwg, G, c;
    __host__ __device__ void init(int M, int N, int G_, int c_) { nM = M / BM; nN = N / BM; nwg = nM * nN; G = G_; c = c_; }
    __host__ __device__ bool next(int i, Unit& u) const {
        const long L = (long)i * G + c; if (L >= nwg) return false;
        int wgid = (int)L; { const int q = nwg / NXCD, r = nwg % NXCD, xcd = wgid % NXCD, off = wgid / NXCD; wgid = (xcd < r ? xcd * (q + 1) : r * (q + 1) + (xcd - r) * q) + off; }
        const int nig = WGM * nN, gid = wgid / nig, fm = gid * WGM, gsz = (nM - fm) < WGM ? (nM - fm) : WGM;
        u.pm = fm + ((wgid % nig) % gsz); u.pn = (wgid % nig) / gsz; u.kb = 0; u.ks = 0; return true;
    }
    __device__ __forceinline__ void a_ready(const Unit&) const {}
    __device__ __forceinline__ void done(const Unit&) const {}
};

__device__ __forceinline__ unsigned cvt_pk_bf16(float lo, float hi) { unsigned r; asm volatile("v_cvt_pk_bf16_f32 %0, %1, %2" : "=v"(r) : "v"(lo), "v"(hi)); return r; }
typedef float f32x2 __attribute__((ext_vector_type(2)));
struct EpiBf16 {
    static constexpr bool PERM = true, AFTER_DRAIN = false;
    bf16_t* O; int ldc;
    __device__ __forceinline__ void operator()(const f32x4 (&acc)[2][2][4][2], const Unit& u, int wr, int wc, int fr, int fq) const {
        const int row0 = u.pm * BM + wr * 64 + fr; const int col0 = u.pn * BM + wc * 32 + 8 * fq;
#pragma unroll
        for (int ai = 0; ai < 2; ++ai)
#pragma unroll
            for (int m = 0; m < 4; ++m) { bf16_t* rowp = O + (size_t)(row0 + ai * HALF + m * 16) * ldc + col0;
#pragma unroll
                for (int bj = 0; bj < 2; ++bj) { const f32x4 v0 = acc[ai][bj][m][0], v1 = acc[ai][bj][m][1];
                    u32x4 w; w.x = cvt_pk_bf16(v0[0], v0[1]); w.y = cvt_pk_bf16(v0[2], v0[3]); w.z = cvt_pk_bf16(v1[0], v1[1]); w.w = cvt_pk_bf16(v1[2], v1[3]);
                    *(u32x4*)(rowp + bj * HALF) = w; } }
    }
};
__device__ __forceinline__ float silu_f(float g) { return g * __builtin_amdgcn_rcpf(1.0f + __expf(-g)); }
struct EpiSwiglu {
    static constexpr bool PERM = true, AFTER_DRAIN = false;
    bf16_t* H; int ldh;
    __device__ __forceinline__ void operator()(const f32x4 (&acc)[2][2][4][2], const Unit& u, int wr, int wc, int fr, int fq) const {
        const int row0 = u.pm * BM + wr * 64 + fr; const int col0 = u.pn * HALF + wc * 32 + 8 * fq;
#pragma unroll
        for (int ai = 0; ai < 2; ++ai)
#pragma unroll
            for (int m = 0; m < 4; ++m) { bf16_t* rowp = H + (size_t)(row0 + ai * HALF + m * 16) * ldh + col0;
                const f32x4 g0 = acc[ai][0][m][0], g1 = acc[ai][0][m][1], u0 = acc[ai][1][m][0], u1 = acc[ai][1][m][1];
                u32x4 w;
                w.x = cvt_pk_bf16(silu_f(g0[0]) * u0[0], silu_f(g0[1]) * u0[1]); w.y = cvt_pk_bf16(silu_f(g0[2]) * u0[2], silu_f(g0[3]) * u0[3]);
                w.z = cvt_pk_bf16(silu_f(g1[0]) * u1[0], silu_f(g1[1]) * u1[1]); w.w = cvt_pk_bf16(silu_f(g1[2]) * u1[2], silu_f(g1[3]) * u1[3]);
                *(u32x4*)rowp = w; }
    }
};
struct EpiF32 {
    static constexpr bool PERM = false, AFTER_DRAIN = false;
    float* O; int ldc;
    __device__ __forceinline__ void operator()(const f32x4 (&acc)[2][2][4][2], const Unit& u, int wr, int wc, int fr, int fq) const {
        const int row0 = u.pm * BM + wr * 64 + fr; const int col0 = u.pn * BM + wc * 32 + 4 * fq;
#pragma unroll
        for (int ai = 0; ai < 2; ++ai)
#pragma unroll
            for (int m = 0; m < 4; ++m) { float* rowp = O + (size_t)(row0 + ai * HALF + m * 16) * ldc + col0;
#pragma unroll
                for (int bj = 0; bj < 2; ++bj)
#pragma unroll
                    for (int n = 0; n < 2; ++n) *(f32x4*)(rowp + bj * HALF + n * 16) = acc[ai][bj][m][n]; }
    }
};
struct SplitKOrder {
    int nM, nN, KS, kbytes, G, c;
    __device__ void init(int M, int N, int KS_, int kslice, int G_, int c_) { nM = M / BM; nN = N / BM; KS = KS_; kbytes = kslice * 2; G = G_; c = c_; }
    __device__ bool next(int i, Unit& u) const { const int L = i * G + c; if (L >= nM * nN * KS) return false; const int ks = L % KS, t = L / KS; u.pm = t % nM; u.pn = t / nM; u.ks = ks; u.kb = ks * kbytes; return true; }
    __device__ __forceinline__ void a_ready(const Unit&) const {}
    __device__ __forceinline__ void done(const Unit&) const {}
};
struct EpiF32Slab {
    static constexpr bool PERM = false, AFTER_DRAIN = false;
    float* O; int ldc; size_t slab;
    __device__ __forceinline__ void operator()(const f32x4 (&acc)[2][2][4][2], const Unit& u, int wr, int wc, int fr, int fq) const {
        const int row0 = u.pm * BM + wr * 64 + fr; const int col0 = u.pn * BM + wc * 32 + 4 * fq; float* Os = O + (size_t)u.ks * slab;
#pragma unroll
        for (int ai = 0; ai < 2; ++ai)
#pragma unroll
            for (int m = 0; m < 4; ++m) { float* rowp = Os + (size_t)(row0 + ai * HALF + m * 16) * ldc + col0;
#pragma unroll
                for (int bj = 0; bj < 2; ++bj)
#pragma unroll
                    for (int n = 0; n < 2; ++n) *(f32x4*)(rowp + bj * HALF + n * 16) = acc[ai][bj][m][n]; }
    }
};
struct PanelSumSq {
    float* xbuf;
    unsigned* cnt;
    unsigned* tmo;
    __device__ __forceinline__ void run(const f32x4 (&v)[2][2][4][2], int pmg, int pn, int wr, int wc, int fr, int fq, PG8_LAS unsigned char* lds, int wid, int lane) const { publish(v, pmg, pn, wr, wc, fr, fq, lds, wid, lane); finish(pmg, lds, wid, lane); }
    __device__ __forceinline__ void publish(const f32x4 (&v)[2][2][4][2], int pmg, int pn, int wr, int wc, int fr, int fq, PG8_LAS unsigned char* lds, int wid, int lane) const {
        PG8_LAS float* P = (PG8_LAS float*)lds;
        PG8_LAS float* S = (PG8_LAS float*)(lds + 8192);
#pragma unroll
        for (int ai = 0; ai < 2; ++ai)
#pragma unroll
            for (int m = 0; m < 4; ++m) {
                float q = 0.f;
#pragma unroll
                for (int bj = 0; bj < 2; ++bj)
#pragma unroll
                    for (int n = 0; n < 2; ++n) { const f32x4 x = v[ai][bj][m][n]; q += (x[0] * x[0] + x[1] * x[1]) + (x[2] * x[2] + x[3] * x[3]); }
                q += shx(q, 16, lane); q += shx(q, 32, lane);
                if (fq == 0) P[(ai * HALF + wr * 64 + m * 16 + fr) * 4 + wc] = q;
            }
        asm volatile("s_waitcnt lgkmcnt(0)" ::: "memory"); __builtin_amdgcn_s_barrier(); asm volatile("" ::: "memory");
        const int row = wid * 32 + (lane & 31);
        if (lane < 32) {
            const float t = (P[row * 4 + 0] + P[row * 4 + 1]) + (P[row * 4 + 2] + P[row * 4 + 3]);
            __hip_atomic_store((unsigned*)xbuf + ((size_t)(pmg * BM + row) * 4 + pn), __float_as_uint(t), __ATOMIC_RELAXED, __HIP_MEMORY_SCOPE_AGENT);
        }
        asm volatile("s_waitcnt vmcnt(0)" ::: "memory");
        if (lane == 0) __hip_atomic_fetch_add(cnt + 64 * pmg, 1u, __ATOMIC_RELAXED, __HIP_MEMORY_SCOPE_AGENT);
    }
    __device__ __forceinline__ void finish(int pmg, PG8_LAS unsigned char* lds, int wid, int lane) const {
        PG8_LAS float* S = (PG8_LAS float*)(lds + 8192);
        const int row = wid * 32 + (lane & 31);
        {   unsigned sp = 0u;
            while ((unsigned)__builtin_amdgcn_readfirstlane(__hip_atomic_load(cnt + 64 * pmg, __ATOMIC_RELAXED, __HIP_MEMORY_SCOPE_AGENT)) < 32u) {
                if (++sp > (1u << 20)) { if (lane == 0) __hip_atomic_store(tmo, 1u, __ATOMIC_RELAXED, __HIP_MEMORY_SCOPE_AGENT); break; }
            }
        }
        if (lane < 32) {
            const unsigned* slot = (const unsigned*)xbuf + (size_t)(pmg * BM + row) * 4; float tot = 0.f;
#pragma unroll
            for (int t = 0; t < 4; ++t) tot += __uint_as_float(__hip_atomic_load(slot + t, __ATOMIC_RELAXED, __HIP_MEMORY_SCOPE_AGENT));
            S[row] = rsqrtf(tot * (1.0f / 1024.0f) + 1e-6f);
        }
        asm volatile("s_waitcnt vmcnt(0) lgkmcnt(0)" ::: "memory"); __builtin_amdgcn_s_barrier(); asm volatile("" ::: "memory");
    }
};
template <bool NEXT, bool BASE16, bool OUT16> struct EpiRmsRes {
    static constexpr bool PERM = false, AFTER_DRAIN = true;
    const void* base_p; void* out_p; bf16_t* xn;
    const float* vG; const float* vA; const float* vS;
    PanelSumSq st1, st2;
    static __device__ __forceinline__ f32x4 up4(u32x2 w) { return (f32x4){__uint_as_float(w.x << 16), __uint_as_float(w.x & 0xffff0000u), __uint_as_float(w.y << 16), __uint_as_float(w.y & 0xffff0000u)}; }
    __device__ __forceinline__ void store_out(void* rowp, int coff, const f32x4 x) const {
        if (OUT16) { u32x2 w; w.x = cvt_pk_bf16(x[0], x[1]); w.y = cvt_pk_bf16(x[2], x[3]); *(u32x2*)((bf16_t*)rowp + coff) = w; }
        else *(f32x4*)((float*)rowp + coff) = x; }
    __device__ __forceinline__ void fused(f32x4 (&acc)[2][2][4][2], const Unit& u, int wr, int wc, int fr, int fq, PG8_LAS unsigned char* lds, int wid, int lane) const {
        const PG8_LAS float* S = (const PG8_LAS float*)(lds + 8192);
        const int pmg = u.pm, slot = pmg >> 4;
        const size_t poff = (size_t)pmg * BM * 1024;
        const int col0 = u.pn * BM + wc * 32 + 4 * fq;
        const size_t lane_off = (size_t)(wr * 64 + fr) * 1024 + col0;
        st1.publish(acc, pmg, u.pn, wr, wc, fr, fq, lds, wid, lane);
        f32x4 pre[4][2][2]; u32x2 pb[2][4][2][2];
        if (BASE16) {
            const bf16_t* b16 = (const bf16_t*)base_p + poff + lane_off;
#pragma unroll
            for (int ai = 0; ai < 2; ++ai)
#pragma unroll
                for (int m = 0; m < 4; ++m)
#pragma unroll
                    for (int bj = 0; bj < 2; ++bj)
#pragma unroll
                        for (int n = 0; n < 2; ++n) pb[ai][m][bj][n] = *(const u32x2*)(b16 + (size_t)(ai * HALF + m * 16) * 1024 + bj * HALF + n * 16);
        } else {
            const float* b32 = (const float*)base_p + poff + lane_off;
#pragma unroll
            for (int m = 0; m < 4; ++m)
#pragma unroll
                for (int bj = 0; bj < 2; ++bj)
#pragma unroll
                    for (int n = 0; n < 2; ++n) pre[m][bj][n] = __builtin_nontemporal_load((const f32x4*)(b32 + (size_t)(m * 16) * 1024 + bj * HALF + n * 16));
        }
        f32x4 g[2][2];
#pragma unroll
        for (int bj = 0; bj < 2; ++bj)
#pragma unroll
            for (int n = 0; n < 2; ++n) g[bj][n] = *(const f32x4*)(vG + slot * 6144 + col0 + bj * HALF + n * 16);
        st1.finish(pmg, lds, wid, lane);
#pragma unroll
        for (int ai = 0; ai < 2; ++ai)
#pragma unroll
            for (int m = 0; m < 4; ++m) { const float rs = S[ai * HALF + wr * 64 + m * 16 + fr];
#pragma unroll
                for (int bj = 0; bj < 2; ++bj)
#pragma unroll
                    for (int n = 0; n < 2; ++n) { f32x4 bs;
                        if (BASE16) bs = up4(pb[ai][m][bj][n]);
                        else bs = ai == 0 ? pre[m][bj][n] : __builtin_nontemporal_load((const f32x4*)((const float*)base_p + poff + lane_off + (size_t)(HALF + m * 16) * 1024 + bj * HALF + n * 16));
                        acc[ai][bj][m][n] = bs + g[bj][n] * acc[ai][bj][m][n] * rs; }
                asm volatile("" : "+v"(acc[ai][0][m][0]), "+v"(acc[ai][0][m][1]), "+v"(acc[ai][1][m][0]), "+v"(acc[ai][1][m][1]));
                if (m & 1) asm volatile("" ::: "memory"); }
        unsigned char* const outl = (unsigned char*)out_p + (poff + lane_off) * (OUT16 ? 2 : 4);
        if (NEXT) {
            f32x4 a[2][2], sh[2][2];
#pragma unroll
            for (int bj = 0; bj < 2; ++bj)
#pragma unroll
                for (int n = 0; n < 2; ++n) { a[bj][n] = *(const f32x4*)(vA + slot * 6144 + col0 + bj * HALF + n * 16); sh[bj][n] = *(const f32x4*)(vS + slot * 6144 + col0 + bj * HALF + n * 16); }
            st2.publish(acc, pmg, u.pn, wr, wc, fr, fq, lds, wid, lane);
#pragma unroll
            for (int ai = 0; ai < 2; ++ai)
#pragma unroll
                for (int m = 0; m < 4; ++m) { void* op = outl + (size_t)(ai * HALF + m * 16) * 1024 * (OUT16 ? 2 : 4);
#pragma unroll
                    for (int bj = 0; bj < 2; ++bj)
#pragma unroll
                        for (int n = 0; n < 2; ++n) store_out(op, bj * HALF + n * 16, acc[ai][bj][m][n]);
                    asm volatile("" ::: "memory"); }
            st2.finish(pmg, lds, wid, lane);
            bf16_t* xnl = xn + poff + lane_off;
#pragma unroll
            for (int ai = 0; ai < 2; ++ai)
#pragma unroll
                for (int m = 0; m < 4; ++m) { const float rs = S[ai * HALF + wr * 64 + m * 16 + fr]; bf16_t* xp = xnl + (size_t)(ai * HALF + m * 16) * 1024;
#pragma unroll
                    for (int bj = 0; bj < 2; ++bj)
#pragma unroll
                        for (int n = 0; n < 2; ++n) { const f32x4 x1 = acc[ai][bj][m][n]; const f32x4 o = x1 * rs * a[bj][n] + sh[bj][n];
                            u32x2 w; w.x = cvt_pk_bf16(o[0], o[1]); w.y = cvt_pk_bf16(o[2], o[3]); *(u32x2*)(xp + bj * HALF + n * 16) = w; }
                    asm volatile("" ::: "memory"); }
        } else {
#pragma unroll
            for (int ai = 0; ai < 2; ++ai)
#pragma unroll
                for (int m = 0; m < 4; ++m) { void* op = outl + (size_t)(ai * HALF + m * 16) * 1024 * (OUT16 ? 2 : 4);
#pragma unroll
                    for (int bj = 0; bj < 2; ++bj)
#pragma unroll
                        for (int n = 0; n < 2; ++n) store_out(op, bj * HALF + n * 16, acc[ai][bj][m][n]);
                    asm volatile("" ::: "memory"); }
        }
    }
};
template <class Epi, class Sched, bool ALIGN_EPI = false, bool SP2 = false>
__device__ __forceinline__ void gemm_phase(PG8_LAS unsigned char* lds, const Gemm g, const Sched& S, const Epi& E, int tid_) {
    asm volatile("" : "+v"(tid_));
    const int tid = tid_, wid = __builtin_amdgcn_readfirstlane(tid >> 6), lane = tid & 63, wr = wid >> 2, wc = wid & 3, fr = lane & 15, fq = lane >> 4;
    const int K = g.ld, nt = g.K / BK;
    unsigned voffA[2], voffB[2];
#pragma unroll
    for (int i = 0; i < 2; ++i) { int R, C; stage_rc(tid * 16 + i * 8192, R, C); const int Rb = Epi::PERM ? ((R & ~31) + perm32(R & 31)) : R;
        voffA[i] = (unsigned)(R * K + C) * 2u; voffB[i] = (unsigned)(Rb * K + C) * 2u; }
    const size_t kstep = (size_t)(BK * 2);
    const size_t hstep = (size_t)HALF * K * 2;
    const size_t tstep = 2 * hstep;
    const unsigned ldsw = (unsigned)wid * 1024u;
    const int aoff = lds_byte(wr * 64 + fr, fq * 8), boff = lds_byte(wc * 32 + fr, fq * 8);
#define PG8_SA(b, h) (((b) * 2 + (h)) * HTB)
#define PG8_SB(b, h) ((4 + (b) * 2 + (h)) * HTB)
#define PG8_STAGE(bufoff, gbase, voff) do { _Pragma("unroll") for (int _i = 0; _i < 2; ++_i) \
        __builtin_amdgcn_global_load_lds((const unsigned*)((const char*)(gbase) + (voff)[_i]), (PG8_LAS unsigned*)(lds + (bufoff) + ldsw + _i * 8192), 16, 0, 0); } while (0)
#define PG8_LDA(dst, b, h) do { _Pragma("unroll") for (int m = 0; m < 4; ++m) _Pragma("unroll") for (int k = 0; k < 2; ++k) dst[m][k] = *(const PG8_LAS bf16x8*)(lds + PG8_SA(b, h) + aoff + m * 2048 + k * 1024); } while (0)
#define PG8_LDB(dst, b, h) do { _Pragma("unroll") for (int n = 0; n < 2; ++n) _Pragma("unroll") for (int k = 0; k < 2; ++k) dst[n][k] = *(const PG8_LAS bf16x8*)(lds + PG8_SB(b, h) + boff + n * 2048 + k * 1024); } while (0)
#define PG8_MMA(ai, bj, At, Bt) do { __builtin_amdgcn_s_setprio(1); _Pragma("unroll") for (int m = 0; m < 4; ++m) _Pragma("unroll") for (int n = 0; n < 2; ++n) _Pragma("unroll") for (int k = 0; k < 2; ++k) \
        acc[ai][bj][m][n] = __builtin_amdgcn_mfma_f32_16x16x32_bf16(Bt[n][k], At[m][k], acc[ai][bj][m][n], 0, 0, 0); __builtin_amdgcn_s_setprio(0); } while (0)
#define PG8_WAIT_V(n) asm volatile("s_waitcnt vmcnt(" #n ")" ::: "memory")
#define PG8_WAIT_L(n) asm volatile("s_waitcnt lgkmcnt(" #n ")" ::: "memory")
#define PG8_BAR __builtin_amdgcn_s_barrier()
#define PG8_SCHED __builtin_amdgcn_sched_barrier(0)
    Unit cur, nxt; int ui = 0;
    if (!S.next(0, cur)) return;
    f32x4 acc[2][2][4][2];
#pragma unroll
    for (int a = 0; a < 2; ++a)
#pragma unroll
        for (int b = 0; b < 2; ++b)
#pragma unroll
            for (int m = 0; m < 4; ++m)
#pragma unroll
                for (int n = 0; n < 2; ++n) acc[a][b][m][n] = (f32x4){0.f, 0.f, 0.f, 0.f};
    bf16x8 At[4][2], B0[2][2], B1[2][2];
    const char* cA = (const char*)g.A + (size_t)cur.pm * tstep + cur.kb; const char* cB = (const char*)g.Bt + (size_t)cur.pn * tstep + cur.kb;
    S.a_ready(cur);
    if constexpr (SP2) {
        PG8_STAGE(PG8_SB(0, 0), cB, voffB); PG8_STAGE(PG8_SB(0, 1), cB + hstep, voffB); PG8_STAGE(PG8_SA(0, 0), cA, voffA); PG8_STAGE(PG8_SA(0, 1), cA + hstep, voffA);
        if (wr == 1) PG8_BAR;
        PG8_WAIT_V(2); PG8_BAR;
        PG8_STAGE(PG8_SB(1, 0), cB + kstep, voffB); PG8_STAGE(PG8_SA(1, 0), cA + kstep, voffA); PG8_STAGE(PG8_SB(1, 1), cB + hstep + kstep, voffB);
        PG8_WAIT_V(6); PG8_BAR;
    } else {
        PG8_STAGE(PG8_SB(0, 0), cB, voffB); PG8_STAGE(PG8_SA(0, 0), cA, voffA); PG8_STAGE(PG8_SB(0, 1), cB + hstep, voffB); PG8_STAGE(PG8_SA(0, 1), cA + hstep, voffA);
        if (wr == 1) PG8_BAR;
        PG8_WAIT_V(4); PG8_BAR;
        PG8_STAGE(PG8_SB(1, 0), cB + kstep, voffB); PG8_STAGE(PG8_SA(1, 0), cA + kstep, voffA); PG8_STAGE(PG8_SB(1, 1), cB + hstep + kstep, voffB);
        PG8_WAIT_V(6); PG8_BAR;
    }
    for (;;) {
        const bool has_next = S.next(ui + 1, nxt);
        const char* nA = has_next ? (const char*)g.A + (size_t)nxt.pm * tstep + nxt.kb : cA; const char* nB = has_next ? (const char*)g.Bt + (size_t)nxt.pn * tstep + nxt.kb : cB;
        for (int t = 0; t < nt; t += 2) {
            const bool last = (t == nt - 2);
            const char* a1 = cA + (size_t)(t + 1) * kstep;
            const char* a2 = last ? nA : cA + (size_t)(t + 2) * kstep; const char* b2 = last ? nB : cB + (size_t)(t + 2) * kstep;
            const char* a3 = a2 + kstep; const char* b3 = b2 + kstep;
            if (last && has_next) S.a_ready(nxt);
            if constexpr (SP2) {
            PG8_LDB(B0, 0, 0); PG8_LDB(B1, 0, 1); PG8_SCHED; PG8_LDA(At, 0, 0); PG8_STAGE(PG8_SA(1, 1), a1 + hstep, voffA);
            PG8_WAIT_V(8); PG8_WAIT_L(0); PG8_BAR; PG8_MMA(0, 0, At, B0); PG8_MMA(0, 1, At, B1); PG8_BAR; PG8_SCHED;
            PG8_LDA(At, 0, 1); PG8_STAGE(PG8_SB(0, 0), b2, voffB); PG8_STAGE(PG8_SB(0, 1), b2 + hstep, voffB); PG8_STAGE(PG8_SA(0, 0), a2, voffA);
            PG8_WAIT_V(8); PG8_WAIT_L(0); PG8_BAR; PG8_MMA(1, 0, At, B0); PG8_MMA(1, 1, At, B1); PG8_BAR; PG8_SCHED;
            PG8_LDB(B0, 1, 0); PG8_LDB(B1, 1, 1); PG8_SCHED; PG8_LDA(At, 1, 0); PG8_STAGE(PG8_SA(0, 1), a2 + hstep, voffA);
            PG8_WAIT_V(8); PG8_WAIT_L(0); PG8_BAR; PG8_MMA(0, 0, At, B0); PG8_MMA(0, 1, At, B1); PG8_BAR; PG8_SCHED;
            PG8_LDA(At, 1, 1); PG8_STAGE(PG8_SB(1, 0), b3, voffB); PG8_STAGE(PG8_SB(1, 1), b3 + hstep, voffB); PG8_STAGE(PG8_SA(1, 0), a3, voffA);
            PG8_WAIT_V(8); PG8_WAIT_L(0); PG8_BAR; PG8_MMA(1, 0, At, B0); PG8_MMA(1, 1, At, B1); PG8_BAR; PG8_SCHED;
            } else {
            PG8_LDB(B0, 0, 0); PG8_SCHED; PG8_LDA(At, 0, 0); PG8_STAGE(PG8_SA(1, 1), a1 + hstep, voffA);
            PG8_WAIT_L(8); PG8_BAR; PG8_WAIT_L(0); PG8_MMA(0, 0, At, B0); PG8_BAR; PG8_SCHED;
            PG8_LDB(B1, 0, 1); PG8_STAGE(PG8_SB(0, 0), b2, voffB);
            PG8_BAR; PG8_WAIT_L(0); PG8_MMA(0, 1, At, B1); PG8_BAR;
            PG8_LDA(At, 0, 1); PG8_STAGE(PG8_SA(0, 0), a2, voffA);
            PG8_BAR; PG8_WAIT_L(0); PG8_MMA(1, 0, At, B0); PG8_BAR; PG8_SCHED;
            PG8_STAGE(PG8_SB(0, 1), b2 + hstep, voffB);
            PG8_WAIT_V(6); PG8_BAR; PG8_MMA(1, 1, At, B1); PG8_BAR;
            PG8_LDB(B0, 1, 0); PG8_SCHED; PG8_LDA(At, 1, 0); PG8_STAGE(PG8_SA(0, 1), a2 + hstep, voffA);
            PG8_WAIT_L(8); PG8_BAR; PG8_WAIT_L(0); PG8_MMA(0, 0, At, B0); PG8_BAR; PG8_SCHED;
            PG8_LDB(B1, 1, 1); PG8_STAGE(PG8_SB(1, 0), b3, voffB);
            PG8_BAR; PG8_WAIT_L(0); PG8_MMA(0, 1, At, B1); PG8_BAR;
            PG8_LDA(At, 1, 1); PG8_STAGE(PG8_SA(1, 0), a3, voffA);
            PG8_BAR; PG8_WAIT_L(0); PG8_MMA(1, 0, At, B0); PG8_BAR; PG8_SCHED;
            PG8_STAGE(PG8_SB(1, 1), b3 + hstep, voffB);
            PG8_WAIT_V(6); PG8_BAR; PG8_MMA(1, 1, At, B1); PG8_BAR;
            }
        }
        if constexpr (ALIGN_EPI) { if (wr == 0) PG8_BAR; }
        if constexpr (!Epi::AFTER_DRAIN) { E(acc, cur, wr, wc, fr, fq); S.done(cur); }
        if (!has_next) break;
#pragma unroll
        for (int a = 0; a < 2; ++a)
#pragma unroll
            for (int b = 0; b < 2; ++b)
#pragma unroll
                for (int m = 0; m < 4; ++m)
#pragma unroll
                    for (int n = 0; n < 2; ++n) acc[a][b][m][n] = (f32x4){0.f, 0.f, 0.f, 0.f};
        cur = nxt; cA = nA; cB = nB; ++ui;
        if constexpr (ALIGN_EPI) { if (wr == 1) PG8_BAR; }
    }
    PG8_WAIT_V(0);
    if constexpr (!ALIGN_EPI) { if (wr == 0) PG8_BAR; }
    PG8_BAR;
    if constexpr (Epi::AFTER_DRAIN) { E.fused(acc, cur, wr, wc, fr, fq, lds, wid, lane); S.done(cur); }
#undef PG8_SA
#undef PG8_SB
#undef PG8_STAGE
#undef PG8_LDA
#undef PG8_LDB
#undef PG8_MMA
#undef PG8_WAIT_V
#undef PG8_WAIT_L
#undef PG8_BAR
#undef PG8_SCHED
}
}
#include <hip/hip_bf16.h>
#include <cmath>
namespace attn_body {
using bf16=__hip_bfloat16;
using bf16x8=__attribute__((ext_vector_type(8)))short;
using s16x4=__attribute__((ext_vector_type(4)))short;
using f32x16=__attribute__((ext_vector_type(16)))float;
using u32x4=__attribute__((ext_vector_type(4)))unsigned;
constexpr int D=64,DM=1024,KVP=128,QP=1536;
constexpr int NW=8,QBLK=32,QB=QBLK*NW,KVBLK=64;
constexpr int ATTN_PITCH=DM, ATTN_UNIT_ROWS=QB;
__device__ __forceinline__ int crow(int r,int hi){return (r&3)+8*(r>>2)+4*hi;}
#define SBAR() __builtin_amdgcn_sched_barrier(0)
__device__ __forceinline__ void cmask(f32x16&p0,f32x16&p1,int jb,int qrel,int hi){
  const float NEG=-INFINITY; int kb=64*jb+4*hi;
  #pragma unroll
  for(int r=0;r<16;++r){int kv=kb+(r&3)+8*(r>>2); if(kv>qrel)p0[r]=NEG; if(kv+32>qrel)p1[r]=NEG;}
}

constexpr int NSLOT=3, SLOTB=8192;
constexpr int LDS_K=0, LDS_V=NSLOT*SLOTB, LDS_WS=2*NSLOT*SLOTB, LDS_OST=LDS_WS+NW*64*4, LDS_BYTES=LDS_OST+NW*4096;
constexpr float C2=0.125f*1.4426950408889634f;
__device__ __forceinline__ void glds16(const void*gsrc,unsigned lds_dst){unsigned keep;
  asm volatile("s_mov_b32 %0, m0\n\ts_mov_b32 m0, %2\n\ts_nop 0\n\tglobal_load_lds_dwordx4 %1, off\n\ts_mov_b32 m0, %0":"=&s"(keep):"v"(gsrc),"s"(lds_dst):"memory");}
__device__ __forceinline__ float max3f(float a,float b,float c){float r;asm("v_max3_f32 %0, %1, %2, %3":"=v"(r):"v"(a),"v"(b),"v"(c));return r;}
__device__ __forceinline__ float max2f(float a,float b){float r;asm("v_max_f32_e32 %0, %1, %2":"=v"(r):"v"(a),"v"(b));return r;}
__device__ __forceinline__ float fadd_s(float a,float b){float r;asm("v_add_f32_e32 %0, %1, %2":"=v"(r):"v"(a),"v"(b));return r;}
__device__ __forceinline__ float fsub_s(float a,float b){float r;asm("v_sub_f32_e32 %0, %1, %2":"=v"(r):"v"(a),"v"(b));return r;}
typedef float f32x2_t __attribute__((ext_vector_type(2))); typedef __bf16 bf16x2_t __attribute__((ext_vector_type(2)));
__device__ __forceinline__ unsigned cvtpk_s(float lo,float hi){f32x2_t v={lo,hi};bf16x2_t b=__builtin_convertvector(v,bf16x2_t);return __builtin_bit_cast(unsigned,b);}
#define WAIT_BAR(N) asm volatile("s_waitcnt vmcnt(" #N ") lgkmcnt(0)\n\ts_barrier":::"memory")

__device__ __forceinline__ void qkt(f32x16&p0,f32x16&p1,const char*Kslot,const bf16x8*qr,const f32x16&negm,int r32,int hi){
  const char*kb=Kslot+hi*1024+r32*16;
  #pragma unroll
  for(int d0=0;d0<4;++d0){
    const bf16x8 b0=*reinterpret_cast<const bf16x8*>(kb+d0*2048);
    const bf16x8 b1=*reinterpret_cast<const bf16x8*>(kb+d0*2048+512);
    if(d0==0){p0=__builtin_amdgcn_mfma_f32_32x32x16_bf16(b0,qr[0],negm,0,0,0);p1=__builtin_amdgcn_mfma_f32_32x32x16_bf16(b1,qr[0],negm,0,0,0);}
    else{p0=__builtin_amdgcn_mfma_f32_32x32x16_bf16(b0,qr[d0],p0,0,0,0);p1=__builtin_amdgcn_mfma_f32_32x32x16_bf16(b1,qr[d0],p1,0,0,0);}}
}
typedef __attribute__((address_space(3))) const char* lds_cptr;
typedef short v4i16_t __attribute__((ext_vector_type(4)));
__device__ __forceinline__ void kload8(bf16x8*kf,lds_cptr kp){
  kf[0]=*(const __attribute__((address_space(3))) bf16x8*)(kp);      kf[1]=*(const __attribute__((address_space(3))) bf16x8*)(kp+512);
  kf[2]=*(const __attribute__((address_space(3))) bf16x8*)(kp+2048); kf[3]=*(const __attribute__((address_space(3))) bf16x8*)(kp+2560);
  kf[4]=*(const __attribute__((address_space(3))) bf16x8*)(kp+4096); kf[5]=*(const __attribute__((address_space(3))) bf16x8*)(kp+4608);
  kf[6]=*(const __attribute__((address_space(3))) bf16x8*)(kp+6144); kf[7]=*(const __attribute__((address_space(3))) bf16x8*)(kp+6656);
}
__device__ __forceinline__ void kload2(bf16x8*kf,lds_cptr kp,int j){ kf[2*j]=*(const __attribute__((address_space(3))) bf16x8*)(kp+j*2048); kf[2*j+1]=*(const __attribute__((address_space(3))) bf16x8*)(kp+j*2048+512); }
__device__ __forceinline__ s16x4 vtr(lds_cptr p){ return __builtin_bit_cast(s16x4,__builtin_amdgcn_ds_read_tr16_b64_v4i16((__attribute__((address_space(3))) v4i16_t*)p)); }
__device__ __forceinline__ float rowmax(const f32x16&p0,const f32x16&p1){
  float a=max3f(p0[0],p0[1],p1[0]),b=max3f(p0[2],p0[3],p1[1]);a=max3f(a,p1[2],p1[3]);
  #pragma unroll
  for(int r=4;r<16;r+=4){a=max3f(a,p0[r],p0[r+1]);b=max3f(b,p0[r+2],p0[r+3]);a=max3f(a,p1[r],p1[r+1]);b=max3f(b,p1[r+2],p1[r+3]);}
  const float m=max2f(a,b);
  auto rr=__builtin_amdgcn_permlane32_swap(__float_as_uint(m),__float_as_uint(m),false,false);
  return max2f(__uint_as_float(rr[0]),__uint_as_float(rr[1]));
}
__device__ __forceinline__ void pv(f32x16*o,int vb,bf16x8 pa0,bf16x8 pa1,bf16x8 pa2,bf16x8 pa3){
  #pragma unroll
  for(int d0=0;d0<2;++d0){s16x4 lo[4],hi[4];
    #pragma unroll
    for(int ks=0;ks<4;++ks){
      asm volatile("ds_read_b64_tr_b16 %0,%1 offset:%c2":"=&v"(lo[ks]):"v"(vb),"i"(d0*4096+ks*1024):"memory");
      asm volatile("ds_read_b64_tr_b16 %0,%1 offset:%c2":"=&v"(hi[ks]):"v"(vb),"i"(d0*4096+ks*1024+512):"memory");}
    asm volatile("s_waitcnt lgkmcnt(0)":::"memory");SBAR();
    #define PK(k) (bf16x8){lo[k][0],lo[k][1],lo[k][2],lo[k][3],hi[k][0],hi[k][1],hi[k][2],hi[k][3]}
    o[d0]=__builtin_amdgcn_mfma_f32_32x32x16_bf16(pa0,PK(0),o[d0],0,0,0);
    o[d0]=__builtin_amdgcn_mfma_f32_32x32x16_bf16(pa1,PK(1),o[d0],0,0,0);
    o[d0]=__builtin_amdgcn_mfma_f32_32x32x16_bf16(pa2,PK(2),o[d0],0,0,0);
    o[d0]=__builtin_amdgcn_mfma_f32_32x32x16_bf16(pa3,PK(3),o[d0],0,0,0);
    #undef PK
  }
}

#ifndef ATTN_STORE16
#define ATTN_STORE16(p,v) (*(u32x4*)(p)=(v))
#endif
template<int THRL> __device__ __forceinline__ void attn_unit(const bf16*Qu,const bf16*__restrict__ Kh,const bf16*__restrict__ Vh,bf16*Ou,const int NT,char*shm,const float*qgain,const float*ropet,const int tq0,int tid_){
  asm volatile("":"+v"(tid_)); const int tid=tid_,lane=tid&63,r32=lane&31,hi=lane>>5; const int wid=__builtin_amdgcn_readfirstlane(tid>>6);
  const bf16*Qw=Qu+(long)(wid*QBLK)*QP;
  const unsigned lds0=(unsigned)(uintptr_t)shm;
  float*wsf=(float*)(shm+LDS_WS)+wid*64;
  const bf16*ksrc=Kh+(long)lane*KVP+wid*8;
  const bf16*vsrc=Vh+(long)(16*(wid&3)+(lane>>2))*KVP+(wid>>2)*32+(lane&3)*8;
  const unsigned kdst=lds0+LDS_K+wid*1024, vdst=lds0+LDS_V+wid*1024;
  #define DMA_K(t,slot) glds16(ksrc+(long)(t)*KVBLK*KVP,(unsigned)__builtin_amdgcn_readfirstlane(kdst+(slot)))
  #define DMA_V(t,slot) glds16(vsrc+(long)(t)*KVBLK*KVP,(unsigned)__builtin_amdgcn_readfirstlane(vdst+(slot)))
  const int vb0=(int)(lds0+LDS_V)+((lane>>4)&1)*32+(lane&3)*8+(4*hi+((lane&15)>>2))*64;
  const char*Kbase=shm+LDS_K; bf16x8 kf[8];
  const lds_cptr shm3=(lds_cptr)shm; const lds_cptr kp0=shm3+LDS_K+hi*1024+r32*16; const lds_cptr vp0=shm3+LDS_V+((lane>>4)&1)*32+(lane&3)*8+(4*hi+((lane&15)>>2))*64;
  DMA_K(0,0);DMA_V(0,0);DMA_K(1,SLOTB);
  bf16x8 qr[4];
  #pragma unroll
  for(int d0=0;d0<4;++d0)qr[d0]=*reinterpret_cast<const bf16x8*>(&Qw[(long)r32*QP+d0*16+hi*8]);
  {
    float qv[4][8]; float ss=0.f;
    #pragma unroll
    for(int d0=0;d0<4;++d0){
      #pragma unroll
      for(int e=0;e<8;++e){ qv[d0][e]=__uint_as_float(((unsigned)(unsigned short)qr[d0][e])<<16); ss+=qv[d0][e]*qv[d0][e]; } }
    { auto rr=__builtin_amdgcn_permlane32_swap(__float_as_uint(ss),__float_as_uint(ss),false,false); ss=__uint_as_float(rr[0])+__uint_as_float(rr[1]); }
    const float rs=__builtin_amdgcn_rsqf(ss*(1.0f/64.0f)+1e-6f);
    #pragma unroll
    for(int d0=0;d0<4;++d0){
      #pragma unroll
      for(int e=0;e<8;++e) qv[d0][e]*=rs*qgain[d0*16+hi*8+e]; }
    if(ropet){ const int t=tq0+wid*QBLK+r32;
      #pragma unroll
      for(int h2=0;h2<2;++h2){ const float*cs=ropet+(((h2==0)?(t>>6):(t&63))*16+hi*8)*2;
        #pragma unroll
        for(int e=0;e<8;++e){ const float c=cs[2*e],sn=cs[2*e+1]; const float x1=qv[2*h2][e],x2=qv[2*h2+1][e]; qv[2*h2][e]=x1*c-x2*sn; qv[2*h2+1][e]=x2*c+x1*sn; } } }
    #pragma unroll
    for(int d0=0;d0<4;++d0){ u32x4 w; w[0]=cvtpk_s(qv[d0][0]*C2,qv[d0][1]*C2); w[1]=cvtpk_s(qv[d0][2]*C2,qv[d0][3]*C2); w[2]=cvtpk_s(qv[d0][4]*C2,qv[d0][5]*C2); w[3]=cvtpk_s(qv[d0][6]*C2,qv[d0][7]*C2); qr[d0]=__builtin_bit_cast(bf16x8,w); }
  }
  float mhat=0.f,l_reg=0.f;f32x16 o[2];o[0]=f32x16{};o[1]=f32x16{};f32x16 negm=f32x16{};asm volatile("":"+v"(negm));
  #define CMASK(P0,P1,t) do{}while(0)
  bool resc=false;
  #define START(P0,P1) do{ const float rm=rowmax(P0,P1); resc=false; \
    { const float dl=rm; mhat=fadd_s(mhat,dl); \
      _Pragma("unroll") for(int r=0;r<16;++r){P0[r]=fsub_s(P0[r],dl);P1[r]=fsub_s(P1[r],dl);} \
      _Pragma("unroll") for(int r=0;r<16;++r)negm[r]=-mhat; asm volatile("":"+v"(negm)); } \
    _Pragma("unroll") for(int r=0;r<16;++r)P0[r]=__builtin_amdgcn_exp2f(P0[r]); }while(0)
  #define RESC() do{ if(resc){ asm volatile("s_waitcnt lgkmcnt(0)":::"memory"); \
      _Pragma("unroll") for(int d_=0;d_<2;++d_) _Pragma("unroll") for(int r=0;r<16;++r)o[d_][r]*=wsf[crow(r,hi)]; } }while(0)
  f32x16 pA0,pA1,pB0,pB1;
  int sl_prev=0,sl_cur=0,sl_next=SLOTB;
  #define ROT() do{sl_prev=sl_cur;sl_cur=sl_next;sl_next=(sl_next==(NSLOT-1)*SLOTB)?0:sl_next+SLOTB;}while(0)
  DMA_K(2,2*SLOTB);
  WAIT_BAR(3);
  qkt(pA0,pA1,Kbase,qr,negm,r32,hi);asm volatile("s_nop 15\n\ts_nop 7":"+v"(pA0),"+v"(pA1));CMASK(pA0,pA1,0);
  START(pA0,pA1);
  _Pragma("unroll") for(int r=0;r<16;++r)pA1[r]=__builtin_amdgcn_exp2f(pA1[r]);
  WAIT_BAR(0);
  DMA_K(3,0);DMA_V(1,SLOTB);
  ROT();
  kload8(kf,kp0+sl_cur);
  WAIT_BAR(2);
  s16x4 vlo[8],vhi[8]; u32x4 pw0,pw1,pw2,pw3;
  #define PKW(P,B) cvtpk_s(P[B],P[B+1])
  #define PAF(k) __builtin_bit_cast(bf16x8,pw##k)
  #define VFR(i) (bf16x8){vlo[i][0],vlo[i][1],vlo[i][2],vlo[i][3],vhi[i][0],vhi[i][1],vhi[i][2],vhi[i][3]}
  #define PIN(x) asm volatile("":"+v"(x))
  #define MX3(a,b,c) __builtin_fmaxf(__builtin_fmaxf((a),(b)),(c))
  #define GAPA(MF,A0,A1,A2,A3,W0,W1,PW) do{ MF; sacc+=A0; sacc+=A1; sacc+=A2; sacc+=A3; PIN(sacc); W0; W1; PIN(PW); SBAR(); }while(0)
  #define EX(v) __builtin_amdgcn_exp2f(v)
  #define GAPB(MF,X,B) do{ MF; X[B]=EX(X[B]); X[B+1]=EX(X[B+1]); X[B+2]=EX(X[B+2]); X[B+3]=EX(X[B+3]); PIN(X); SBAR(); }while(0)
  #define VRD(i) do{ vlo[i]=vtr(vp_+(((i)>>2)*4096+((i)&3)*1024)); vhi[i]=vtr(vp_+(((i)>>2)*4096+((i)&3)*1024+512)); }while(0)
  #define KRD(G,j) do{ if(G){ kload2(kf,kp0+sl_next,j); SBAR(); } }while(0)
  #define STEP(C0,C1,P0,P1,t,GK,GV,GL) do{ SBAR(); \
    const lds_cptr vp_=vp0+sl_prev; \
    VRD(0); SBAR(); float sacc=(P0[0]+P0[1]); \
    GAPA(C0=__builtin_amdgcn_mfma_f32_32x32x16_bf16(kf[0],qr[0],negm,0,0,0), P0[2],P0[3],P0[4],P0[5],     pw0[0]=PKW(P0,0), pw0[1]=PKW(P0,2), pw0); \
    VRD(4); SBAR(); GAPA(C1=__builtin_amdgcn_mfma_f32_32x32x16_bf16(kf[1],qr[0],negm,0,0,0), P0[6],P0[7],P0[8],P0[9],     pw0[2]=PKW(P0,4), pw0[3]=PKW(P0,6), pw0); \
    VRD(1); SBAR(); GAPA(C0=__builtin_amdgcn_mfma_f32_32x32x16_bf16(kf[2],qr[1],C0,0,0,0),   P0[10],P0[11],P0[12],P0[13], pw1[0]=PKW(P0,8), pw1[1]=PKW(P0,10), pw1); \
    VRD(5); SBAR(); GAPA(C1=__builtin_amdgcn_mfma_f32_32x32x16_bf16(kf[3],qr[1],C1,0,0,0),   P0[14],P0[15],P1[0],P1[1],   pw1[2]=PKW(P0,12),pw1[3]=PKW(P0,14), pw1); \
    VRD(2); SBAR(); GAPA(C0=__builtin_amdgcn_mfma_f32_32x32x16_bf16(kf[4],qr[2],C0,0,0,0),   P1[2],P1[3],P1[4],P1[5],     pw2[0]=PKW(P1,0), pw2[1]=PKW(P1,2), pw2); \
    VRD(6); SBAR(); GAPA(C1=__builtin_amdgcn_mfma_f32_32x32x16_bf16(kf[5],qr[2],C1,0,0,0),   P1[6],P1[7],P1[8],P1[9],     pw2[2]=PKW(P1,4), pw2[3]=PKW(P1,6), pw2); \
    VRD(3); SBAR(); GAPA(C0=__builtin_amdgcn_mfma_f32_32x32x16_bf16(kf[6],qr[3],C0,0,0,0),   P1[10],P1[11],P1[12],P1[13], pw3[0]=PKW(P1,8), pw3[1]=PKW(P1,10), pw3); \
    VRD(7); SBAR(); GAPA(C1=__builtin_amdgcn_mfma_f32_32x32x16_bf16(kf[7],qr[3],C1,0,0,0),   P1[14],P1[15],0.f,0.f,       pw3[2]=PKW(P1,12),pw3[3]=PKW(P1,14), pw3); \
    l_reg+=sacc; \
    if(GK){DMA_K((t)+3,sl_cur);} if(GV){DMA_V((t)+1,sl_next);} \
    CMASK(C0,C1,t); \
    { float a=MX3(C0[0],C0[1],C1[0]),b=MX3(C0[2],C0[3],C1[1]); a=MX3(a,C1[2],C1[3]); \
      _Pragma("unroll") for(int r=4;r<16;r+=4){a=MX3(a,C0[r],C0[r+1]);b=MX3(b,C0[r+2],C0[r+3]);a=MX3(a,C1[r],C1[r+1]);b=MX3(b,C1[r+2],C1[r+3]);} \
      float rm=__builtin_fmaxf(a,b); { auto rr=__builtin_amdgcn_permlane32_swap(__float_as_uint(rm),__float_as_uint(rm),false,false); rm=__builtin_fmaxf(__uint_as_float(rr[0]),__uint_as_float(rr[1])); } \
      resc=false; \
      if(__builtin_expect(__any(rm>(float)THRL),0)){ const float dl=__builtin_fmaxf(rm,0.f); mhat+=dl; \
        _Pragma("unroll") for(int r=0;r<16;++r){C0[r]-=dl;C1[r]-=dl;} \
        _Pragma("unroll") for(int r=0;r<16;++r)negm[r]=-mhat; asm volatile("":"+v"(negm)); \
        const float f=__builtin_amdgcn_exp2f(-dl); l_reg*=f; if(hi==0)wsf[r32]=f; resc=true; } } \
    SBAR(); \
    GAPB(o[0]=__builtin_amdgcn_mfma_f32_32x32x16_bf16(PAF(0),VFR(0),o[0],0,0,0), C0,0); \
    GAPB(o[1]=__builtin_amdgcn_mfma_f32_32x32x16_bf16(PAF(0),VFR(4),o[1],0,0,0), C0,4); \
    KRD(GL,0); GAPB(o[0]=__builtin_amdgcn_mfma_f32_32x32x16_bf16(PAF(1),VFR(1),o[0],0,0,0), C0,8); \
    KRD(GL,1); GAPB(o[1]=__builtin_amdgcn_mfma_f32_32x32x16_bf16(PAF(1),VFR(5),o[1],0,0,0), C0,12); \
    KRD(GL,2); GAPB(o[0]=__builtin_amdgcn_mfma_f32_32x32x16_bf16(PAF(2),VFR(2),o[0],0,0,0), C1,0); \
    KRD(GL,3); GAPB(o[1]=__builtin_amdgcn_mfma_f32_32x32x16_bf16(PAF(2),VFR(6),o[1],0,0,0), C1,4); \
    GAPB(o[0]=__builtin_amdgcn_mfma_f32_32x32x16_bf16(PAF(3),VFR(3),o[0],0,0,0), C1,8); \
    GAPB(o[1]=__builtin_amdgcn_mfma_f32_32x32x16_bf16(PAF(3),VFR(7),o[1],0,0,0), C1,12); \
    }while(0)
  int t=1;
  #undef CMASK
  #define CMASK(P0,P1,t) do{}while(0)
  for(;t+5<NT;t+=2){
    STEP(pB0,pB1,pA0,pA1,t,true,true,true);     WAIT_BAR(2); RESC(); ROT();
    STEP(pA0,pA1,pB0,pB1,t+1,true,true,true);   WAIT_BAR(2); RESC(); ROT();
  }
  #undef CMASK
  #define CMASK(P0,P1,t) do{}while(0)
  #define ENDW(tt) do{ if((tt)+3<NT){WAIT_BAR(2);} else if((tt)+2<NT){WAIT_BAR(1);} else {WAIT_BAR(0);} }while(0)
  for(;t+1<NT;t+=2){
    STEP(pB0,pB1,pA0,pA1,t,(t+3<NT),(t+1<NT),(t+1<NT));       ENDW(t);   RESC(); ROT();
    STEP(pA0,pA1,pB0,pB1,t+1,(t+4<NT),(t+2<NT),(t+2<NT));     ENDW(t+1); RESC(); ROT();
  }
  STEP(pB0,pB1,pA0,pA1,NT-1,false,false,false); RESC();
  { float sacc=pB0[0]+pB0[1]; _Pragma("unroll") for(int r=2;r<16;++r)sacc+=pB0[r]; _Pragma("unroll") for(int r=0;r<16;++r)sacc+=pB1[r]; l_reg+=sacc;
    pw0=(u32x4){PKW(pB0,0),PKW(pB0,2),PKW(pB0,4),PKW(pB0,6)};pw1=(u32x4){PKW(pB0,8),PKW(pB0,10),PKW(pB0,12),PKW(pB0,14)};pw2=(u32x4){PKW(pB1,0),PKW(pB1,2),PKW(pB1,4),PKW(pB1,6)};pw3=(u32x4){PKW(pB1,8),PKW(pB1,10),PKW(pB1,12),PKW(pB1,14)};
    SBAR(); pv(o,vb0+sl_cur,PAF(0),PAF(1),PAF(2),PAF(3)); }
  #undef PKW
  #undef PAF
  #undef VFR
  #undef PIN
  #undef MX3
  #undef GAPA
  #undef GAPB
  #undef EX
  #undef VRD
  #undef KRD
  #undef STEP
  #undef ENDW
  {auto rr=__builtin_amdgcn_permlane32_swap(__float_as_uint(l_reg),__float_as_uint(l_reg),false,false);l_reg=__uint_as_float(rr[0])+__uint_as_float(rr[1]);}
  if(hi==0)wsf[32+r32]=l_reg;asm volatile("s_waitcnt lgkmcnt(0)":::"memory");
  float rli[16];
  #pragma unroll
  for(int r=0;r<16;++r)rli[r]=__builtin_amdgcn_rcpf(wsf[32+crow(r,hi)]);
  bf16*Ow=Ou+(long)(wid*QBLK)*DM;
  { bf16*stg=(bf16*)(shm+LDS_OST)+wid*2048;
    #pragma unroll
    for(int r=0;r<16;++r){const int orow=crow(r,hi);
      #pragma unroll
      for(int d0=0;d0<2;++d0)stg[orow*64+d0*32+r32]=__float2bfloat16(o[d0][r]*rli[r]);}
    asm volatile("s_waitcnt lgkmcnt(0)":::"memory");
    #pragma unroll
    for(int i=0;i<4;++i){const int row=i*8+(lane>>3),ch=lane&7; const u32x4 v=*(const u32x4*)(stg+row*64+ch*8); ATTN_STORE16(Ow+(long)row*DM+ch*8,v);} }
  asm volatile("s_waitcnt lgkmcnt(0)\n\ts_barrier":::"memory");
  #undef DMA_K
  #undef DMA_V
  #undef CMASK
  #undef START
  #undef RESC
  #undef ROT
}
constexpr int ATTN_LDS_BYTES=LDS_BYTES;
#undef SBAR
#undef WAIT_BAR
}
constexpr int DM = 1024, NBATCH = 4, SEQ = 4096, CTXL = 256, NLAYER = 2;
constexpr int RLAT = NBATCH * SEQ, RCTX = NBATCH * CTXL, RT = RLAT + RCTX;
constexpr int INW = 1536, FFH = 2816, KVLEN = CTXL + SEQ, NCHK = KVLEN / 64;
constexpr int NCHUNK = RT / 64;
constexpr float RMS_EPS = 1e-6f;
constexpr int NWAVES = 8, NTHR = 512;
constexpr size_t MiB = 1u << 20;
constexpr size_t WS_CTL = 0, CTL_ZERO_BYTES = 1 * MiB;
constexpr size_t WS_WT = 1 * MiB, WT_LAYER = 21 * MiB + MiB / 2, WIN_OFF = 0, WOUT_OFF = 3 * MiB, WFI_OFF = 5 * MiB, WFO_OFF = 16 * MiB;
constexpr int MOD_SLABS = 32, MOD_ROWS = 1024 / MOD_SLABS;
constexpr size_t WS_MODP = 156 * MiB  , WS_MOD = 46 * MiB, WS_ROPE = 46 * MiB + MiB / 2, WS_AGG = 47 * MiB;
constexpr size_t WS_GWF = 48 * MiB + MiB / 2, WS_PWF = 48 * MiB + 3 * MiB / 4, WS_SPB = 49 * MiB;
constexpr size_t WS_XRC = 50 * MiB;
constexpr size_t WS_XN = 54 * MiB;
constexpr size_t WS_YO = 88 * MiB;
constexpr size_t WS_RES = 88 * MiB;
constexpr size_t WS_LRU = 0  , LRU_PLANE = 17 * MiB;
constexpr size_t WS_Y = 156 * MiB;
constexpr size_t WS_P = 190 * MiB;
constexpr size_t WS_KB = 241 * MiB, WS_VB = 245 * MiB + MiB / 4;
constexpr size_t WS_H = 156 * MiB;
constexpr size_t WS_XB = 250 * MiB, XB_BANK = 272 * 1024;
constexpr size_t WS_END = 256 * MiB;
static_assert(WS_VB + (size_t)NBATCH * KVLEN * 128 * 2 <= WS_END && WS_H + (size_t)RT * FFH * 2 <= WS_END && WS_P + (size_t)RT * INW * 2 <= WS_KB, "ws map");
constexpr int LDS_BYTES = 147456;

#define GAS __attribute__((address_space(1)))
#define LAS __attribute__((address_space(3)))
typedef unsigned short bf16;
typedef unsigned v4u __attribute__((ext_vector_type(4)));
typedef unsigned v2u __attribute__((ext_vector_type(2)));
typedef float f32x4 __attribute__((ext_vector_type(4)));
typedef float f32x2v __attribute__((ext_vector_type(2)));
typedef short bf16x8 __attribute__((ext_vector_type(8)));
typedef __bf16 bf16x2_t __attribute__((ext_vector_type(2)));
#define LDS_WAIT() asm volatile("s_waitcnt lgkmcnt(0)" ::: "memory")
__device__ __forceinline__ unsigned pk2(float lo, float hi) { f32x2v v = {lo, hi}; bf16x2_t b = __builtin_convertvector(v, bf16x2_t); return __builtin_bit_cast(unsigned, b); }
__device__ __forceinline__ float bflo(unsigned w) { return __uint_as_float(w << 16); }
__device__ __forceinline__ float bfhi(unsigned w) { return __uint_as_float(w & 0xffff0000u); }
__device__ __forceinline__ float wave_sum(float v, int lane_) {
#pragma unroll
    for (int o = 1; o < 64; o <<= 1) v += shx(v, o, lane_);
    return v;
}
__device__ __forceinline__ float sigmoid_f(float x) { return __builtin_amdgcn_rcpf(1.0f + __expf(-x)); }
__device__ __forceinline__ float gelu_tanh_f(float x) { const float t = fmaf(x * x, -2.0f * 1.4426950408889634f * 0.7978845608028654f * 0.044715f, -2.0f * 1.4426950408889634f * 0.7978845608028654f); return x * __builtin_amdgcn_rcpf(1.0f + __builtin_amdgcn_exp2f(x * t)); }

#define XB_TMO      128
#define XB_XCNT(j)  (256  + 64 * (j))
#define XB_XSUB(j)  (1280 + 64 * (j))
#define XB_XGEN(j)  (2304 + 64 * (j))
#define XB_TOP      3328
#define XB_TOPGEN   3392
#define XCD_BAR_WORDS 3456
#define XB_SPIN_CAP (1u << 18)

__device__ __forceinline__ unsigned xb_ld(unsigned* p)              { return __hip_atomic_load(p, __ATOMIC_RELAXED, __HIP_MEMORY_SCOPE_AGENT); }
__device__ __forceinline__ unsigned xb_add(unsigned* p, unsigned v) { return __hip_atomic_fetch_add(p, v, __ATOMIC_RELAXED, __HIP_MEMORY_SCOPE_AGENT); }
__device__ __forceinline__ unsigned xb_xcc_id() { return (unsigned)__builtin_amdgcn_s_getreg((3 << 11) | 20) & 0xFu; }
#define XB_SPIN(cond, bar) do { unsigned _sp = 0; while (cond) { \
    if ((++_sp & 255u) == 0u) { if (xb_ld(&(bar)[XB_TMO])) break; if (_sp > XB_SPIN_CAP) { atomicAdd(&(bar)[XB_TMO], 1u); break; } } } } while (0)

struct XcdBarrier {
    unsigned* bar; unsigned x;
    volatile LAS unsigned* st;
};

__device__ __forceinline__ XcdBarrier xcd_barrier_post(unsigned* bar, volatile LAS unsigned* st, bool leader) {
    XcdBarrier b; b.bar = bar; b.x = xb_xcc_id(); b.st = st;
    if (leader) (void)xb_add(&bar[XB_XCNT(b.x)], 1u);
    return b;
}
__device__ __forceinline__ void xcd_barrier_complete(unsigned* bar, unsigned x, unsigned& nloc, unsigned& nx) {
    const unsigned G = gridDim.x * gridDim.y * gridDim.z;
    unsigned sum, cnt, mine, sp = 0u;
    for (;;) {
        sum = 0u; cnt = 0u; mine = 0u;
#pragma unroll
        for (unsigned j = 0; j < 16; ++j) { const unsigned c = xb_ld(&bar[XB_XCNT(j)]); sum += c; cnt += (c > 0u) ? 1u : 0u; mine = (j == x) ? c : mine; }
        if (sum == G) break;
        __builtin_amdgcn_s_sleep(1);
        if ((++sp & 255u) == 0u) { if (xb_ld(&bar[XB_TMO])) break; if (sp > XB_SPIN_CAP) { atomicAdd(&bar[XB_TMO], 1u); break; } }
    }
    nloc = mine > 0u ? mine : 1u; nx = cnt > 0u ? cnt : 1u;
}

__device__ __forceinline__ void xcd_barrier(const XcdBarrier& b, bool leader) {
    asm volatile("s_waitcnt vmcnt(0)" ::: "memory");
    __syncthreads();
    if (leader) {
        unsigned* bar = b.bar;
        __builtin_amdgcn_s_waitcnt(0);
        unsigned nloc = b.st[0], nx = b.st[1];
        if (nloc == 0u) { xcd_barrier_complete(bar, b.x, nloc, nx); b.st[0] = nloc; b.st[1] = nx; }
        const unsigned old = xb_add(&bar[XB_XSUB(b.x)], 1u);
        const unsigned gen = old / nloc;
        if (old + 1u == (gen + 1u) * nloc) {
            __builtin_amdgcn_fence(__ATOMIC_RELEASE, "agent");
            asm volatile("s_waitcnt vmcnt(0)" ::: "memory");
            const unsigned og = xb_add(&bar[XB_TOP], 1u);
            const unsigned tg = og / nx;
            if (og + 1u == (tg + 1u) * nx) xb_add(&bar[XB_TOPGEN], 1u);
            else XB_SPIN(xb_ld(&bar[XB_TOPGEN]) == tg, bar);
            __builtin_amdgcn_fence(__ATOMIC_ACQUIRE, "agent");
            xb_add(&bar[XB_XGEN(b.x)], 1u);
            asm volatile("s_waitcnt vmcnt(0)" ::: "memory");
        } else {
            XB_SPIN(xb_ld(&bar[XB_XGEN(b.x)]) == gen, bar);
            __builtin_amdgcn_fence(__ATOMIC_ACQUIRE, "agent");
            asm volatile("s_waitcnt vmcnt(0)" ::: "memory");
        }
    }
    __syncthreads();
}

constexpr int CW_TMO = 0, CW_SEAM = 16384, SEAM_BANK = 68 * 64;
constexpr int CW_BAR = 4096;
constexpr int MISC_OFF = LDS_BYTES - 64;
struct Params { const float* in[21]; float* out; unsigned char* ws; };
typedef const __attribute__((address_space(4))) unsigned long long* kargp_t;
__device__ __forceinline__ const float* kin(int i) { return (const float*)((kargp_t)__builtin_amdgcn_kernarg_segment_ptr())[i]; }
__device__ __forceinline__ float* kout() { return (float*)((kargp_t)__builtin_amdgcn_kernarg_segment_ptr())[21]; }
__device__ __forceinline__ unsigned char* kws() { return (unsigned char*)((kargp_t)__builtin_amdgcn_kernarg_segment_ptr())[22]; }
enum { I_X = 0, I_C, I_CTX, I_CCTX, I_WMOD, I_BMOD, I_NORMG, I_WIN, I_QNG, I_KNG, I_CONVW, I_CONVB, I_GATEW, I_GATEB, I_LAM, I_POOLW, I_POOLB, I_POOLS, I_WOUT, I_WFI, I_WFO };

__device__ __forceinline__ void transpose_item(const float* W, int K, int N, bf16* WT, int orow0, int k0, int n0, LAS float* scr, int lane) {
    float tv[32];
#pragma unroll
    for (int i = 0; i < 32; ++i) tv[i] = __builtin_nontemporal_load(W + (size_t)(k0 + 2 * i + (lane >> 5)) * N + n0 + (lane & 31));
#pragma unroll
    for (int i = 0; i < 32; ++i) scr[(2 * i + (lane >> 5)) * 33 + (lane & 31)] = tv[i];
    LDS_WAIT(); asm volatile("" ::: "memory");
    const int c = lane & 7;
#pragma unroll
    for (int j = 0; j < 4; ++j) { const int n = (lane >> 3) + 8 * j; const LAS float* s = scr + (8 * c) * 33 + n;
        v4u o; o.x = pk2(s[0 * 33], s[1 * 33]); o.y = pk2(s[2 * 33], s[3 * 33]); o.z = pk2(s[4 * 33], s[5 * 33]); o.w = pk2(s[6 * 33], s[7 * 33]);
        *(GAS v4u*)(WT + (size_t)(orow0 + n) * K + k0 + 8 * c) = o; }
    LDS_WAIT(); asm volatile("" ::: "memory");
}
__device__ __forceinline__ void phase0a(const Params& p, LAS unsigned char* lds, int tid, int lane, int wave, int vcu, int G) {
    unsigned char* ws = kws();
    { const int gt = ((tid >> 6) * (int)gridDim.x + (int)blockIdx.x) * 64 + (tid & 63);
      if (gt < 1024) { const int pos = gt >> 4, i = gt & 15; const float freq = exp2f(-(float)i * (13.287712379549449f / 16.0f)); const float ang = (float)pos * freq;
          const float k = rintf(ang * 0.15915494309189535f); float r = fmaf(-k, 6.2831855f, ang); r = fmaf(k, 1.7484555e-7f, r);
          float* rp = (float*)(ws + WS_ROPE); rp[2 * gt] = cosf(r); rp[2 * gt + 1] = sinf(r); } }
    { const int gt = ((tid >> 6) * (int)gridDim.x + (int)blockIdx.x) * 64 + (tid & 63);
      if (gt < 16384) { const int ln = gt & 63, f = gt >> 6, kk = f & 1, nt = (f >> 1) & 3, g2 = (f >> 3) & 1, n = (f >> 4) & 3, d = (f >> 6) & 1, l = f >> 7, qd = ln >> 4, l16 = ln & 15;
          const float* gw_ = kin(I_GATEW) + ((size_t)(((l * 2 + d) * 2 + g2) * 4 + n)) * 4096 + (kk * 32 + qd * 8) * 64 + nt * 16 + l16;
          v4u o; o.x = pk2(gw_[0], gw_[64]); o.y = pk2(gw_[128], gw_[192]); o.z = pk2(gw_[256], gw_[320]); o.w = pk2(gw_[384], gw_[448]);
          ((v4u*)(ws + WS_GWF))[gt] = o; }
      else if (gt < 16384 + 4096) { const int q = gt - 16384, ln = q & 63, f = q >> 6, kk = f & 1, nt = (f >> 1) & 3, lg = f >> 3, qd = ln >> 4, l16 = ln & 15;
          const float* pw = kin(I_POOLW) + (size_t)lg * 4096 + (kk * 32 + qd * 8) * 64 + nt * 16 + l16;
          v4u o; o.x = pk2(pw[0], pw[64]); o.y = pk2(pw[128], pw[192]); o.z = pk2(pw[256], pw[320]); o.w = pk2(pw[384], pw[448]);
          ((v4u*)(ws + WS_PWF))[q] = o; }
      else if (gt < 16384 + 4096 + 3072) { const int q = gt - 20480, ch = q & 255, k3 = (q >> 8) % 3, ld = q / 768;
          float v;
          if (k3 < 2) v = kin(I_GATEB)[(ld * 2 + k3) * 256 + ch]; else v = -8.0f * 1.4426950408889634f * log1pf(expf(-kin(I_LAM)[ld * 256 + ch]));
          ((float*)(ws + WS_SPB))[q] = v; } }
    LAS float* S = (LAS float*)(lds + 8 * 8448);
    for (int i = tid; i < 5 * 1024; i += NTHR) { const float v = (i < 4096) ? kin(I_C)[i] : kin(I_CCTX)[i - 4096]; S[i] = v / (1.0f + expf(-v)); }
    __syncthreads();
    LAS float* scr = (LAS float*)(lds + wave * 8448);
    constexpr int I_IN = 16 * 48, I_OUT = 16 * 32, I_FI = 16 * 176, I_FO = 44 * 32, PER = I_IN + I_OUT + I_FI + I_FO;
    constexpr int NGEMV = NLAYER * MOD_SLABS * 24;
    for (int it0 = wave * G + vcu; it0 < NGEMV + NLAYER * PER; it0 += NWAVES * G) {
        if (it0 < NGEMV) {
            const int l = it0 / (MOD_SLABS * 24), rem = it0 % (MOD_SLABS * 24), slab = rem / 24, cb = rem % 24, col = cb * 256 + lane * 4;
            f32x4 a0 = {0.f, 0.f, 0.f, 0.f}, a1 = a0, a2 = a0, a3 = a0, a4 = a0;
            const float* wp = kin(I_WMOD) + ((size_t)(l * 1024 + slab * MOD_ROWS)) * 6144 + col;
#pragma unroll 8
            for (int k = 0; k < MOD_ROWS; ++k) { const f32x4 w = __builtin_nontemporal_load((const GAS f32x4*)(wp + (size_t)k * 6144)); const int kk = slab * MOD_ROWS + k;
                a0 += S[kk] * w; a1 += S[1024 + kk] * w; a2 += S[2048 + kk] * w; a3 += S[3072 + kk] * w; a4 += S[4096 + kk] * w; }
            float* o = (float*)(ws + WS_MODP) + ((size_t)((l * MOD_SLABS + slab) * 5)) * 6144 + col;
            *(f32x4*)(o) = a0; *(f32x4*)(o + 6144) = a1; *(f32x4*)(o + 2 * 6144) = a2; *(f32x4*)(o + 3 * 6144) = a3; *(f32x4*)(o + 4 * 6144) = a4;
            continue;
        }
        const int it = it0 - NGEMV;
        const int l = it / PER; int r = it % PER; unsigned char* wl = ws + WS_WT + (size_t)l * WT_LAYER;
        if (r < I_IN) { const int kb = r / 48, nb = r % 48; transpose_item(kin(I_WIN) + (size_t)l * 1024 * 1536, 1024, 1536, (bf16*)(wl + WIN_OFF), 32 * nb, 64 * kb, 32 * nb, scr, lane); continue; } r -= I_IN;
        if (r < I_OUT) { const int kb = r / 32, nb = r % 32; transpose_item(kin(I_WOUT) + (size_t)l * 1024 * 1024, 1024, 1024, (bf16*)(wl + WOUT_OFF), 32 * nb, 64 * kb, 32 * nb, scr, lane); continue; } r -= I_OUT;
        if (r < I_FI) { const int kb = r / 176, nb = r % 176; const int n0 = 32 * nb; const int j = n0 < FFH ? n0 : n0 - FFH; const int orow0 = 256 * (j / 128) + (j % 128) + (n0 < FFH ? 0 : 128);
            transpose_item(kin(I_WFI) + (size_t)l * 1024 * 5632, 1024, 5632, (bf16*)(wl + WFI_OFF), orow0, 64 * kb, n0, scr, lane); continue; } r -= I_FI;
        { const int kb = r / 32, nb = r % 32; transpose_item(kin(I_WFO) + (size_t)l * FFH * 1024, FFH, 1024, (bf16*)(wl + WFO_OFF), 32 * nb, 64 * kb, 32 * nb, scr, lane); }
    }
}
__device__ __forceinline__ void phase0b(const Params& p, int tid) {
    const int gt = ((tid >> 6) * (int)gridDim.x + (int)blockIdx.x) * 64 + (tid & 63);
    if (gt < NLAYER * 5 * 6144) {
        const int l = gt / 30720, rem = gt % 30720, r = rem / 6144, j = rem % 6144, c = j >> 10, col = j & 1023;
        const float* modp = (const float*)(kws() + WS_MODP);
        float raw = kin(I_BMOD)[l * 6144 + j];
#pragma unroll
        for (int s = 0; s < MOD_SLABS; ++s) raw += modp[((size_t)((l * MOD_SLABS + s) * 5 + r)) * 6144 + j];
        const float* ng = kin(I_NORMG) + l * 4096;
        float val = raw;
        if (c == 1) val = ng[col] * (1.0f + raw); else if (c == 2) val = raw * ng[1024 + col]; else if (c == 4) val = ng[2048 + col] * (1.0f + raw); else if (c == 5) val = raw * ng[3072 + col];
        ((float*)(kws() + WS_MOD))[gt] = val;
    }
}
template <bool HAS_YO, bool HAS_NEXT>
__device__ __forceinline__ void norm_phase(const float* yo, const float* src_lat, const float* src_ctx, float* dst_lat, float* dst_ctx,
                                           const float* modG, const float* modA, const float* modS, bf16* XN, int nrows, int gw, int NGW, int lane) {
    asm volatile("" : "+v"(lane));
    for (int m = gw; m < nrows; m += NGW) {
        const int r = m < RLAT ? (m >> 12) : 4;
        const float* src = m < RLAT ? src_lat + (size_t)m * DM : src_ctx + (size_t)(m - RLAT) * DM;
        f32x4 v[4];
#pragma unroll
        for (int j = 0; j < 4; ++j) v[j] = __builtin_nontemporal_load((const GAS f32x4*)(src + 4 * lane + 256 * j));
        if (HAS_YO) {
            f32x4 y[4]; float ss = 0.f;
#pragma unroll
            for (int j = 0; j < 4; ++j) { y[j] = *(const GAS f32x4*)(yo + (size_t)m * DM + 4 * lane + 256 * j); ss += (y[j].x * y[j].x + y[j].y * y[j].y) + (y[j].z * y[j].z + y[j].w * y[j].w); }
            const float rs = rsqrtf(wave_sum(ss, lane) * (1.0f / DM) + RMS_EPS);
            float* dst = m < RLAT ? dst_lat + (size_t)m * DM : dst_ctx + (size_t)(m - RLAT) * DM;
#pragma unroll
            for (int j = 0; j < 4; ++j) { const f32x4 g = *(const GAS f32x4*)(modG + r * 6144 + 4 * lane + 256 * j); v[j] += g * y[j] * rs; *(GAS f32x4*)(dst + 4 * lane + 256 * j) = v[j]; }
        }
        if (HAS_NEXT) {
            float ss = 0.f;
#pragma unroll
            for (int j = 0; j < 4; ++j) ss += (v[j].x * v[j].x + v[j].y * v[j].y) + (v[j].z * v[j].z + v[j].w * v[j].w);
            const float rs = rsqrtf(wave_sum(ss, lane) * (1.0f / DM) + RMS_EPS);
#pragma unroll
            for (int j = 0; j < 4; ++j) { const f32x4 a = *(const GAS f32x4*)(modA + r * 6144 + 4 * lane + 256 * j), s = *(const GAS f32x4*)(modS + r * 6144 + 4 * lane + 256 * j);
                const f32x4 o = v[j] * rs * a + s; v2u w; w.x = pk2(o.x, o.y); w.y = pk2(o.z, o.w); *(GAS v2u*)(XN + (size_t)m * DM + 4 * lane + 256 * j) = w; }
        }
    }
}
__device__ __forceinline__ void xn0_slot_phase(LAS unsigned char* lds, int tid, int wave, int vcu) {
    asm volatile("" : "+v"(tid)); const int lane = tid & 63;
    const bool lat = vcu < 240; const int slot = lat ? vcu / 60 : 4, w = lat ? vcu % 60 : vcu - 240, nw = lat ? 60 : 16, nrows = lat ? SEQ : RCTX;
    LAS float* AS = (LAS float*)lds;
    {   const float* modp = (const float*)(kws() + WS_MODP);
        for (int col = tid; col < 1024; col += NTHR) {
            float r0 = kin(I_BMOD)[col], r1 = kin(I_BMOD)[1024 + col];
#pragma unroll 16
            for (int s = 0; s < MOD_SLABS; ++s) { const float* q = modp + ((size_t)(s * 5 + slot)) * 6144 + col; r0 += q[0]; r1 += q[1024]; }
            AS[col] = kin(I_NORMG)[col] * (1.0f + r1); AS[1024 + col] = r0; } }
    __syncthreads();
    const float* src = lat ? kin(I_X) + (size_t)slot * SEQ * DM : kin(I_CTX);
    bf16* dstn = (bf16*)(kws() + WS_XN) + (size_t)(lat ? slot * SEQ : RLAT) * DM;
    f32x4 a[4], sh[4];
#pragma unroll
    for (int j = 0; j < 4; ++j) { a[j] = *(const LAS f32x4*)(AS + 4 * lane + 256 * j); sh[j] = *(const LAS f32x4*)(AS + 1024 + 4 * lane + 256 * j); }
    for (int i = w + nw * wave; i < nrows; i += nw * NWAVES) {
        f32x4 v[4]; float ss = 0.f;
#pragma unroll
        for (int j = 0; j < 4; ++j) v[j] = __builtin_nontemporal_load((const GAS f32x4*)(src + (size_t)i * DM + 4 * lane + 256 * j));
#pragma unroll
        for (int j = 0; j < 4; ++j) ss += (v[j].x * v[j].x + v[j].y * v[j].y) + (v[j].z * v[j].z + v[j].w * v[j].w);
        const float rs = rsqrtf(wave_sum(ss, lane) * (1.0f / DM) + RMS_EPS);
#pragma unroll
        for (int j = 0; j < 4; ++j) { const f32x4 o = v[j] * rs * a[j] + sh[j]; v2u wv; wv.x = pk2(o.x, o.y); wv.y = pk2(o.z, o.w); *(GAS v2u*)(dstn + (size_t)i * DM + 4 * lane + 256 * j) = wv; }
    }
    __syncthreads();
}
__device__ __forceinline__ void ctx_norm(const float* slabs, int nslab, const float* src, float* dst, const float* vG, const float* vA, const float* vS, bf16* XNc, int gw, int NGW, int lane) {
    asm volatile("" : "+v"(lane));
    for (int m = gw; m < RCTX; m += NGW) {
        f32x4 v[4], g[4], a[4], sh[4];
#pragma unroll
        for (int j = 0; j < 4; ++j) { v[j] = __builtin_nontemporal_load((const GAS f32x4*)(src + (size_t)m * DM + 4 * lane + 256 * j)); g[j] = *(const GAS f32x4*)(vG + 4 * lane + 256 * j);
            a[j] = *(const GAS f32x4*)(vA + 4 * lane + 256 * j); sh[j] = *(const GAS f32x4*)(vS + 4 * lane + 256 * j); }
        f32x4 y[4] = {{0.f, 0.f, 0.f, 0.f}, {0.f, 0.f, 0.f, 0.f}, {0.f, 0.f, 0.f, 0.f}, {0.f, 0.f, 0.f, 0.f}};
        const float* sp = slabs + (size_t)m * DM + 4 * lane;
        for (int s0 = 0; s0 < nslab; s0 += 6) {
            f32x4 t[6][4];
#pragma unroll
            for (int s = 0; s < 6; ++s)
#pragma unroll
                for (int j = 0; j < 4; ++j) t[s][j] = (s0 + s < nslab) ? __builtin_nontemporal_load((const GAS f32x4*)(sp + (size_t)(s0 + s) * RCTX * DM + 256 * j)) : (f32x4){0.f, 0.f, 0.f, 0.f};
#pragma unroll
            for (int s = 0; s < 6; ++s)
#pragma unroll
                for (int j = 0; j < 4; ++j) y[j] += t[s][j]; }
        float ss = 0.f;
#pragma unroll
        for (int j = 0; j < 4; ++j) ss += (y[j].x * y[j].x + y[j].y * y[j].y) + (y[j].z * y[j].z + y[j].w * y[j].w);
        const float rs = rsqrtf(wave_sum(ss, lane) * (1.0f / DM) + RMS_EPS);
        float s2 = 0.f;
#pragma unroll
        for (int j = 0; j < 4; ++j) { v[j] += g[j] * y[j] * rs;
            *(GAS f32x4*)(dst + (size_t)m * DM + 4 * lane + 256 * j) = v[j]; s2 += (v[j].x * v[j].x + v[j].y * v[j].y) + (v[j].z * v[j].z + v[j].w * v[j].w); }
        const float rs2 = rsqrtf(wave_sum(s2, lane) * (1.0f / DM) + RMS_EPS);
#pragma unroll
        for (int j = 0; j < 4; ++j) { const f32x4 o = v[j] * rs2 * a[j] + sh[j]; v2u w; w.x = pk2(o.x, o.y); w.y = pk2(o.z, o.w); *(GAS v2u*)(XNc + (size_t)m * DM + 4 * lane + 256 * j) = w; }
    }
}
struct ChunkInfo { int row0, t0, L, b, isctx, cpos; };
__device__ __forceinline__ ChunkInfo chunk_info(int c) {
    ChunkInfo ci;
    if (c < RLAT / 64) { ci.b = c >> 6; const int j = c & 63; ci.t0 = j * 64; ci.row0 = ci.b * SEQ + ci.t0; ci.L = SEQ; ci.isctx = 0; ci.cpos = 4 + j; }
    else { const int cc = c - RLAT / 64; ci.b = cc >> 2; const int j = cc & 3; ci.t0 = j * 64; ci.row0 = RLAT + ci.b * CTXL + ci.t0; ci.L = CTXL; ci.isctx = 1; ci.cpos = j; }
    return ci;
}
constexpr int LROW = 264;
__device__ __forceinline__ void qk_norm_rope(float (&v)[8], const float* gain8, const float* rope, int s, int t, bool do_rope, int lane_) {
    float ss = 0.f;
#pragma unroll
    for (int e = 0; e < 8; ++e) ss += v[e] * v[e];
    ss += shx(ss, 1, lane_); ss += shx(ss, 2, lane_); ss += shx(ss, 4, lane_);
    const float rs = __builtin_amdgcn_rsqf(ss * (1.0f / 64.0f) + RMS_EPS);
#pragma unroll
    for (int e = 0; e < 8; ++e) v[e] *= rs * gain8[e];
    const int pos = (s < 4) ? (t >> 6) : (t & 63);
    const float* cs = rope + (pos * 16 + (s & 1) * 8) * 2;
    float pv[8];
#pragma unroll
    for (int e = 0; e < 8; ++e) pv[e] = shx(v[e], 2, lane_);
    if (do_rope) {
#pragma unroll
        for (int e4 = 0; e4 < 4; ++e4) { const f32x4 q = *(const GAS f32x4*)(cs + 4 * e4);
            const int e = 2 * e4;
            if (s & 2) { v[e] = v[e] * q.x + pv[e] * q.y; v[e + 1] = v[e + 1] * q.z + pv[e + 1] * q.w; }
            else       { v[e] = v[e] * q.x - pv[e] * q.y; v[e + 1] = v[e + 1] * q.z - pv[e + 1] * q.w; } }
    }
}
__device__ __forceinline__ void unpack8(const v4u w, float (&v)[8]) { v[0] = bflo(w.x); v[1] = bfhi(w.x); v[2] = bflo(w.y); v[3] = bfhi(w.y); v[4] = bflo(w.z); v[5] = bfhi(w.z); v[6] = bflo(w.w); v[7] = bfhi(w.w); }
__device__ __forceinline__ v4u pack8(const float (&v)[8]) { v4u w; w.x = pk2(v[0], v[1]); w.y = pk2(v[2], v[3]); w.z = pk2(v[4], v[5]); w.w = pk2(v[6], v[7]); return w; }

__device__ __forceinline__ void mixprep_chunk(const Params& p, int layer, int c, int smask, LAS unsigned char* lds, int tid, int lane, int wave) {
    asm volatile("" : "+v"(tid)); lane = tid & 63;
    const ChunkInfo ci = chunk_info(c);
    unsigned char* ws = kws();
    const bf16* P = (const bf16*)(ws + WS_P); bf16* Y = (bf16*)(ws + WS_Y);
    const float* rope = (const float*)(ws + WS_ROPE);
    const int quad = lane >> 4, l16 = lane & 15;
    v4u wB[5], wC[5], kraw[2], vraw[2];
    if (smask & 2) {
#pragma unroll
        for (int i = 0; i < 5; ++i) { const int idx = tid + i * NTHR, rr = idx >> 5, c8 = idx & 31; const int t = ci.t0 - 8 + rr;
            wB[i] = (v4u){0u, 0u, 0u, 0u};
            if (t >= 0 && t < ci.L) wB[i] = __builtin_nontemporal_load((const GAS v4u*)(P + ((size_t)ci.row0 - 8 + rr) * INW + 1280 + c8 * 8)); } }
    if (smask & 4) {
#pragma unroll
        for (int i = 0; i < 5; ++i) { const int idx = tid + i * NTHR, rr = idx >> 5, c8 = idx & 31; const int t = ci.t0 - 2 + rr;
            wC[i] = (v4u){0u, 0u, 0u, 0u};
            if (idx < 67 * 32 && t >= 0 && t < ci.L) wC[i] = __builtin_nontemporal_load((const GAS v4u*)(P + ((size_t)ci.row0 - 2 + rr) * INW + 768 + c8 * 8)); } }
    if (smask & 1) {   const int s = lane & 7;
#pragma unroll
        for (int ps = 0; ps < 2; ++ps) { const int idx = ps * NTHR + tid, tok = idx >> 4, s16 = idx & 15; const size_t row = (size_t)ci.row0 + tok;
            kraw[ps] = __builtin_nontemporal_load((const GAS v4u*)(P + row * INW + 512 + s16 * 8)); vraw[ps] = __builtin_nontemporal_load((const GAS v4u*)(P + row * INW + 640 + s16 * 8)); }
        float gk[8];
#pragma unroll
        for (int e = 0; e < 8; ++e) gk[e] = kin(I_KNG)[layer * 64 + s * 8 + e];
#pragma unroll
        for (int ps = 0; ps < 2; ++ps) { const int idx = ps * NTHR + tid, tok = idx >> 4; const int t = ci.t0 + tok;
            float v[8]; unpack8(kraw[ps], v);
            qk_norm_rope(v, gk, rope, s, t, !ci.isctx, lane);
            kraw[ps] = pack8(v); }
        bf16* KB = (bf16*)(ws + WS_KB); bf16* VB = (bf16*)(ws + WS_VB);
#pragma unroll
        for (int ps = 0; ps < 2; ++ps) { const int idx = ps * NTHR + tid, tok = idx >> 4, s16 = idx & 15; const int t = ci.t0 + tok;
            const size_t krow = (size_t)ci.b * KVLEN + (ci.isctx ? t : CTXL + t);
            *(GAS v4u*)(KB + krow * 128 + s16 * 8) = kraw[ps]; *(GAS v4u*)(VB + krow * 128 + s16 * 8) = vraw[ps]; }
    }
    if (smask & 2) {   LAS bf16* PX = (LAS bf16*)lds;
        LAS bf16* DB = (LAS bf16*)(lds + 45056);
#pragma unroll
        for (int i = 0; i < 5; ++i) { const int idx = tid + i * NTHR, rr = idx >> 5, c8 = idx & 31; *(LAS v4u*)(PX + rr * LROW + c8 * 8) = wB[i]; }
        __syncthreads();
        {   const int cp = tid & 127, tg = tid >> 7, g = cp >> 5, half = 1 << g;
            const LAS unsigned* PXw = (const LAS unsigned*)PX;
            float s0 = 0.f, s1 = 0.f;
            for (int rr = tg * 16 - half + 8; rr < tg * 16 + half + 8; ++rr) { const unsigned w = PXw[rr * (LROW / 2) + cp]; s0 += bflo(w); s1 += bfhi(w); }
#pragma unroll 4
            for (int i = 0; i < 16; ++i) { const int tok = tg * 16 + i, t = ci.t0 + tok;
                const int lo = max(t - half, 0), hi = min(t + half, ci.L); const float icnt = __builtin_amdgcn_rcpf((float)(hi - lo));
                const unsigned w = PXw[(tok + 8) * (LROW / 2) + cp];
                const float d0 = s0 * icnt - bflo(w), d1 = s1 * icnt - bfhi(w);
                ((LAS unsigned*)DB)[tok * (LROW / 2) + cp] = pk2(d0, d1);
                const unsigned wa = PXw[(tok + half + 8) * (LROW / 2) + cp], wr_ = PXw[(tok - half + 8) * (LROW / 2) + cp];
                s0 += bflo(wa) - bflo(wr_); s1 += bfhi(wa) - bfhi(wr_); }
        }
        __syncthreads();
        {   const int g = wave & 3, th = wave >> 2;
            const GAS v4u* pwf = (const GAS v4u*)(ws + WS_PWF) + (size_t)((layer * 4 + g) * 8) * 64 + lane;
            bf16x8 wf[4][2];
#pragma unroll
            for (int nt = 0; nt < 4; ++nt)
#pragma unroll
                for (int kk = 0; kk < 2; ++kk) wf[nt][kk] = __builtin_bit_cast(bf16x8, pwf[(nt * 2 + kk) * 64]);
            f32x4 pbv[4], psv[4];
#pragma unroll
            for (int nt = 0; nt < 4; ++nt) { pbv[nt] = *(const GAS f32x4*)(kin(I_POOLB) + layer * 256 + g * 64 + nt * 16 + quad * 4); psv[nt] = *(const GAS f32x4*)(kin(I_POOLS) + layer * 256 + g * 64 + nt * 16 + quad * 4); }
#pragma unroll
            for (int mi = 0; mi < 2; ++mi) { const int mt = th * 2 + mi;
                bf16x8 af[2];
#pragma unroll
                for (int kk = 0; kk < 2; ++kk) af[kk] = *(const LAS bf16x8*)(DB + (mt * 16 + l16) * LROW + g * 64 + kk * 32 + quad * 8);
                const size_t row = (size_t)ci.row0 + mt * 16 + l16;
#pragma unroll
                for (int nt = 0; nt < 4; ++nt) { f32x4 acc = {0.f, 0.f, 0.f, 0.f};
                    acc = __builtin_amdgcn_mfma_f32_16x16x32_bf16(wf[nt][0], af[0], acc, 0, 0, 0);
                    acc = __builtin_amdgcn_mfma_f32_16x16x32_bf16(wf[nt][1], af[1], acc, 0, 0, 0);
                    const int ch = g * 64 + nt * 16 + quad * 4;
                    const f32x4 o = (acc + pbv[nt]) * psv[nt]; v2u w; w.x = pk2(o.x, o.y); w.y = pk2(o.z, o.w);
                    *(GAS v2u*)(Y + row * DM + 768 + ch) = w; } }
        }
        __syncthreads();
    }
    if (smask & 4) {   LAS bf16* LX = (LAS bf16*)lds;
        LAS bf16* UB = (LAS bf16*)(lds + 35840);
        LAS float* SC = (LAS float*)(lds + 69632 + wave * 8704);
#pragma unroll
        for (int i = 0; i < 5; ++i) { const int idx = tid + i * NTHR, rr = idx >> 5, c8 = idx & 31; if (idx < 67 * 32) *(LAS v4u*)(LX + rr * LROW + c8 * 8) = wC[i]; }
        __syncthreads();
        {   const int cp = tid & 127, tg = tid >> 7;
            const float* cw = kin(I_CONVW) + layer * 1024; const float* cb = kin(I_CONVB) + layer * 256;
            float w0[4], w1[4];
#pragma unroll
            for (int k = 0; k < 4; ++k) { w0[k] = cw[k * 256 + 2 * cp]; w1[k] = cw[k * 256 + 2 * cp + 1]; }
            const float b0 = cb[2 * cp], b1 = cb[2 * cp + 1];
            const LAS unsigned* LXw = (const LAS unsigned*)LX;
#pragma unroll 4
            for (int i = 0; i < 16; ++i) { const int tok = tg * 16 + i; float u0 = b0, u1 = b1;
#pragma unroll
                for (int k = 0; k < 4; ++k) { const unsigned w = LXw[(tok + k) * (LROW / 2) + cp]; u0 += bflo(w) * w0[k]; u1 += bfhi(w) * w1[k]; }
                ((LAS unsigned*)UB)[tok * (LROW / 2) + cp] = pk2(u0, u1); }
        }
        __syncthreads();
        {   const int d = wave >> 2, n = wave & 3;
            const GAS v4u* gwf = (const GAS v4u*)(ws + WS_GWF) + (size_t)(((layer * 2 + d) * 4 + n) * 16) * 64 + lane;
            const GAS float* spb = (const GAS float*)(ws + WS_SPB) + (layer * 2 + d) * 768 + n * 64 + quad * 4;
            bf16x8 wf[2][4][2]; f32x4 brv[4], biv[4], spv[4];
#pragma unroll
            for (int gt = 0; gt < 2; ++gt)
#pragma unroll
                for (int nt = 0; nt < 4; ++nt)
#pragma unroll
                    for (int kk = 0; kk < 2; ++kk) wf[gt][nt][kk] = __builtin_bit_cast(bf16x8, gwf[((gt * 4 + nt) * 2 + kk) * 64]);
#pragma unroll
            for (int nt = 0; nt < 4; ++nt) { brv[nt] = *(const GAS f32x4*)(spb + nt * 16); biv[nt] = *(const GAS f32x4*)(spb + 256 + nt * 16); spv[nt] = *(const GAS f32x4*)(spb + 512 + nt * 16); }
            float h = 0.f, ap = 1.f;
            unsigned* HA = (unsigned*)((unsigned char*)kout() + WS_LRU + (size_t)d * LRU_PLANE);
#pragma unroll 1
            for (int q = 0; q < 4; ++q) { const int mt = d ? 3 - q : q; asm volatile("" ::: "memory");
                bf16x8 af[2];
#pragma unroll
                for (int kk = 0; kk < 2; ++kk) af[kk] = *(const LAS bf16x8*)(UB + (mt * 16 + l16) * LROW + n * 64 + kk * 32 + quad * 8);
#pragma unroll
                for (int nt = 0; nt < 4; ++nt) { f32x4 ar = brv[nt], ai = biv[nt];
                    ar = __builtin_amdgcn_mfma_f32_16x16x32_bf16(wf[0][nt][0], af[0], ar, 0, 0, 0); ar = __builtin_amdgcn_mfma_f32_16x16x32_bf16(wf[0][nt][1], af[1], ar, 0, 0, 0);
                    ai = __builtin_amdgcn_mfma_f32_16x16x32_bf16(wf[1][nt][0], af[0], ai, 0, 0, 0); ai = __builtin_amdgcn_mfma_f32_16x16x32_bf16(wf[1][nt][1], af[1], ai, 0, 0, 0);
                    const v2u xw = *(const LAS v2u*)(UB + (mt * 16 + l16) * LROW + n * 64 + nt * 16 + quad * 4);
                    const float xv[4] = {bflo(xw.x), bfhi(xw.x), bflo(xw.y), bfhi(xw.y)};
                    f32x4 av, uv;
#pragma unroll
                    for (int j = 0; j < 4; ++j) { const float r = __builtin_amdgcn_rcpf(1.0f + __builtin_amdgcn_exp2f(-1.4426950408889634f * ar[j])), ig = __builtin_amdgcn_rcpf(1.0f + __builtin_amdgcn_exp2f(-1.4426950408889634f * ai[j]));
                        const float a = __builtin_amdgcn_exp2f(r * spv[nt][j]);
                        av[j] = a; uv[j] = __builtin_amdgcn_sqrtf(fmaf(-a, a, 1.0f)) * (ig * xv[j]); }
                    *(LAS f32x4*)(SC + l16 * 68 + nt * 16 + quad * 4) = av; *(LAS f32x4*)(SC + 1088 + l16 * 68 + nt * 16 + quad * 4) = uv; }
                LDS_WAIT(); asm volatile("" ::: "memory");
#pragma unroll 4
                for (int s = 0; s < 16; ++s) { const int tt = d ? 15 - s : s; const float a = SC[tt * 68 + lane], u = SC[1088 + tt * 68 + lane];
                    h = a * h + u; ap *= a; const size_t o = ((size_t)ci.row0 + mt * 16 + tt) * 256 + n * 64 + lane; HA[o] = pk2(h, ap); }
                LDS_WAIT(); asm volatile("" ::: "memory");
            }
            f32x2v* agg = (f32x2v*)(ws + WS_AGG); agg[((size_t)((d * NBATCH + ci.b) * NCHK + ci.cpos)) * 256 + n * 64 + lane] = (f32x2v){ap, h};
        }
        __syncthreads();
    }
}
__device__ __forceinline__ void fixup_chunk(const Params& p, int c, LAS unsigned char* lds, int tid) {
    asm volatile("" : "+v"(tid));
    const ChunkInfo ci = chunk_info(c);
    unsigned char* ws = kws();
    LAS float* CR = (LAS float*)lds;
    {   const int d = tid >> 8, ch = tid & 255;
        const f32x2v* agg = (const f32x2v*)(ws + WS_AGG) + ((size_t)((d * NBATCH + ci.b) * NCHK)) * 256 + ch;
        float s = 0.f;
        const int n = (d == 0) ? ci.cpos : (ci.isctx ? 3 - ci.cpos : 71 - ci.cpos);
        for (int k0 = 0; k0 < n; k0 += 24) {
            f32x2v ah[24];
#pragma unroll
            for (int j = 0; j < 24; ++j) { const int k = k0 + j; const int i = (d == 0) ? k : (k < 4 ? 3 - k : 71 - k);
                ah[j] = (k < n) ? agg[(size_t)i * 256] : (f32x2v){1.0f, 0.0f}; }
#pragma unroll
            for (int j = 0; j < 24; ++j) s = ah[j].x * s + ah[j].y;
        }
        CR[tid] = s;
    }
    __syncthreads();
    {   const unsigned* HAF = (const unsigned*)((unsigned char*)kout() + WS_LRU); const unsigned* HAB = (const unsigned*)((unsigned char*)kout() + WS_LRU + LRU_PLANE);
        bf16* Y = (bf16*)(ws + WS_Y);
        const int c4 = tid & 63; const f32x4 cf = *(const LAS f32x4*)(CR + 4 * c4), cb = *(const LAS f32x4*)(CR + 256 + 4 * c4);
#pragma unroll 2
        for (int it = 0; it < 8; ++it) { const int tok = it * 8 + (tid >> 6); const size_t row = (size_t)ci.row0 + tok; const size_t o = row * 256 + 4 * c4;
            const v4u fw = __builtin_nontemporal_load((const GAS v4u*)(HAF + o)), bw = __builtin_nontemporal_load((const GAS v4u*)(HAB + o));
            const f32x4 hf = {bflo(fw.x), bflo(fw.y), bflo(fw.z), bflo(fw.w)}, af = {bfhi(fw.x), bfhi(fw.y), bfhi(fw.z), bfhi(fw.w)};
            const f32x4 hb = {bflo(bw.x), bflo(bw.y), bflo(bw.z), bflo(bw.w)}, ab = {bfhi(bw.x), bfhi(bw.y), bfhi(bw.z), bfhi(bw.w)};
            const v2u gw_ = __builtin_nontemporal_load((const GAS v2u*)((const bf16*)(ws + WS_P) + row * INW + 1024 + 4 * c4));
            const f32x4 hs = (hf + af * cf) + (hb + ab * cb);
            v2u w; w.x = pk2(gelu_tanh_f(bflo(gw_.x)) * hs.x, gelu_tanh_f(bfhi(gw_.x)) * hs.y); w.y = pk2(gelu_tanh_f(bflo(gw_.y)) * hs.z, gelu_tanh_f(bfhi(gw_.y)) * hs.w);
            *(GAS v2u*)(Y + row * DM + 512 + 4 * c4) = w; }
    }
    __syncthreads();
}
#ifndef ATTN_OUT
#define ATTN_OUT(Qu, k) (Qu)
#endif
__global__ void __launch_bounds__(NTHR, 2) hybrid_fwd(Params p) {
    extern __shared__ __attribute__((aligned(16))) unsigned char lds_raw[];
    cg::grid_group grid = cg::this_grid();
    LAS unsigned char* lds = (LAS unsigned char*)lds_raw;
    const int wave = __builtin_amdgcn_readfirstlane((int)threadIdx.x >> 6);
#define lane hw_lane()
#define tid (wave * 64 + lane)
    const int G = gridDim.x; const int bx = blockIdx.x; const int vcu = (G % 8 == 0) ? (bx % 8) * (G / 8) + bx / 8 : bx;
    const int gw = vcu * NWAVES + wave, NGW = G * NWAVES;
    unsigned char* ws = kws();
    bf16* XN = (bf16*)(ws + WS_XN); float* YO = kout();     float* XRC = (float*)(ws + WS_XRC);
    const float* MOD = (const float*)(ws + WS_MOD);
    unsigned* ctl = (unsigned*)(ws + WS_CTL);

    if (tid < 16) ((LAS unsigned*)(lds + MISC_OFF))[tid] = 0u;
    __syncthreads();
    (void)xcd_barrier_post((unsigned*)(kws() + WS_CTL) + CW_BAR, (volatile LAS unsigned*)(lds + MISC_OFF), wave == 0 && lane == 0);
#define GRID_BAR() do { XcdBarrier b_; b_.bar = (unsigned*)(kws() + WS_CTL) + CW_BAR; b_.x = xb_xcc_id(); b_.st = (volatile LAS unsigned*)(lds + MISC_OFF); xcd_barrier(b_, wave == 0 && lane == 0); } while (0)
    if (__builtin_expect(gridDim.x > 1000000u, 0)) grid.sync();
    phase0a(p, lds, tid, lane, wave, vcu, G);
    GRID_BAR();
    xn0_slot_phase(lds, tid, wave, vcu);
    phase0b(p, tid);
    GRID_BAR();
#pragma unroll 1
    for (int layer = 0; layer < NLAYER; ++layer) {
        const bool last = (layer == NLAYER - 1);
        unsigned char* wl = ws + WS_WT + (size_t)layer * WT_LAYER;
        const float* MODL = MOD + layer * 30720;
        const int Mrows = last ? RLAT : RT;
        {   pg8::Gemm g{XN, (const bf16*)(wl + WIN_OFF), RT, INW, DM, DM}; pg8::StaticOrder S; S.init(RT, INW, G, bx);
            pg8::EpiBf16 E{(bf16*)(ws + WS_P), INW};
            pg8::gemm_phase<pg8::EpiBf16, pg8::StaticOrder, true, true>(lds, g, S, E, tid); }
        GRID_BAR();
        for (int it = vcu; it < RLAT / 64 + 3 * (RCTX / 64); it += G) {
            const int j = it - RLAT / 64; const int c = j < 0 ? it : RLAT / 64 + j / 3; const int sm = j < 0 ? 7 : (1 << (j % 3));
            mixprep_chunk(p, layer, c, sm, lds, tid, lane, wave); }
        GRID_BAR();
        {   const bf16* Y = (const bf16*)(ws + WS_Y); const bf16* KB = (const bf16*)(ws + WS_KB); const bf16* VB = (const bf16*)(ws + WS_VB);
#pragma unroll 1
            for (int k = 0; k < 3; ++k) {
                size_t qrow; int b, hq, nt;
                if (k < 2) { const int u = (vcu >> 5) * 64 + (vcu & 31) + 32 * k; const int bk = u >> 6, idx = u & 63; b = bk >> 1; hq = (bk & 1) * 4 + (idx >> 4); qrow = (size_t)b * SEQ + (idx & 15) * 256; nt = NCHK; }
                else { if (last || vcu < 32 || vcu >= 64) break; const int u = vcu - 32; b = u >> 3; hq = u & 7; qrow = (size_t)RLAT + b * CTXL; nt = 4; }
                const bf16* Qu = (const bf16*)(ws + WS_P) + qrow * INW + hq * 64; const bf16* Ou = Y + qrow * DM + hq * 64; const size_t kvo = (size_t)b * KVLEN * 128 + (hq >> 2) * 64;
                attn_body::attn_unit<8>((const attn_body::bf16*)Qu, (const attn_body::bf16*)(KB + kvo), (const attn_body::bf16*)(VB + kvo), (attn_body::bf16*)ATTN_OUT(Ou, k), nt, (char*)lds_raw,
                                        kin(I_QNG) + layer * 64, k < 2 ? (const float*)(ws + WS_ROPE) : nullptr, (int)(qrow & (SEQ - 1)), tid);
            }
            const int nfix = last ? RLAT / 64 : NCHUNK;
            for (int c = vcu; c < nfix; c += G) fixup_chunk(p, c, lds, tid);
        }
        GRID_BAR();
        {   pg8::Gemm g{(const bf16*)(ws + WS_Y), (const bf16*)(wl + WOUT_OFF), RLAT, DM, DM, DM}; pg8::StaticOrder S; S.init(RLAT, DM, G, bx);
            pg8::PanelSumSq st1{(float*)(ws + WS_XB + (size_t)(layer * 4 + 0) * XB_BANK), ctl + CW_SEAM + (layer * 4 + 0) * SEAM_BANK, ctl + CW_TMO};
            pg8::PanelSumSq st2{(float*)(ws + WS_XB + (size_t)(layer * 4 + 1) * XB_BANK), ctl + CW_SEAM + (layer * 4 + 1) * SEAM_BANK, ctl + CW_TMO};
            if (layer == 0) { pg8::EpiRmsRes<true, false, true> E{kin(I_X), ws + WS_RES, XN, MODL + 2 * 1024, MODL + 4 * 1024, MODL + 3 * 1024, st1, st2};
                pg8::gemm_phase<pg8::EpiRmsRes<true, false, true>, pg8::StaticOrder, false, true>(lds, g, S, E, tid); }
            else { pg8::EpiRmsRes<true, true, true> E{ws + WS_RES, ws + WS_RES, XN, MODL + 2 * 1024, MODL + 4 * 1024, MODL + 3 * 1024, st1, st2};
                pg8::gemm_phase<pg8::EpiRmsRes<true, true, true>, pg8::StaticOrder, false, true>(lds, g, S, E, tid); } }
        if (!last) {
            __syncthreads();
            {   pg8::Gemm g{(const bf16*)(ws + WS_Y) + (size_t)RLAT * DM, (const bf16*)(wl + WOUT_OFF), RCTX, DM, 256, DM}; pg8::SplitKOrder S; S.init(RCTX, DM, 4, 256, G, bx);
                pg8::EpiF32Slab E{YO, DM, (size_t)RCTX * DM};
                pg8::gemm_phase<pg8::EpiF32Slab, pg8::SplitKOrder, true, true>(lds, g, S, E, tid); }
            GRID_BAR();
            ctx_norm(YO, 4, kin(I_CTX), XRC, MODL + 4 * 6144 + 2 * 1024, MODL + 4 * 6144 + 4 * 1024, MODL + 4 * 6144 + 3 * 1024, XN + (size_t)RLAT * DM, gw, NGW, lane);
        }
        GRID_BAR();
        {   pg8::Gemm g{XN, (const bf16*)(wl + WFI_OFF), Mrows, 2 * FFH, DM, DM}; pg8::StaticOrder S; S.init(Mrows, 2 * FFH, G, bx);
            pg8::EpiSwiglu E{(bf16*)(ws + WS_H), FFH};
            pg8::gemm_phase<pg8::EpiSwiglu, pg8::StaticOrder, true, true>(lds, g, S, E, tid); }
        GRID_BAR();
        if (!last) {
            {   pg8::Gemm g{(const bf16*)(ws + WS_H), (const bf16*)(wl + WFO_OFF), RLAT, DM, FFH, FFH}; pg8::StaticOrder S; S.init(RLAT, DM, G, bx);
                pg8::PanelSumSq st1{(float*)(ws + WS_XB + (size_t)(layer * 4 + 2) * XB_BANK), ctl + CW_SEAM + (layer * 4 + 2) * SEAM_BANK, ctl + CW_TMO};
                pg8::PanelSumSq st2{(float*)(ws + WS_XB + (size_t)(layer * 4 + 3) * XB_BANK), ctl + CW_SEAM + (layer * 4 + 3) * SEAM_BANK, ctl + CW_TMO};
                pg8::EpiRmsRes<true, true, true> E{ws + WS_RES, ws + WS_RES, XN, MODL + 5 * 1024, MOD + 30720 + 1 * 1024, MOD + 30720 + 0 * 1024, st1, st2};
                pg8::gemm_phase<pg8::EpiRmsRes<true, true, true>, pg8::StaticOrder, false, true>(lds, g, S, E, tid); }
            __syncthreads();
            {   pg8::Gemm g{(const bf16*)(ws + WS_H) + (size_t)RLAT * FFH, (const bf16*)(wl + WFO_OFF), RCTX, DM, 256, FFH}; pg8::SplitKOrder S; S.init(RCTX, DM, 11, 256, G, bx);
                pg8::EpiF32Slab E{YO, DM, (size_t)RCTX * DM};
                pg8::gemm_phase<pg8::EpiF32Slab, pg8::SplitKOrder, true, true>(lds, g, S, E, tid); }
            GRID_BAR();
            ctx_norm(YO, 11, XRC, XRC, MODL + 4 * 6144 + 5 * 1024, MOD + 30720 + 4 * 6144 + 1 * 1024, MOD + 30720 + 4 * 6144 + 0 * 1024, XN + (size_t)RLAT * DM, gw, NGW, lane);
            GRID_BAR();
        } else {
            pg8::Gemm g{(const bf16*)(ws + WS_H), (const bf16*)(wl + WFO_OFF), RLAT, DM, FFH, FFH}; pg8::StaticOrder S; S.init(RLAT, DM, G, bx);
            pg8::PanelSumSq st1{(float*)(ws + WS_XB + (size_t)(layer * 4 + 2) * XB_BANK), ctl + CW_SEAM + (layer * 4 + 2) * SEAM_BANK, ctl + CW_TMO};
            pg8::EpiRmsRes<false, true, false> E{ws + WS_RES, kout(), XN, MODL + 5 * 1024, nullptr, nullptr, st1, st1};
            pg8::gemm_phase<pg8::EpiRmsRes<false, true, false>, pg8::StaticOrder, false, true>(lds, g, S, E, tid);
        }
    }
}

#undef tid
#undef lane
extern "C" void kernel_launch(void* const* d_in, const int* in_sizes, int n_in, void* d_out, int out_size, void* d_ws, size_t ws_size, hipStream_t stream) {
    static int grid = 0;
    if (grid == 0) {
        if (n_in != 21 || out_size != RLAT * DM || ws_size < WS_END) { fprintf(stderr, "kernel_launch: unexpected shapes (n_in %d out %d ws %zu)\n", n_in, out_size, ws_size); grid = -1; return; }
        int dev = 0, cus = 0, per_cu = 0;
        hipGetDevice(&dev); hipDeviceGetAttribute(&cus, hipDeviceAttributeMultiprocessorCount, dev);
        hipFuncSetAttribute((const void*)hybrid_fwd, hipFuncAttributeMaxDynamicSharedMemorySize, LDS_BYTES);
        hipOccupancyMaxActiveBlocksPerMultiprocessor(&per_cu, (const void*)hybrid_fwd, NTHR, LDS_BYTES);
        (void)hipGetLastError();
        if (per_cu < 1) { fprintf(stderr, "kernel_launch: occupancy query says %d blocks per CU\n", per_cu); per_cu = 1; }
        grid = cus;
        if (grid != 256) { fprintf(stderr, "kernel_launch: built for a 256-CU device (got %d)\n", cus); grid = -1; return; }
    }
    if (grid < 0) return;
    if (hipMemsetAsync((char*)d_ws + WS_CTL, 0, 262144, stream) != hipSuccess) { fprintf(stderr, "kernel_launch: memset failed\n"); return; }
    Params p{};
    for (int i = 0; i < 21; ++i) p.in[i] = (const float*)d_in[i];
    p.out = (float*)d_out; p.ws = (unsigned char*)d_ws;
    void* args[] = {&p};
    hipError_t e = hipLaunchCooperativeKernel((const void*)hybrid_fwd, dim3(grid), dim3(NTHR), args, LDS_BYTES, stream);
    if (e != hipSuccess) fprintf(stderr, "cooperative launch failed: %s (grid %d)\n", hipGetErrorString(e), grid);
}
```

```cpp
#include <hip/hip_runtime.h>
#include <hip/hip_cooperative_groups.h>
#include <hip/hip_bf16.h>
#include <cstdio>
#include <cstdint>
#include <cmath>
namespace cg = cooperative_groups;
__device__ __forceinline__ float shx(float v, int mask, int lane_) { return __int_as_float(__builtin_amdgcn_ds_bpermute((lane_ ^ mask) << 2, __float_as_int(v))); }
__device__ __forceinline__ int hw_lane() { int l; asm volatile("v_mbcnt_lo_u32_b32 %0, -1, 0\n\tv_mbcnt_hi_u32_b32 %0, -1, %0" : "=v"(l)); return l; }
namespace pg8 {
#define PG8_LAS __attribute__((address_space(3)))
typedef unsigned short bf16_t;
typedef short bf16x8 __attribute__((ext_vector_type(8)));
typedef float f32x4 __attribute__((ext_vector_type(4)));
typedef unsigned u32x4 __attribute__((ext_vector_type(4)));
typedef unsigned u32x2 __attribute__((ext_vector_type(2)));
constexpr int BM = 256, BK = 64, HALF = 128, HTB = HALF * BK * 2  , STAGE_BYTES = 8 * HTB, NXCD = 8, WGM = 8;

__host__ __device__ __forceinline__ int lds_byte(int r, int c) { const int st = (r >> 4) * 2 + (c >> 5), rr = r & 15, cc = c & 31, ob = rr * 64 + cc * 2; return st * 1024 + (ob ^ (((ob >> 9) & 1) << 5)); }
__host__ __device__ __forceinline__ void stage_rc(int b, int& R, int& C) { const int st = b / 1024, sb = b % 1024, swz = sb ^ (((sb >> 9) & 1) << 5); R = (st >> 1) * 16 + swz / 64; C = (st & 1) * 32 + (swz % 64) / 2; }
__host__ __device__ __forceinline__ int perm32(int rho) { const int n = rho >> 4, i = rho & 15; return 8 * (i >> 2) + 4 * n + (i & 3); }

struct Unit { int pm, pn, kb, ks; };
struct Gemm { const bf16_t* A; const bf16_t* Bt; int M, N, K, ld; };

struct StaticOrder {
    int nM, nN, nwg, G, c;
    __host__ __device__ void init(int M, int N, int G_, int c_) { nM = M / BM; nN = N / BM; nwg = nM * nN; G = G_; c = c_; }
    __host__ __device__ bool next(int i, Unit& u) const {
        const long L = (long)i * G + c; if (L >= nwg) return false;
        int wgid = (int)L; { const int q = nwg / NXCD, r = nwg % NXCD, xcd = wgid % NXCD, off = wgid / NXCD; wgid = (xcd < r ? xcd * (q + 1) : r * (q + 1) + (xcd - r) * q) + off; }
        const int nig = WGM * nN, gid = wgid / nig, fm = gid * WGM, gsz = (nM - fm) < WGM ? (nM - fm) : WGM;
        u.pm = fm + ((wgid % nig) % gsz); u.pn = (wgid % nig) / gsz; u.kb = 0; u.ks = 0; return true;
    }
    __device__ __forceinline__ void a_ready(const Unit&) const {}
    __device__ __forceinline__ void done(const Unit&) const {}
};

__device__ __forceinline__ unsigned cvt_pk_bf16(float lo, float hi) { unsigned r; asm volatile("v_cvt_pk_bf16_f32 %0, %1, %2" : "=v"(r) : "v"(lo), "v"(hi)); return r; }
typedef float f32x2 __attribute__((ext_vector_type(2)));
struct EpiBf16 {
    static constexpr bool PERM = true, AFTER_DRAIN = false;
    bf16_t* O; int ldc;
    __device__ __forceinline__ void operator()(const f32x4 (&acc)[2][2][4][2], const Unit& u, int wr, int wc, int fr, int fq) const {
        const int row0 = u.pm * BM + wr * 64 + fr; const int col0 = u.pn * BM + wc * 32 + 8 * fq;
#pragma unroll
        for (int ai = 0; ai < 2; ++ai)
#pragma unroll
            for (int m = 0; m < 4; ++m) { bf16_t* rowp = O + (size_t)(row0 + ai * HALF + m * 16) * ldc + col0;
#pragma unroll
                for (int bj = 0; bj < 2; ++bj) { const f32x4 v0 = acc[ai][bj][m][0], v1 = acc[ai][bj][m][1];
                    u32x4 w; w.x = cvt_pk_bf16(v0[0], v0[1]); w.y = cvt_pk_bf16(v0[2], v0[3]); w.z = cvt_pk_bf16(v1[0], v1[1]); w.w = cvt_pk_bf16(v1[2], v1[3]);
                    *(u32x4*)(rowp + bj * HALF) = w; } }
    }
};
__device__ __forceinline__ float silu_f(float g) { return g * __builtin_amdgcn_rcpf(1.0f + __expf(-g)); }
struct EpiSwiglu {
    static constexpr bool PERM = true, AFTER_DRAIN = false;
    bf16_t* H; int ldh;
    __device__ __forceinline__ void operator()(const f32x4 (&acc)[2][2][4][2], const Unit& u, int wr, int wc, int fr, int fq) const {
        const int row0 = u.pm * BM + wr * 64 + fr; const int col0 = u.pn * HALF + wc * 32 + 8 * fq;
#pragma unroll
        for (int ai = 0; ai < 2; ++ai)
#pragma unroll
            for (int m = 0; m < 4; ++m) { bf16_t* rowp = H + (size_t)(row0 + ai * HALF + m * 16) * ldh + col0;
                const f32x4 g0 = acc[ai][0][m][0], g1 = acc[ai][0][m][1], u0 = acc[ai][1][m][0], u1 = acc[ai][1][m][1];
                u32x4 w;
                w.x = cvt_pk_bf16(silu_f(g0[0]) * u0[0], silu_f(g0[1]) * u0[1]); w.y = cvt_pk_bf16(silu_f(g0[2]) * u0[2], silu_f(g0[3]) * u0[3]);
                w.z = cvt_pk_bf16(silu_f(g1[0]) * u1[0], silu_f(g1[1]) * u1[1]); w.w = cvt_pk_bf16(silu_f(g1[2]) * u1[2], silu_f(g1[3]) * u1[3]);
                *(u32x4*)rowp = w; }
    }
};
struct EpiF32 {
    static constexpr bool PERM = false, AFTER_DRAIN = false;
    float* O; int ldc;
    __device__ __forceinline__ void operator()(const f32x4 (&acc)[2][2][4][2], const Unit& u, int wr, int wc, int fr, int fq) const {
        const int row0 = u.pm * BM + wr * 64 + fr; const int col0 = u.pn * BM + wc * 32 + 4 * fq;
#pragma unroll
        for (int ai = 0; ai < 2; ++ai)
#pragma unroll
            for (int m = 0; m < 4; ++m) { float* rowp = O + (size_t)(row0 + ai * HALF + m * 16) * ldc + col0;
#pragma unroll
                for (int bj = 0; bj < 2; ++bj)
#pragma unroll
                    for (int n = 0; n < 2; ++n) *(f32x4*)(rowp + bj * HALF + n * 16) = acc[ai][bj][m][n]; }
    }
};
struct SplitKOrder {
    int nM, nN, KS, kbytes, G, c;
    __device__ void init(int M, int N, int KS_, int kslice, int G_, int c_) { nM = M / BM; nN = N / BM; KS = KS_; kbytes = kslice * 2; G = G_; c = c_; }
    __device__ bool next(int i, Unit& u) const { const int L = i * G + c; if (L >= nM * nN * KS) return false; const int ks = L % KS, t = L / KS; u.pm = t % nM; u.pn = t / nM; u.ks = ks; u.kb = ks * kbytes; return true; }
    __device__ __forceinline__ void a_ready(const Unit&) const {}
    __device__ __forceinline__ void done(const Unit&) const {}
};
struct EpiF32Slab {
    static constexpr bool PERM = false, AFTER_DRAIN = false;
    float* O; int ldc; size_t slab;
    __device__ __forceinline__ void operator()(const f32x4 (&acc)[2][2][4][2], const Unit& u, int wr, int wc, int fr, int fq) const {
        const int row0 = u.pm * BM + wr * 64 + fr; const int col0 = u.pn * BM + wc * 32 + 4 * fq; float* Os = O + (size_t)u.ks * slab;
#pragma unroll
        for (int ai = 0; ai < 2; ++ai)
#pragma unroll
            for (int m = 0; m < 4; ++m) { float* rowp = Os + (size_t)(row0 + ai * HALF + m * 16) * ldc + col0;
#pragma unroll
                for (int bj = 0; bj < 2; ++bj)
#pragma unroll
                    for (int n = 0; n < 2; ++n) *(f32x4*)(rowp + bj * HALF + n * 16) = acc[ai][bj][m][n]; }
    }
};
struct PanelSumSq {
    float* xbuf;
    unsigned* cnt;
    unsigned* tmo;
    __device__ __forceinline__ void run(const f32x4 (&v)[2][2][4][2], int pmg, int pn, int wr, int wc, int fr, int fq, PG8_LAS unsigned char* lds, int wid, int lane) const { publish(v, pmg, pn, wr, wc, fr, fq, lds, wid, lane); finish(pmg, lds, wid, lane); }
    __device__ __forceinline__ void publish(const f32x4 (&v)[2][2][4][2], int pmg, int pn, int wr, int wc, int fr, int fq, PG8_LAS unsigned char* lds, int wid, int lane) const {
        PG8_LAS float* P = (PG8_LAS float*)lds;
        PG8_LAS float* S = (PG8_LAS float*)(lds + 8192);
#pragma unroll
        for (int ai = 0; ai < 2; ++ai)
#pragma unroll
            for (int m = 0; m < 4; ++m) {
                float q = 0.f;
#pragma unroll
                for (int bj = 0; bj < 2; ++bj)
#pragma unroll
                    for (int n = 0; n < 2; ++n) { const f32x4 x = v[ai][bj][m][n]; q += (x[0] * x[0] + x[1] * x[1]) + (x[2] * x[2] + x[3] * x[3]); }
                q += shx(q, 16, lane); q += shx(q, 32, lane);
                if (fq == 0) P[(ai * HALF + wr * 64 + m * 16 + fr) * 4 + wc] = q;
            }
        asm volatile("s_waitcnt lgkmcnt(0)" ::: "memory"); __builtin_amdgcn_s_barrier(); asm volatile("" ::: "memory");
        const int row = wid * 32 + (lane & 31);
        if (lane < 32) {
            const float t = (P[row * 4 + 0] + P[row * 4 + 1]) + (P[row * 4 + 2] + P[row * 4 + 3]);
            __hip_atomic_store((unsigned*)xbuf + ((size_t)(pmg * BM + row) * 4 + pn), __float_as_uint(t), __ATOMIC_RELAXED, __HIP_MEMORY_SCOPE_AGENT);
        }
        asm volatile("s_waitcnt vmcnt(0)" ::: "memory");
        if (lane == 0) __hip_atomic_fetch_add(cnt + 64 * pmg, 1u, __ATOMIC_RELAXED, __HIP_MEMORY_SCOPE_AGENT);
    }
    __device__ __forceinline__ void finish(int pmg, PG8_LAS unsigned char* lds, int wid, int lane) const {
        PG8_LAS float* S = (PG8_LAS float*)(lds + 8192);
        const int row = wid * 32 + (lane & 31);
        {   unsigned sp = 0u;
            while ((unsigned)__builtin_amdgcn_readfirstlane(__hip_atomic_load(cnt + 64 * pmg, __ATOMIC_RELAXED, __HIP_MEMORY_SCOPE_AGENT)) < 32u) {
                __builtin_amdgcn_s_sleep(1);
                if (++sp > (1u << 18)) { if (lane == 0) __hip_atomic_store(tmo, 1u, __ATOMIC_RELAXED, __HIP_MEMORY_SCOPE_AGENT); break; }
            }
        }
        if (lane < 32) {
            const unsigned* slot = (const unsigned*)xbuf + (size_t)(pmg * BM + row) * 4; float tot = 0.f;
#pragma unroll
            for (int t = 0; t < 4; ++t) tot += __uint_as_float(__hip_atomic_load(slot + t, __ATOMIC_RELAXED, __HIP_MEMORY_SCOPE_AGENT));
            S[row] = rsqrtf(tot * (1.0f / 1024.0f) + 1e-6f);
        }
        asm volatile("s_waitcnt vmcnt(0) lgkmcnt(0)" ::: "memory"); __builtin_amdgcn_s_barrier(); asm volatile("" ::: "memory");
    }
};
template <bool NEXT, bool BASE16, bool OUT16> struct EpiRmsRes {
    static constexpr bool PERM = false, AFTER_DRAIN = true;
    const void* base_p; void* out_p; bf16_t* xn;
    const float* vG; const float* vA; const float* vS;
    PanelSumSq st1, st2;
    static __device__ __forceinline__ f32x4 up4(u32x2 w) { return (f32x4){__uint_as_float(w.x << 16), __uint_as_float(w.x & 0xffff0000u), __uint_as_float(w.y << 16), __uint_as_float(w.y & 0xffff0000u)}; }
    __device__ __forceinline__ void store_out(void* rowp, int coff, const f32x4 x) const {
        if (OUT16) { u32x2 w; w.x = cvt_pk_bf16(x[0], x[1]); w.y = cvt_pk_bf16(x[2], x[3]); *(u32x2*)((bf16_t*)rowp + coff) = w; }
        else *(f32x4*)((float*)rowp + coff) = x; }
    __device__ __forceinline__ void fused(f32x4 (&acc)[2][2][4][2], const Unit& u, int wr, int wc, int fr, int fq, PG8_LAS unsigned char* lds, int wid, int lane) const {
        const PG8_LAS float* S = (const PG8_LAS float*)(lds + 8192);
        const int pmg = u.pm, slot = pmg >> 4;
        const size_t poff = (size_t)pmg * BM * 1024;
        const int col0 = u.pn * BM + wc * 32 + 4 * fq;
        const size_t lane_off = (size_t)(wr * 64 + fr) * 1024 + col0;
        st1.publish(acc, pmg, u.pn, wr, wc, fr, fq, lds, wid, lane);
        f32x4 pre[4][2][2]; u32x2 pb[2][4][2][2];
        if (BASE16) {
            const bf16_t* b16 = (const bf16_t*)base_p + poff + lane_off;
#pragma unroll
            for (int ai = 0; ai < 2; ++ai)
#pragma unroll
                for (int m = 0; m < 4; ++m)
#pragma unroll
                    for (int bj = 0; bj < 2; ++bj)
#pragma unroll
                        for (int n = 0; n < 2; ++n) pb[ai][m][bj][n] = *(const u32x2*)(b16 + (size_t)(ai * HALF + m * 16) * 1024 + bj * HALF + n * 16);
        } else {
            const float* b32 = (const float*)base_p + poff + lane_off;
#pragma unroll
            for (int m = 0; m < 4; ++m)
#pragma unroll
                for (int bj = 0; bj < 2; ++bj)
#pragma unroll
                    for (int n = 0; n < 2; ++n) pre[m][bj][n] = __builtin_nontemporal_load((const f32x4*)(b32 + (size_t)(m * 16) * 1024 + bj * HALF + n * 16));
        }
        f32x4 g[2][2];
#pragma unroll
        for (int bj = 0; bj < 2; ++bj)
#pragma unroll
            for (int n = 0; n < 2; ++n) g[bj][n] = *(const f32x4*)(vG + slot * 6144 + col0 + bj * HALF + n * 16);
        st1.finish(pmg, lds, wid, lane);
#pragma unroll
        for (int ai = 0; ai < 2; ++ai)
#pragma unroll
            for (int m = 0; m < 4; ++m) { const float rs = S[ai * HALF + wr * 64 + m * 16 + fr];
#pragma unroll
                for (int bj = 0; bj < 2; ++bj)
#pragma unroll
                    for (int n = 0; n < 2; ++n) { f32x4 bs;
                        if (BASE16) bs = up4(pb[ai][m][bj][n]);
                        else bs = ai == 0 ? pre[m][bj][n] : __builtin_nontemporal_load((const f32x4*)((const float*)base_p + poff + lane_off + (size_t)(HALF + m * 16) * 1024 + bj * HALF + n * 16));
                        acc[ai][bj][m][n] = bs + g[bj][n] * acc[ai][bj][m][n] * rs; }
                asm volatile("" : "+v"(acc[ai][0][m][0]), "+v"(acc[ai][0][m][1]), "+v"(acc[ai][1][m][0]), "+v"(acc[ai][1][m][1]));
                if (m & 1) asm volatile("" ::: "memory"); }
        unsigned char* const outl = (unsigned char*)out_p + (poff + lane_off) * (OUT16 ? 2 : 4);
        if (NEXT) {
            f32x4 a[2][2], sh[2][2];
#pragma unroll
            for (int bj = 0; bj < 2; ++bj)
#pragma unroll
                for (int n = 0; n < 2; ++n) { a[bj][n] = *(const f32x4*)(vA + slot * 6144 + col0 + bj * HALF + n * 16); sh[bj][n] = *(const f32x4*)(vS + slot * 6144 + col0 + bj * HALF + n * 16); }
            st2.publish(acc, pmg, u.pn, wr, wc, fr, fq, lds, wid, lane);
#pragma unroll
            for (int ai = 0; ai < 2; ++ai)
#pragma unroll
                for (int m = 0; m < 4; ++m) { void* op = outl + (size_t)(ai * HALF + m * 16) * 1024 * (OUT16 ? 2 : 4);
#pragma unroll
                    for (int bj = 0; bj < 2; ++bj)
#pragma unroll
                        for (int n = 0; n < 2; ++n) store_out(op, bj * HALF + n * 16, acc[ai][bj][m][n]);
                    asm volatile("" ::: "memory"); }
            st2.finish(pmg, lds, wid, lane);
            bf16_t* xnl = xn + poff + lane_off;
#pragma unroll
            for (int ai = 0; ai < 2; ++ai)
#pragma unroll
                for (int m = 0; m < 4; ++m) { const float rs = S[ai * HALF + wr * 64 + m * 16 + fr]; bf16_t* xp = xnl + (size_t)(ai * HALF + m * 16) * 1024;
#pragma unroll
                    for (int bj = 0; bj < 2; ++bj)
#pragma unroll
                        for (int n = 0; n < 2; ++n) { const f32x4 x1 = acc[ai][bj][m][n]; const f32x4 o = x1 * rs * a[bj][n] + sh[bj][n];
                            u32x2 w; w.x = cvt_pk_bf16(o[0], o[1]); w.y = cvt_pk_bf16(o[2], o[3]); *(u32x2*)(xp + bj * HALF + n * 16) = w; }
                    asm volatile("" ::: "memory"); }
        } else {
#pragma unroll
            for (int ai = 0; ai < 2; ++ai)
#pragma unroll
                for (int m = 0; m < 4; ++m) { void* op = outl + (size_t)(ai * HALF + m * 16) * 1024 * (OUT16 ? 2 : 4);
#pragma unroll
                    for (int bj = 0; bj < 2; ++bj)
#pragma unroll
                        for (int n = 0; n < 2; ++n) store_out(op, bj * HALF + n * 16, acc[ai][bj][m][n]);
                    asm volatile("" ::: "memory"); }
        }
    }
};
template <class Epi, class Sched, bool ALIGN_EPI = false, bool SP2 = false>
__device__ __forceinline__ void gemm_phase(PG8_LAS unsigned char* lds, const Gemm g, const Sched& S, const Epi& E, int tid_) {
    asm volatile("" : "+v"(tid_));
    const int tid = tid_, wid = __builtin_amdgcn_readfirstlane(tid >> 6), lane = tid & 63, wr = wid >> 2, wc = wid & 3, fr = lane & 15, fq = lane >> 4;
    const int K = g.ld, nt = g.K / BK;
    unsigned voffA[2], voffB[2];
#pragma unroll
    for (int i = 0; i < 2; ++i) { int R, C; stage_rc(tid * 16 + i * 8192, R, C); const int Rb = Epi::PERM ? ((R & ~31) + perm32(R & 31)) : R;
        voffA[i] = (unsigned)(R * K + C) * 2u; voffB[i] = (unsigned)(Rb * K + C) * 2u; }
    const size_t kstep = (size_t)(BK * 2);
    const size_t hstep = (size_t)HALF * K * 2;
    const size_t tstep = 2 * hstep;
    const unsigned ldsw = (unsigned)wid * 1024u;
    const int aoff = lds_byte(wr * 64 + fr, fq * 8), boff = lds_byte(wc * 32 + fr, fq * 8);
#define PG8_SA(b, h) (((b) * 2 + (h)) * HTB)
#define PG8_SB(b, h) ((4 + (b) * 2 + (h)) * HTB)
#define PG8_STAGE(bufoff, gbase, voff) do { _Pragma("unroll") for (int _i = 0; _i < 2; ++_i) \
        __builtin_amdgcn_global_load_lds((const unsigned*)((const char*)(gbase) + (voff)[_i]), (PG8_LAS unsigned*)(lds + (bufoff) + ldsw + _i * 8192), 16, 0, 0); } while (0)
#define PG8_LDA(dst, b, h) do { _Pragma("unroll") for (int m = 0; m < 4; ++m) _Pragma("unroll") for (int k = 0; k < 2; ++k) dst[m][k] = *(const PG8_LAS bf16x8*)(lds + PG8_SA(b, h) + aoff + m * 2048 + k * 1024); } while (0)
#define PG8_LDB(dst, b, h) do { _Pragma("unroll") for (int n = 0; n < 2; ++n) _Pragma("unroll") for (int k = 0; k < 2; ++k) dst[n][k] = *(const PG8_LAS bf16x8*)(lds + PG8_SB(b, h) + boff + n * 2048 + k * 1024); } while (0)
#define PG8_MMA(ai, bj, At, Bt) do { __builtin_amdgcn_s_setprio(1); _Pragma("unroll") for (int m = 0; m < 4; ++m) _Pragma("unroll") for (int n = 0; n < 2; ++n) _Pragma("unroll") for (int k = 0; k < 2; ++k) \
        acc[ai][bj][m][n] = __builtin_amdgcn_mfma_f32_16x16x32_bf16(Bt[n][k], At[m][k], acc[ai][bj][m][n], 0, 0, 0); __builtin_amdgcn_s_setprio(0); } while (0)
#define PG8_WAIT_V(n) asm volatile("s_waitcnt vmcnt(" #n ")" ::: "memory")
#define PG8_WAIT_L(n) asm volatile("s_waitcnt lgkmcnt(" #n ")" ::: "memory")
#define PG8_BAR __builtin_amdgcn_s_barrier()
#define PG8_SCHED __builtin_amdgcn_sched_barrier(0)
    Unit cur, nxt; int ui = 0;
    if (!S.next(0, cur)) return;
    f32x4 acc[2][2][4][2];
#pragma unroll
    for (int a = 0; a < 2; ++a)
#pragma unroll
        for (int b = 0; b < 2; ++b)
#pragma unroll
            for (int m = 0; m < 4; ++m)
#pragma unroll
                for (int n = 0; n < 2; ++n) acc[a][b][m][n] = (f32x4){0.f, 0.f, 0.f, 0.f};
    bf16x8 At[4][2], B0[2][2], B1[2][2];
    const char* cA = (const char*)g.A + (size_t)cur.pm * tstep + cur.kb; const char* cB = (const char*)g.Bt + (size_t)cur.pn * tstep + cur.kb;
    S.a_ready(cur);
    if constexpr (SP2) {
        PG8_STAGE(PG8_SB(0, 0), cB, voffB); PG8_STAGE(PG8_SB(0, 1), cB + hstep, voffB); PG8_STAGE(PG8_SA(0, 0), cA, voffA); PG8_STAGE(PG8_SA(0, 1), cA + hstep, voffA);
        if (wr == 1) PG8_BAR;
        PG8_WAIT_V(2); PG8_BAR;
        PG8_STAGE(PG8_SB(1, 0), cB + kstep, voffB); PG8_STAGE(PG8_SA(1, 0), cA + kstep, voffA); PG8_STAGE(PG8_SB(1, 1), cB + hstep + kstep, voffB);
        PG8_WAIT_V(6); PG8_BAR;
    } else {
        PG8_STAGE(PG8_SB(0, 0), cB, voffB); PG8_STAGE(PG8_SA(0, 0), cA, voffA); PG8_STAGE(PG8_SB(0, 1), cB + hstep, voffB); PG8_STAGE(PG8_SA(0, 1), cA + hstep, voffA);
        if (wr == 1) PG8_BAR;
        PG8_WAIT_V(4); PG8_BAR;
        PG8_STAGE(PG8_SB(1, 0), cB + kstep, voffB); PG8_STAGE(PG8_SA(1, 0), cA + kstep, voffA); PG8_STAGE(PG8_SB(1, 1), cB + hstep + kstep, voffB);
        PG8_WAIT_V(6); PG8_BAR;
    }
    for (;;) {
        const bool has_next = S.next(ui + 1, nxt);
        const char* nA = has_next ? (const char*)g.A + (size_t)nxt.pm * tstep + nxt.kb : cA; const char* nB = has_next ? (const char*)g.Bt + (size_t)nxt.pn * tstep + nxt.kb : cB;
        for (int t = 0; t < nt; t += 2) {
            const bool last = (t == nt - 2);
            const char* a1 = cA + (size_t)(t + 1) * kstep;
            const char* a2 = last ? nA : cA + (size_t)(t + 2) * kstep; const char* b2 = last ? nB : cB + (size_t)(t + 2) * kstep;
            const char* a3 = a2 + kstep; const char* b3 = b2 + kstep;
            if (last && has_next) S.a_ready(nxt);
            if constexpr (SP2) {
            PG8_LDB(B0, 0, 0); PG8_LDB(B1, 0, 1); PG8_SCHED; PG8_LDA(At, 0, 0); PG8_STAGE(PG8_SA(1, 1), a1 + hstep, voffA);
            PG8_WAIT_V(8); PG8_WAIT_L(0); PG8_BAR; PG8_MMA(0, 0, At, B0); PG8_MMA(0, 1, At, B1); PG8_BAR; PG8_SCHED;
            PG8_LDA(At, 0, 1); PG8_STAGE(PG8_SB(0, 0), b2, voffB); PG8_STAGE(PG8_SB(0, 1), b2 + hstep, voffB); PG8_STAGE(PG8_SA(0, 0), a2, voffA);
            PG8_WAIT_V(8); PG8_WAIT_L(0); PG8_BAR; PG8_MMA(1, 0, At, B0); PG8_MMA(1, 1, At, B1); PG8_BAR; PG8_SCHED;
            PG8_LDB(B0, 1, 0); PG8_LDB(B1, 1, 1); PG8_SCHED; PG8_LDA(At, 1, 0); PG8_STAGE(PG8_SA(0, 1), a2 + hstep, voffA);
            PG8_WAIT_V(8); PG8_WAIT_L(0); PG8_BAR; PG8_MMA(0, 0, At, B0); PG8_MMA(0, 1, At, B1); PG8_BAR; PG8_SCHED;
            PG8_LDA(At, 1, 1); PG8_STAGE(PG8_SB(1, 0), b3, voffB); PG8_STAGE(PG8_SB(1, 1), b3 + hstep, voffB); PG8_STAGE(PG8_SA(1, 0), a3, voffA);
            PG8_WAIT_V(8); PG8_WAIT_L(0); PG8_BAR; PG8_MMA(1, 0, At, B0); PG8_MMA(1, 1, At, B1); PG8_BAR; PG8_SCHED;
            } else {
            PG8_LDB(B0, 0, 0); PG8_SCHED; PG8_LDA(At, 0, 0); PG8_STAGE(PG8_SA(1, 1), a1 + hstep, voffA);
            PG8_WAIT_L(8); PG8_BAR; PG8_WAIT_L(0); PG8_MMA(0, 0, At, B0); PG8_BAR; PG8_SCHED;
            PG8_LDB(B1, 0, 1); PG8_STAGE(PG8_SB(0, 0), b2, voffB);
            PG8_BAR; PG8_WAIT_L(0); PG8_MMA(0, 1, At, B1); PG8_BAR;
            PG8_LDA(At, 0, 1); PG8_STAGE(PG8_SA(0, 0), a2, voffA);
            PG8_BAR; PG8_WAIT_L(0); PG8_MMA(1, 0, At, B0); PG8_BAR; PG8_SCHED;
            PG8_STAGE(PG8_SB(0, 1), b2 + hstep, voffB);
            PG8_WAIT_V(6); PG8_BAR; PG8_MMA(1, 1, At, B1); PG8_BAR;
            PG8_LDB(B0, 1, 0); PG8_SCHED; PG8_LDA(At, 1, 0); PG8_STAGE(PG8_SA(0, 1), a2 + hstep, voffA);
            PG8_WAIT_L(8); PG8_BAR; PG8_WAIT_L(0); PG8_MMA(0, 0, At, B0); PG8_BAR; PG8_SCHED;
            PG8_LDB(B1, 1, 1); PG8_STAGE(PG8_SB(1, 0), b3, voffB);
            PG8_BAR; PG8_WAIT_L(0); PG8_MMA(0, 1, At, B1); PG8_BAR;
            PG8_LDA(At, 1, 1); PG8_STAGE(PG8_SA(1, 0), a3, voffA);
            PG8_BAR; PG8_WAIT_L(0); PG8_MMA(1, 0, At, B0); PG8_BAR; PG8_SCHED;
            PG8_STAGE(PG8_SB(1, 1), b3 + hstep, voffB);
            PG8_WAIT_V(6); PG8_BAR; PG8_MMA(1, 1, At, B1); PG8_BAR;
            }
        }
        if constexpr (ALIGN_EPI) { if (wr == 0) PG8_BAR; }
        if constexpr (!Epi::AFTER_DRAIN) { E(acc, cur, wr, wc, fr, fq); S.done(cur); }
        if (!has_next) break;
#pragma unroll
        for (int a = 0; a < 2; ++a)
#pragma unroll
            for (int b = 0; b < 2; ++b)
#pragma unroll
                for (int m = 0; m < 4; ++m)
#pragma unroll
                    for (int n = 0; n < 2; ++n) acc[a][b][m][n] = (f32x4){0.f, 0.f, 0.f, 0.f};
        cur = nxt; cA = nA; cB = nB; ++ui;
        if constexpr (ALIGN_EPI) { if (wr == 1) PG8_BAR; }
    }
    PG8_WAIT_V(0);
    if constexpr (!ALIGN_EPI) { if (wr == 0) PG8_BAR; }
    PG8_BAR;
    if constexpr (Epi::AFTER_DRAIN) { E.fused(acc, cur, wr, wc, fr, fq, lds, wid, lane); S.done(cur); }
#undef PG8_SA
#undef PG8_SB
#undef PG8_STAGE
#undef PG8_LDA
#undef PG8_LDB
#undef PG8_MMA
#undef PG8_WAIT_V
#undef PG8_WAIT_L
#undef PG8_BAR
#undef PG8_SCHED
}
}
#include <hip/hip_bf16.h>
#include <cmath>
namespace attn_body {
using bf16=__hip_bfloat16;
using bf16x8=__attribute__((ext_vector_type(8)))short;
using s16x4=__attribute__((ext_vector_type(4)))short;
using f32x16=__attribute__((ext_vector_type(16)))float;
using u32x4=__attribute__((ext_vector_type(4)))unsigned;
constexpr int D=64,DM=1024,KVP=128,QP=1536;
constexpr int NW=8,QBLK=32,QB=QBLK*NW,KVBLK=64;
constexpr int ATTN_PITCH=DM, ATTN_UNIT_ROWS=QB;
__device__ __forceinline__ int crow(int r,int hi){return (r&3)+8*(r>>2)+4*hi;}
#define SBAR() __builtin_amdgcn_sched_barrier(0)
__device__ __forceinline__ void cmask(f32x16&p0,f32x16&p1,int jb,int qrel,int hi){
  const float NEG=-INFINITY; int kb=64*jb+4*hi;
  #pragma unroll
  for(int r=0;r<16;++r){int kv=kb+(r&3)+8*(r>>2); if(kv>qrel)p0[r]=NEG; if(kv+32>qrel)p1[r]=NEG;}
}

constexpr int NSLOT=3, SLOTB=8192;
constexpr int LDS_K=0, LDS_V=NSLOT*SLOTB, LDS_WS=2*NSLOT*SLOTB, LDS_OST=LDS_WS+NW*64*4, LDS_BYTES=LDS_OST+NW*4096;
constexpr float C2=0.125f*1.4426950408889634f;
__device__ __forceinline__ void glds16(const void*gsrc,unsigned lds_dst){unsigned keep;
  asm volatile("s_mov_b32 %0, m0\n\ts_mov_b32 m0, %2\n\ts_nop 0\n\tglobal_load_lds_dwordx4 %1, off\n\ts_mov_b32 m0, %0":"=&s"(keep):"v"(gsrc),"s"(lds_dst):"memory");}
__device__ __forceinline__ float max3f(float a,float b,float c){float r;asm("v_max3_f32 %0, %1, %2, %3":"=v"(r):"v"(a),"v"(b),"v"(c));return r;}
__device__ __forceinline__ float max2f(float a,float b){float r;asm("v_max_f32_e32 %0, %1, %2":"=v"(r):"v"(a),"v"(b));return r;}
__device__ __forceinline__ float fadd_s(float a,float b){float r;asm("v_add_f32_e32 %0, %1, %2":"=v"(r):"v"(a),"v"(b));return r;}
__device__ __forceinline__ float fsub_s(float a,float b){float r;asm("v_sub_f32_e32 %0, %1, %2":"=v"(r):"v"(a),"v"(b));return r;}
typedef float f32x2_t __attribute__((ext_vector_type(2))); typedef __bf16 bf16x2_t __attribute__((ext_vector_type(2)));
__device__ __forceinline__ unsigned cvtpk_s(float lo,float hi){f32x2_t v={lo,hi};bf16x2_t b=__builtin_convertvector(v,bf16x2_t);return __builtin_bit_cast(unsigned,b);}
#define WAIT_BAR(N) asm volatile("s_waitcnt vmcnt(" #N ") lgkmcnt(0)\n\ts_barrier":::"memory")

__device__ __forceinline__ void qkt(f32x16&p0,f32x16&p1,const char*Kslot,const bf16x8*qr,const f32x16&negm,int r32,int hi){
  const char*kb=Kslot+hi*1024+r32*16;
  #pragma unroll
  for(int d0=0;d0<4;++d0){
    const bf16x8 b0=*reinterpret_cast<const bf16x8*>(kb+d0*2048);
    const bf16x8 b1=*reinterpret_cast<const bf16x8*>(kb+d0*2048+512);
    if(d0==0){p0=__builtin_amdgcn_mfma_f32_32x32x16_bf16(b0,qr[0],negm,0,0,0);p1=__builtin_amdgcn_mfma_f32_32x32x16_bf16(b1,qr[0],negm,0,0,0);}
    else{p0=__builtin_amdgcn_mfma_f32_32x32x16_bf16(b0,qr[d0],p0,0,0,0);p1=__builtin_amdgcn_mfma_f32_32x32x16_bf16(b1,qr[d0],p1,0,0,0);}}
}
typedef __attribute__((address_space(3))) const char* lds_cptr;
typedef short v4i16_t __attribute__((ext_vector_type(4)));
__device__ __forceinline__ void kload8(bf16x8*kf,lds_cptr kp){
  kf[0]=*(const __attribute__((address_space(3))) bf16x8*)(kp);      kf[1]=*(const __attribute__((address_space(3))) bf16x8*)(kp+512);
  kf[2]=*(const __attribute__((address_space(3))) bf16x8*)(kp+2048); kf[3]=*(const __attribute__((address_space(3))) bf16x8*)(kp+2560);
  kf[4]=*(const __attribute__((address_space(3))) bf16x8*)(kp+4096); kf[5]=*(const __attribute__((address_space(3))) bf16x8*)(kp+4608);
  kf[6]=*(const __attribute__((address_space(3))) bf16x8*)(kp+6144); kf[7]=*(const __attribute__((address_space(3))) bf16x8*)(kp+6656);
}
__device__ __forceinline__ void kload2(bf16x8*kf,lds_cptr kp,int j){ kf[2*j]=*(const __attribute__((address_space(3))) bf16x8*)(kp+j*2048); kf[2*j+1]=*(const __attribute__((address_space(3))) bf16x8*)(kp+j*2048+512); }
__device__ __forceinline__ s16x4 vtr(lds_cptr p){ return __builtin_bit_cast(s16x4,__builtin_amdgcn_ds_read_tr16_b64_v4i16((__attribute__((address_space(3))) v4i16_t*)p)); }
__device__ __forceinline__ float rowmax(const f32x16&p0,const f32x16&p1){
  float a=max3f(p0[0],p0[1],p1[0]),b=max3f(p0[2],p0[3],p1[1]);a=max3f(a,p1[2],p1[3]);
  #pragma unroll
  for(int r=4;r<16;r+=4){a=max3f(a,p0[r],p0[r+1]);b=max3f(b,p0[r+2],p0[r+3]);a=max3f(a,p1[r],p1[r+1]);b=max3f(b,p1[r+2],p1[r+3]);}
  const float m=max2f(a,b);
  auto rr=__builtin_amdgcn_permlane32_swap(__float_as_uint(m),__float_as_uint(m),false,false);
  return max2f(__uint_as_float(rr[0]),__uint_as_float(rr[1]));
}
__device__ __forceinline__ void pv(f32x16*o,int vb,bf16x8 pa0,bf16x8 pa1,bf16x8 pa2,bf16x8 pa3){
  #pragma unroll
  for(int d0=0;d0<2;++d0){s16x4 lo[4],hi[4];
    #pragma unroll
    for(int ks=0;ks<4;++ks){
      asm volatile("ds_read_b64_tr_b16 %0,%1 offset:%c2":"=&v"(lo[ks]):"v"(vb),"i"(d0*4096+ks*1024):"memory");
      asm volatile("ds_read_b64_tr_b16 %0,%1 offset:%c2":"=&v"(hi[ks]):"v"(vb),"i"(d0*4096+ks*1024+512):"memory");}
    asm volatile("s_waitcnt lgkmcnt(0)":::"memory");SBAR();
    #define PK(k) (bf16x8){lo[k][0],lo[k][1],lo[k][2],lo[k][3],hi[k][0],hi[k][1],hi[k][2],hi[k][3]}
    o[d0]=__builtin_amdgcn_mfma_f32_32x32x16_bf16(pa0,PK(0),o[d0],0,0,0);
    o[d0]=__builtin_amdgcn_mfma_f32_32x32x16_bf16(pa1,PK(1),o[d0],0,0,0);
    o[d0]=__builtin_amdgcn_mfma_f32_32x32x16_bf16(pa2,PK(2),o[d0],0,0,0);
    o[d0]=__builtin_amdgcn_mfma_f32_32x32x16_bf16(pa3,PK(3),o[d0],0,0,0);
    #undef PK
  }
}

#ifndef ATTN_STORE16
#define ATTN_STORE16(p,v) (*(u32x4*)(p)=(v))
#endif
template<int THRL> __device__ __forceinline__ void attn_unit(const bf16*Qu,const bf16*__restrict__ Kh,const bf16*__restrict__ Vh,bf16*Ou,const int NT,char*shm,const float*qgain,const float*ropet,const int tq0,int tid_){
  asm volatile("":"+v"(tid_)); const int tid=tid_,lane=tid&63,r32=lane&31,hi=lane>>5; const int wid=__builtin_amdgcn_readfirstlane(tid>>6);
  const bf16*Qw=Qu+(long)(wid*QBLK)*QP;
  const unsigned lds0=(unsigned)(uintptr_t)shm;
  float*wsf=(float*)(shm+LDS_WS)+wid*64;
  const bf16*ksrc=Kh+(long)lane*KVP+wid*8;
  const bf16*vsrc=Vh+(long)(16*(wid&3)+(lane>>2))*KVP+(wid>>2)*32+(lane&3)*8;
  const unsigned kdst=lds0+LDS_K+wid*1024, vdst=lds0+LDS_V+wid*1024;
  #define DMA_K(t,slot) glds16(ksrc+(long)(t)*KVBLK*KVP,(unsigned)__builtin_amdgcn_readfirstlane(kdst+(slot)))
  #define DMA_V(t,slot) glds16(vsrc+(long)(t)*KVBLK*KVP,(unsigned)__builtin_amdgcn_readfirstlane(vdst+(slot)))
  const int vb0=(int)(lds0+LDS_V)+((lane>>4)&1)*32+(lane&3)*8+(4*hi+((lane&15)>>2))*64;
  const char*Kbase=shm+LDS_K; bf16x8 kf[8];
  const lds_cptr shm3=(lds_cptr)shm; const lds_cptr kp0=shm3+LDS_K+hi*1024+r32*16; const lds_cptr vp0=shm3+LDS_V+((lane>>4)&1)*32+(lane&3)*8+(4*hi+((lane&15)>>2))*64;
  DMA_K(0,0);DMA_V(0,0);DMA_K(1,SLOTB);
  bf16x8 qr[4];
  #pragma unroll
  for(int d0=0;d0<4;++d0)qr[d0]=*reinterpret_cast<const bf16x8*>(&Qw[(long)r32*QP+d0*16+hi*8]);
  {
    float qv[4][8]; float ss=0.f;
    #pragma unroll
    for(int d0=0;d0<4;++d0){
      #pragma unroll
      for(int e=0;e<8;++e){ qv[d0][e]=__uint_as_float(((unsigned)(unsigned short)qr[d0][e])<<16); ss+=qv[d0][e]*qv[d0][e]; } }
    { auto rr=__builtin_amdgcn_permlane32_swap(__float_as_uint(ss),__float_as_uint(ss),false,false); ss=__uint_as_float(rr[0])+__uint_as_float(rr[1]); }
    const float rs=__builtin_amdgcn_rsqf(ss*(1.0f/64.0f)+1e-6f);
    #pragma unroll
    for(int d0=0;d0<4;++d0){
      #pragma unroll
      for(int e=0;e<8;++e) qv[d0][e]*=rs*qgain[d0*16+hi*8+e]; }
    if(ropet){ const int t=tq0+wid*QBLK+r32;
      #pragma unroll
      for(int h2=0;h2<2;++h2){ const float*cs=ropet+(((h2==0)?(t>>6):(t&63))*16+hi*8)*2;
        #pragma unroll
        for(int e=0;e<8;++e){ const float c=cs[2*e],sn=cs[2*e+1]; const float x1=qv[2*h2][e],x2=qv[2*h2+1][e]; qv[2*h2][e]=x1*c-x2*sn; qv[2*h2+1][e]=x2*c+x1*sn; } } }
    #pragma unroll
    for(int d0=0;d0<4;++d0){ u32x4 w; w[0]=cvtpk_s(qv[d0][0]*C2,qv[d0][1]*C2); w[1]=cvtpk_s(qv[d0][2]*C2,qv[d0][3]*C2); w[2]=cvtpk_s(qv[d0][4]*C2,qv[d0][5]*C2); w[3]=cvtpk_s(qv[d0][6]*C2,qv[d0][7]*C2); qr[d0]=__builtin_bit_cast(bf16x8,w); }
  }
  float mhat=0.f,l_reg=0.f;f32x16 o[2];o[0]=f32x16{};o[1]=f32x16{};f32x16 negm=f32x16{};asm volatile("":"+v"(negm));
  #define CMASK(P0,P1,t) do{}while(0)
  bool resc=false;
  #define START(P0,P1) do{ const float rm=rowmax(P0,P1); resc=false; \
    { const float dl=rm; mhat=fadd_s(mhat,dl); \
      _Pragma("unroll") for(int r=0;r<16;++r){P0[r]=fsub_s(P0[r],dl);P1[r]=fsub_s(P1[r],dl);} \
      _Pragma("unroll") for(int r=0;r<16;++r)negm[r]=-mhat; asm volatile("":"+v"(negm)); } \
    _Pragma("unroll") for(int r=0;r<16;++r)P0[r]=__builtin_amdgcn_exp2f(P0[r]); }while(0)
  #define RESC() do{ if(resc){ asm volatile("s_waitcnt lgkmcnt(0)":::"memory"); \
      _Pragma("unroll") for(int d_=0;d_<2;++d_) _Pragma("unroll") for(int r=0;r<16;++r)o[d_][r]*=wsf[crow(r,hi)]; } }while(0)
  f32x16 pA0,pA1,pB0,pB1;
  int sl_prev=0,sl_cur=0,sl_next=SLOTB;
  #define ROT() do{sl_prev=sl_cur;sl_cur=sl_next;sl_next=(sl_next==(NSLOT-1)*SLOTB)?0:sl_next+SLOTB;}while(0)
  DMA_K(2,2*SLOTB);
  WAIT_BAR(3);
  qkt(pA0,pA1,Kbase,qr,negm,r32,hi);asm volatile("s_nop 15\n\ts_nop 7":"+v"(pA0),"+v"(pA1));CMASK(pA0,pA1,0);
  START(pA0,pA1);
  _Pragma("unroll") for(int r=0;r<16;++r)pA1[r]=__builtin_amdgcn_exp2f(pA1[r]);
  WAIT_BAR(0);
  DMA_K(3,0);DMA_V(1,SLOTB);
  ROT();
  kload8(kf,kp0+sl_cur);
  WAIT_BAR(2);
  s16x4 vlo[8],vhi[8]; u32x4 pw0,pw1,pw2,pw3;
  #define PKW(P,B) cvtpk_s(P[B],P[B+1])
  #define PAF(k) __builtin_bit_cast(bf16x8,pw##k)
  #define VFR(i) (bf16x8){vlo[i][0],vlo[i][1],vlo[i][2],vlo[i][3],vhi[i][0],vhi[i][1],vhi[i][2],vhi[i][3]}
  #define PIN(x) asm volatile("":"+v"(x))
  #define MX3(a,b,c) __builtin_fmaxf(__builtin_fmaxf((a),(b)),(c))
  #define GAPA(MF,A0,A1,A2,A3,W0,W1,PW) do{ MF; sacc+=A0; sacc+=A1; sacc+=A2; sacc+=A3; PIN(sacc); W0; W1; PIN(PW); SBAR(); }while(0)
  #define EX(v) __builtin_amdgcn_exp2f(v)
  #define GAPB(MF,X,B) do{ MF; X[B]=EX(X[B]); X[B+1]=EX(X[B+1]); X[B+2]=EX(X[B+2]); X[B+3]=EX(X[B+3]); PIN(X); SBAR(); }while(0)
  #define VRD(i) do{ vlo[i]=vtr(vp_+(((i)>>2)*4096+((i)&3)*1024)); vhi[i]=vtr(vp_+(((i)>>2)*4096+((i)&3)*1024+512)); }while(0)
  #define KRD(G,j) do{ if(G){ kload2(kf,kp0+sl_next,j); SBAR(); } }while(0)
  #define STEP(C0,C1,P0,P1,t,GK,GV,GL) do{ SBAR(); \
    const lds_cptr vp_=vp0+sl_prev; \
    VRD(0); SBAR(); float sacc=(P0[0]+P0[1]); \
    GAPA(C0=__builtin_amdgcn_mfma_f32_32x32x16_bf16(kf[0],qr[0],negm,0,0,0), P0[2],P0[3],P0[4],P0[5],     pw0[0]=PKW(P0,0), pw0[1]=PKW(P0,2), pw0); \
    VRD(4); SBAR(); GAPA(C1=__builtin_amdgcn_mfma_f32_32x32x16_bf16(kf[1],qr[0],negm,0,0,0), P0[6],P0[7],P0[8],P0[9],     pw0[2]=PKW(P0,4), pw0[3]=PKW(P0,6), pw0); \
    VRD(1); SBAR(); GAPA(C0=__builtin_amdgcn_mfma_f32_32x32x16_bf16(kf[2],qr[1],C0,0,0,0),   P0[10],P0[11],P0[12],P0[13], pw1[0]=PKW(P0,8), pw1[1]=PKW(P0,10), pw1); \
    VRD(5); SBAR(); GAPA(C1=__builtin_amdgcn_mfma_f32_32x32x16_bf16(kf[3],qr[1],C1,0,0,0),   P0[14],P0[15],P1[0],P1[1],   pw1[2]=PKW(P0,12),pw1[3]=PKW(P0,14), pw1); \
    VRD(2); SBAR(); GAPA(C0=__builtin_amdgcn_mfma_f32_32x32x16_bf16(kf[4],qr[2],C0,0,0,0),   P1[2],P1[3],P1[4],P1[5],     pw2[0]=PKW(P1,0), pw2[1]=PKW(P1,2), pw2); \
    VRD(6); SBAR(); GAPA(C1=__builtin_amdgcn_mfma_f32_32x32x16_bf16(kf[5],qr[2],C1,0,0,0),   P1[6],P1[7],P1[8],P1[9],     pw2[2]=PKW(P1,4), pw2[3]=PKW(P1,6), pw2); \
    VRD(3); SBAR(); GAPA(C0=__builtin_amdgcn_mfma_f32_32x32x16_bf16(kf[6],qr[3],C0,0,0,0),   P1[10],P1[11],P1[12],P1[13], pw3[0]=PKW(P1,8), pw3[1]=PKW(P1,10), pw3); \
    VRD(7); SBAR(); GAPA(C1=__builtin_amdgcn_mfma_f32_32x32x16_bf16(kf[7],qr[3],C1,0,0,0),   P1[14],P1[15],0.f,0.f,       pw3[2]=PKW(P1,12),pw3[3]=PKW(P1,14), pw3); \
    l_reg+=sacc; \
    if(GK){DMA_K((t)+3,sl_cur);} if(GV){DMA_V((t)+1,sl_next);} \
    CMASK(C0,C1,t); \
    { float a=MX3(C0[0],C0[1],C1[0]),b=MX3(C0[2],C0[3],C1[1]); a=MX3(a,C1[2],C1[3]); \
      _Pragma("unroll") for(int r=4;r<16;r+=4){a=MX3(a,C0[r],C0[r+1]);b=MX3(b,C0[r+2],C0[r+3]);a=MX3(a,C1[r],C1[r+1]);b=MX3(b,C1[r+2],C1[r+3]);} \
      float rm=__builtin_fmaxf(a,b); { auto rr=__builtin_amdgcn_permlane32_swap(__float_as_uint(rm),__float_as_uint(rm),false,false); rm=__builtin_fmaxf(__uint_as_float(rr[0]),__uint_as_float(rr[1])); } \
      resc=false; \
      if(__builtin_expect(__any(rm>(float)THRL),0)){ const float dl=__builtin_fmaxf(rm,0.f); mhat+=dl; \
        _Pragma("unroll") for(int r=0;r<16;++r){C0[r]-=dl;C1[r]-=dl;} \
        _Pragma("unroll") for(int r=0;r<16;++r)negm[r]=-mhat; asm volatile("":"+v"(negm)); \
        const float f=__builtin_amdgcn_exp2f(-dl); l_reg*=f; if(hi==0)wsf[r32]=f; resc=true; } } \
    SBAR(); \
    GAPB(o[0]=__builtin_amdgcn_mfma_f32_32x32x16_bf16(PAF(0),VFR(0),o[0],0,0,0), C0,0); \
    GAPB(o[1]=__builtin_amdgcn_mfma_f32_32x32x16_bf16(PAF(0),VFR(4),o[1],0,0,0), C0,4); \
    KRD(GL,0); GAPB(o[0]=__builtin_amdgcn_mfma_f32_32x32x16_bf16(PAF(1),VFR(1),o[0],0,0,0), C0,8); \
    KRD(GL,1); GAPB(o[1]=__builtin_amdgcn_mfma_f32_32x32x16_bf16(PAF(1),VFR(5),o[1],0,0,0), C0,12); \
    KRD(GL,2); GAPB(o[0]=__builtin_amdgcn_mfma_f32_32x32x16_bf16(PAF(2),VFR(2),o[0],0,0,0), C1,0); \
    KRD(GL,3); GAPB(o[1]=__builtin_amdgcn_mfma_f32_32x32x16_bf16(PAF(2),VFR(6),o[1],0,0,0), C1,4); \
    GAPB(o[0]=__builtin_amdgcn_mfma_f32_32x32x16_bf16(PAF(3),VFR(3),o[0],0,0,0), C1,8); \
    GAPB(o[1]=__builtin_amdgcn_mfma_f32_32x32x16_bf16(PAF(3),VFR(7),o[1],0,0,0), C1,12); \
    }while(0)
  int t=1;
  #undef CMASK
  #define CMASK(P0,P1,t) do{}while(0)
  for(;t+5<NT;t+=2){
    STEP(pB0,pB1,pA0,pA1,t,true,true,true);     WAIT_BAR(2); RESC(); ROT();
    STEP(pA0,pA1,pB0,pB1,t+1,true,true,true);   WAIT_BAR(2); RESC(); ROT();
  }
  #undef CMASK
  #define CMASK(P0,P1,t) do{}while(0)
  #define ENDW(tt) do{ if((tt)+3<NT){WAIT_BAR(2);} else if((tt)+2<NT){WAIT_BAR(1);} else {WAIT_BAR(0);} }while(0)
  for(;t+1<NT;t+=2){
    STEP(pB0,pB1,pA0,pA1,t,(t+3<NT),(t+1<NT),(t+1<NT));       ENDW(t);   RESC(); ROT();
    STEP(pA0,pA1,pB0,pB1,t+1,(t+4<NT),(t+2<NT),(t+2<NT));     ENDW(t+1); RESC(); ROT();
  }
  STEP(pB0,pB1,pA0,pA1,NT-1,false,false,false); RESC();
  { float sacc=pB0[0]+pB0[1]; _Pragma("unroll") for(int r=2;r<16;++r)sacc+=pB0[r]; _Pragma("unroll") for(int r=0;r<16;++r)sacc+=pB1[r]; l_reg+=sacc;
    pw0=(u32x4){PKW(pB0,0),PKW(pB0,2),PKW(pB0,4),PKW(pB0,6)};pw1=(u32x4){PKW(pB0,8),PKW(pB0,10),PKW(pB0,12),PKW(pB0,14)};pw2=(u32x4){PKW(pB1,0),PKW(pB1,2),PKW(pB1,4),PKW(pB1,6)};pw3=(u32x4){PKW(pB1,8),PKW(pB1,10),PKW(pB1,12),PKW(pB1,14)};
    SBAR(); pv(o,vb0+sl_cur,PAF(0),PAF(1),PAF(2),PAF(3)); }
  #undef PKW
  #undef PAF
  #undef VFR
  #undef PIN
  #undef MX3
  #undef GAPA
  #undef GAPB
  #undef EX
  #undef VRD
  #undef KRD
  #undef STEP
  #undef ENDW
  {auto rr=__builtin_amdgcn_permlane32_swap(__float_as_uint(l_reg),__float_as_uint(l_reg),false,false);l_reg=__uint_as_float(rr[0])+__uint_as_float(rr[1]);}
  if(hi==0)wsf[32+r32]=l_reg;asm volatile("s_waitcnt lgkmcnt(0)":::"memory");
  float rli[16];
  #pragma unroll
  for(int r=0;r<16;++r)rli[r]=__builtin_amdgcn_rcpf(wsf[32+crow(r,hi)]);
  bf16*Ow=Ou+(long)(wid*QBLK)*DM;
  { bf16*stg=(bf16*)(shm+LDS_OST)+wid*2048;
    #pragma unroll
    for(int r=0;r<16;++r){const int orow=crow(r,hi);
      #pragma unroll
      for(int d0=0;d0<2;++d0)stg[orow*64+d0*32+r32]=__float2bfloat16(o[d0][r]*rli[r]);}
    asm volatile("s_waitcnt lgkmcnt(0)":::"memory");
    #pragma unroll
    for(int i=0;i<4;++i){const int row=i*8+(lane>>3),ch=lane&7; const u32x4 v=*(const u32x4*)(stg+row*64+ch*8); ATTN_STORE16(Ow+(long)row*DM+ch*8,v);} }
  asm volatile("s_waitcnt lgkmcnt(0)\n\ts_barrier":::"memory");
  #undef DMA_K
  #undef DMA_V
  #undef CMASK
  #undef START
  #undef RESC
  #undef ROT
}
constexpr int ATTN_LDS_BYTES=LDS_BYTES;
#undef SBAR
#undef WAIT_BAR
}
constexpr int DM = 1024, NBATCH = 4, SEQ = 4096, CTXL = 256, NLAYER = 2;
constexpr int RLAT = NBATCH * SEQ, RCTX = NBATCH * CTXL, RT = RLAT + RCTX;
constexpr int INW = 1536, FFH = 2816, KVLEN = CTXL + SEQ, NCHK = KVLEN / 64;
constexpr int NCHUNK = RT / 64;
constexpr float RMS_EPS = 1e-6f;
constexpr int NWAVES = 8, NTHR = 512;
constexpr size_t MiB = 1u << 20;
constexpr size_t WS_CTL = 0, CTL_ZERO_BYTES = 1 * MiB;
constexpr size_t WS_WT = 1 * MiB, WT_LAYER = 21 * MiB + MiB / 2, WIN_OFF = 0, WOUT_OFF = 3 * MiB, WFI_OFF = 5 * MiB, WFO_OFF = 16 * MiB;
constexpr int MOD_SLABS = 32, MOD_ROWS = 1024 / MOD_SLABS;
constexpr size_t WS_MODP = 156 * MiB  , WS_MOD = 46 * MiB, WS_ROPE = 46 * MiB + MiB / 2, WS_AGG = 47 * MiB;
constexpr size_t WS_GWF = 48 * MiB + MiB / 2, WS_PWF = 48 * MiB + 3 * MiB / 4, WS_SPB = 49 * MiB;
constexpr size_t WS_XRC = 50 * MiB;
constexpr size_t WS_XN = 54 * MiB;
constexpr size_t WS_YO = 88 * MiB;
constexpr size_t WS_RES = 88 * MiB;
constexpr size_t WS_LRU = 0  , LRU_PLANE = 17 * MiB;
constexpr size_t WS_Y = 156 * MiB;
constexpr size_t WS_P = 190 * MiB;
constexpr size_t WS_KB = 241 * MiB, WS_VB = 245 * MiB + MiB / 4;
constexpr size_t WS_H = 156 * MiB;
constexpr size_t WS_XB = 250 * MiB, XB_BANK = 272 * 1024;
constexpr size_t WS_END = 256 * MiB;
static_assert(WS_VB + (size_t)NBATCH * KVLEN * 128 * 2 <= WS_END && WS_H + (size_t)RT * FFH * 2 <= WS_END && WS_P + (size_t)RT * INW * 2 <= WS_KB, "ws map");
constexpr int LDS_BYTES = 147456;

#define GAS __attribute__((address_space(1)))
#define LAS __attribute__((address_space(3)))
typedef unsigned short bf16;
typedef unsigned v4u __attribute__((ext_vector_type(4)));
typedef unsigned v2u __attribute__((ext_vector_type(2)));
typedef float f32x4 __attribute__((ext_vector_type(4)));
typedef float f32x2v __attribute__((ext_vector_type(2)));
typedef short bf16x8 __attribute__((ext_vector_type(8)));
typedef __bf16 bf16x2_t __attribute__((ext_vector_type(2)));
#define LDS_WAIT() asm volatile("s_waitcnt lgkmcnt(0)" ::: "memory")
__device__ __forceinline__ unsigned pk2(float lo, float hi) { f32x2v v = {lo, hi}; bf16x2_t b = __builtin_convertvector(v, bf16x2_t); return __builtin_bit_cast(unsigned, b); }
__device__ __forceinline__ float bflo(unsigned w) { return __uint_as_float(w << 16); }
__device__ __forceinline__ float bfhi(unsigned w) { return __uint_as_float(w & 0xffff0000u); }
__device__ __forceinline__ float wave_sum(float v, int lane_) {
#pragma unroll
    for (int o = 1; o < 64; o <<= 1) v += shx(v, o, lane_);
    return v;
}
__device__ __forceinline__ float sigmoid_f(float x) { return __builtin_amdgcn_rcpf(1.0f + __expf(-x)); }
__device__ __forceinline__ float gelu_tanh_f(float x) { const float t = fmaf(x * x, -2.0f * 1.4426950408889634f * 0.7978845608028654f * 0.044715f, -2.0f * 1.4426950408889634f * 0.7978845608028654f); return x * __builtin_amdgcn_rcpf(1.0f + __builtin_amdgcn_exp2f(x * t)); }

#define XB_TMO      128
#define XB_XCNT(j)  (256  + 64 * (j))
#define XB_XSUB(j)  (1280 + 64 * (j))
#define XB_XGEN(j)  (2304 + 64 * (j))
#define XB_TOP      3328
#define XB_TOPGEN   3392
#define XCD_BAR_WORDS 3456
#define XB_SPIN_CAP (1u << 18)

__device__ __forceinline__ unsigned xb_ld(unsigned* p)              { return __hip_atomic_load(p, __ATOMIC_RELAXED, __HIP_MEMORY_SCOPE_AGENT); }
__device__ __forceinline__ unsigned xb_add(unsigned* p, unsigned v) { return __hip_atomic_fetch_add(p, v, __ATOMIC_RELAXED, __HIP_MEMORY_SCOPE_AGENT); }
__device__ __forceinline__ unsigned xb_xcc_id() { return (unsigned)__builtin_amdgcn_s_getreg((3 << 11) | 20) & 0xFu; }
#define XB_SPIN(cond, bar) do { unsigned _sp = 0; while (cond) { __builtin_amdgcn_s_sleep(1); \
    if ((++_sp & 255u) == 0u) { if (xb_ld(&(bar)[XB_TMO])) break; if (_sp > XB_SPIN_CAP) { atomicAdd(&(bar)[XB_TMO], 1u); break; } } } } while (0)

struct XcdBarrier {
    unsigned* bar; unsigned x;
    volatile LAS unsigned* st;
};

__device__ __forceinline__ XcdBarrier xcd_barrier_post(unsigned* bar, volatile LAS unsigned* st, bool leader) {
    XcdBarrier b; b.bar = bar; b.x = xb_xcc_id(); b.st = st;
    if (leader) (void)xb_add(&bar[XB_XCNT(b.x)], 1u);
    return b;
}
__device__ __forceinline__ void xcd_barrier_complete(unsigned* bar, unsigned x, unsigned& nloc, unsigned& nx) {
    const unsigned G = gridDim.x * gridDim.y * gridDim.z;
    unsigned sum, cnt, mine, sp = 0u;
    for (;;) {
        sum = 0u; cnt = 0u; mine = 0u;
#pragma unroll
        for (unsigned j = 0; j < 16; ++j) { const unsigned c = xb_ld(&bar[XB_XCNT(j)]); sum += c; cnt += (c > 0u) ? 1u : 0u; mine = (j == x) ? c : mine; }
        if (sum == G) break;
        __builtin_amdgcn_s_sleep(1);
        if ((++sp & 255u) == 0u) { if (xb_ld(&bar[XB_TMO])) break; if (sp > XB_SPIN_CAP) { atomicAdd(&bar[XB_TMO], 1u); break; } }
    }
    nloc = mine > 0u ? mine : 1u; nx = cnt > 0u ? cnt : 1u;
}

__device__ __forceinline__ void xcd_barrier(const XcdBarrier& b, bool leader) {
    asm volatile("s_waitcnt vmcnt(0)" ::: "memory");
    __syncthreads();
    if (leader) {
        unsigned* bar = b.bar;
        __builtin_amdgcn_s_waitcnt(0);
        unsigned nloc = b.st[0], nx = b.st[1];
        if (nloc == 0u) { xcd_barrier_complete(bar, b.x, nloc, nx); b.st[0] = nloc; b.st[1] = nx; }
        const unsigned old = xb_add(&bar[XB_XSUB(b.x)], 1u);
        const unsigned gen = old / nloc;
        if (old + 1u == (gen + 1u) * nloc) {
            __builtin_amdgcn_fence(__ATOMIC_RELEASE, "agent");
            asm volatile("s_waitcnt vmcnt(0)" ::: "memory");
            const unsigned og = xb_add(&bar[XB_TOP], 1u);
            const unsigned tg = og / nx;
            if (og + 1u == (tg + 1u) * nx) xb_add(&bar[XB_TOPGEN], 1u);
            else XB_SPIN(xb_ld(&bar[XB_TOPGEN]) == tg, bar);
            __builtin_amdgcn_fence(__ATOMIC_ACQUIRE, "agent");
            xb_add(&bar[XB_XGEN(b.x)], 1u);
            asm volatile("s_waitcnt vmcnt(0)" ::: "memory");
        } else {
            XB_SPIN(xb_ld(&bar[XB_XGEN(b.x)]) == gen, bar);
            __builtin_amdgcn_fence(__ATOMIC_ACQUIRE, "agent");
            asm volatile("s_waitcnt vmcnt(0)" ::: "memory");
        }
    }
    __syncthreads();
}

constexpr int CW_TMO = 0, CW_SEAM = 16384, SEAM_BANK = 68 * 64;
constexpr int CW_BAR = 4096;
constexpr int MISC_OFF = LDS_BYTES - 64;
struct Params { const float* in[21]; float* out; unsigned char* ws; };
typedef const __attribute__((address_space(4))) unsigned long long* kargp_t;
__device__ __forceinline__ const float* kin(int i) { return (const float*)((kargp_t)__builtin_amdgcn_kernarg_segment_ptr())[i]; }
__device__ __forceinline__ float* kout() { return (float*)((kargp_t)__builtin_amdgcn_kernarg_segment_ptr())[21]; }
__device__ __forceinline__ unsigned char* kws() { return (unsigned char*)((kargp_t)__builtin_amdgcn_kernarg_segment_ptr())[22]; }
enum { I_X = 0, I_C, I_CTX, I_CCTX, I_WMOD, I_BMOD, I_NORMG, I_WIN, I_QNG, I_KNG, I_CONVW, I_CONVB, I_GATEW, I_GATEB, I_LAM, I_POOLW, I_POOLB, I_POOLS, I_WOUT, I_WFI, I_WFO };

__device__ __forceinline__ void transpose_item(const float* W, int K, int N, bf16* WT, int orow0, int k0, int n0, LAS float* scr, int lane) {
    float tv[32];
#pragma unroll
    for (int i = 0; i < 32; ++i) tv[i] = __builtin_nontemporal_load(W + (size_t)(k0 + 2 * i + (lane >> 5)) * N + n0 + (lane & 31));
#pragma unroll
    for (int i = 0; i < 32; ++i) scr[(2 * i + (lane >> 5)) * 33 + (lane & 31)] = tv[i];
    LDS_WAIT(); asm volatile("" ::: "memory");
    const int c = lane & 7;
#pragma unroll
    for (int j = 0; j < 4; ++j) { const int n = (lane >> 3) + 8 * j; const LAS float* s = scr + (8 * c) * 33 + n;
        v4u o; o.x = pk2(s[0 * 33], s[1 * 33]); o.y = pk2(s[2 * 33], s[3 * 33]); o.z = pk2(s[4 * 33], s[5 * 33]); o.w = pk2(s[6 * 33], s[7 * 33]);
        *(GAS v4u*)(WT + (size_t)(orow0 + n) * K + k0 + 8 * c) = o; }
    LDS_WAIT(); asm volatile("" ::: "memory");
}
__device__ __forceinline__ void phase0a(const Params& p, LAS unsigned char* lds, int tid, int lane, int wave, int vcu, int G) {
    unsigned char* ws = kws();
    { const int gt = ((tid >> 6) * (int)gridDim.x + (int)blockIdx.x) * 64 + (tid & 63);
      if (gt < 1024) { const int pos = gt >> 4, i = gt & 15; const float freq = exp2f(-(float)i * (13.287712379549449f / 16.0f)); const float ang = (float)pos * freq;
          const float k = rintf(ang * 0.15915494309189535f); float r = fmaf(-k, 6.2831855f, ang); r = fmaf(k, 1.7484555e-7f, r);
          float* rp = (float*)(ws + WS_ROPE); rp[2 * gt] = cosf(r); rp[2 * gt + 1] = sinf(r); } }
    { const int gt = ((tid >> 6) * (int)gridDim.x + (int)blockIdx.x) * 64 + (tid & 63);
      if (gt < 16384) { const int ln = gt & 63, f = gt >> 6, kk = f & 1, nt = (f >> 1) & 3, g2 = (f >> 3) & 1, n = (f >> 4) & 3, d = (f >> 6) & 1, l = f >> 7, qd = ln >> 4, l16 = ln & 15;
          const float* gw_ = kin(I_GATEW) + ((size_t)(((l * 2 + d) * 2 + g2) * 4 + n)) * 4096 + (kk * 32 + qd * 8) * 64 + nt * 16 + l16;
          v4u o; o.x = pk2(gw_[0], gw_[64]); o.y = pk2(gw_[128], gw_[192]); o.z = pk2(gw_[256], gw_[320]); o.w = pk2(gw_[384], gw_[448]);
          ((v4u*)(ws + WS_GWF))[gt] = o; }
      else if (gt < 16384 + 4096) { const int q = gt - 16384, ln = q & 63, f = q >> 6, kk = f & 1, nt = (f >> 1) & 3, lg = f >> 3, qd = ln >> 4, l16 = ln & 15;
          const float* pw = kin(I_POOLW) + (size_t)lg * 4096 + (kk * 32 + qd * 8) * 64 + nt * 16 + l16;
          v4u o; o.x = pk2(pw[0], pw[64]); o.y = pk2(pw[128], pw[192]); o.z = pk2(pw[256], pw[320]); o.w = pk2(pw[384], pw[448]);
          ((v4u*)(ws + WS_PWF))[q] = o; }
      else if (gt < 16384 + 4096 + 3072) { const int q = gt - 20480, ch = q & 255, k3 = (q >> 8) % 3, ld = q / 768;
          float v;
          if (k3 < 2) v = kin(I_GATEB)[(ld * 2 + k3) * 256 + ch]; else v = -8.0f * 1.4426950408889634f * log1pf(expf(-kin(I_LAM)[ld * 256 + ch]));
          ((float*)(ws + WS_SPB))[q] = v; } }
    LAS float* S = (LAS float*)(lds + 8 * 8448);
    for (int i = tid; i < 5 * 1024; i += NTHR) { const float v = (i < 4096) ? kin(I_C)[i] : kin(I_CCTX)[i - 4096]; S[i] = v / (1.0f + expf(-v)); }
    __syncthreads();
    LAS float* scr = (LAS float*)(lds + wave * 8448);
    constexpr int I_IN = 16 * 48, I_OUT = 16 * 32, I_FI = 16 * 176, I_FO = 44 * 32, PER = I_IN + I_OUT + I_FI + I_FO;
    constexpr int NGEMV = NLAYER * MOD_SLABS * 24;
    static_assert(NLAYER * PER == 43 * 256 && NGEMV == 6 * 256, "prologue deal assumes 256 workgroups");
    for (int q = (wave < 6 ? -1 : wave - 6); q < (wave < 6 ? 43 : 14); q = (q < 0 ? 14 + wave : q + (wave < 6 ? 6 : 2))) {
        const int it0 = q < 0 ? wave * G + vcu : NGEMV + vcu + G * q;
        if (it0 < NGEMV) {
            const int l = it0 / (MOD_SLABS * 24), rem = it0 % (MOD_SLABS * 24), slab = rem / 24, cb = rem % 24, col = cb * 256 + lane * 4;
            f32x4 a0 = {0.f, 0.f, 0.f, 0.f}, a1 = a0, a2 = a0, a3 = a0, a4 = a0;
            const float* wp = kin(I_WMOD) + ((size_t)(l * 1024 + slab * MOD_ROWS)) * 6144 + col;
#pragma unroll 8
            for (int k = 0; k < MOD_ROWS; ++k) { const f32x4 w = __builtin_nontemporal_load((const GAS f32x4*)(wp + (size_t)k * 6144)); const int kk = slab * MOD_ROWS + k;
                a0 += S[kk] * w; a1 += S[1024 + kk] * w; a2 += S[2048 + kk] * w; a3 += S[3072 + kk] * w; a4 += S[4096 + kk] * w; }
            float* o = (float*)(ws + WS_MODP) + ((size_t)((l * MOD_SLABS + slab) * 5)) * 6144 + col;
            *(f32x4*)(o) = a0; *(f32x4*)(o + 6144) = a1; *(f32x4*)(o + 2 * 6144) = a2; *(f32x4*)(o + 3 * 6144) = a3; *(f32x4*)(o + 4 * 6144) = a4;
            continue;
        }
        const int it = it0 - NGEMV;
        const int l = it / PER; int r = it % PER; unsigned char* wl = ws + WS_WT + (size_t)l * WT_LAYER;
        if (r < I_IN) { const int kb = r / 48, nb = r % 48; transpose_item(kin(I_WIN) + (size_t)l * 1024 * 1536, 1024, 1536, (bf16*)(wl + WIN_OFF), 32 * nb, 64 * kb, 32 * nb, scr, lane); continue; } r -= I_IN;
        if (r < I_OUT) { const int kb = r / 32, nb = r % 32; transpose_item(kin(I_WOUT) + (size_t)l * 1024 * 1024, 1024, 1024, (bf16*)(wl + WOUT_OFF), 32 * nb, 64 * kb, 32 * nb, scr, lane); continue; } r -= I_OUT;
        if (r < I_FI) { const int kb = r / 176, nb = r % 176; const int n0 = 32 * nb; const int j = n0 < FFH ? n0 : n0 - FFH; const int orow0 = 256 * (j / 128) + (j % 128) + (n0 < FFH ? 0 : 128);
            transpose_item(kin(I_WFI) + (size_t)l * 1024 * 5632, 1024, 5632, (bf16*)(wl + WFI_OFF), orow0, 64 * kb, n0, scr, lane); continue; } r -= I_FI;
        { const int kb = r / 32, nb = r % 32; transpose_item(kin(I_WFO) + (size_t)l * FFH * 1024, FFH, 1024, (bf16*)(wl + WFO_OFF), 32 * nb, 64 * kb, 32 * nb, scr, lane); }
    }
}
__device__ __forceinline__ void phase0b(const Params& p, int tid) {
    const int gt = ((tid >> 6) * (int)gridDim.x + (int)blockIdx.x) * 64 + (tid & 63);
    if (gt < NLAYER * 5 * 6144) {
        const int l = gt / 30720, rem = gt % 30720, r = rem / 6144, j = rem % 6144, c = j >> 10, col = j & 1023;
        const float* modp = (const float*)(kws() + WS_MODP);
        float raw = kin(I_BMOD)[l * 6144 + j];
#pragma unroll
        for (int s = 0; s < MOD_SLABS; ++s) raw += modp[((size_t)((l * MOD_SLABS + s) * 5 + r)) * 6144 + j];
        const float* ng = kin(I_NORMG) + l * 4096;
        float val = raw;
        if (c == 1) val = ng[col] * (1.0f + raw); else if (c == 2) val = raw * ng[1024 + col]; else if (c == 4) val = ng[2048 + col] * (1.0f + raw); else if (c == 5) val = raw * ng[3072 + col];
        ((float*)(kws() + WS_MOD))[gt] = val;
    }
}
template <bool HAS_YO, bool HAS_NEXT>
__device__ __forceinline__ void norm_phase(const float* yo, const float* src_lat, const float* src_ctx, float* dst_lat, float* dst_ctx,
                                           const float* modG, const float* modA, const float* modS, bf16* XN, int nrows, int gw, int NGW, int lane) {
    asm volatile("" : "+v"(lane));
    for (int m = gw; m < nrows; m += NGW) {
        const int r = m < RLAT ? (m >> 12) : 4;
        const float* src = m < RLAT ? src_lat + (size_t)m * DM : src_ctx + (size_t)(m - RLAT) * DM;
        f32x4 v[4];
#pragma unroll
        for (int j = 0; j < 4; ++j) v[j] = __builtin_nontemporal_load((const GAS f32x4*)(src + 4 * lane + 256 * j));
        if (HAS_YO) {
            f32x4 y[4]; float ss = 0.f;
#pragma unroll
            for (int j = 0; j < 4; ++j) { y[j] = *(const GAS f32x4*)(yo + (size_t)m * DM + 4 * lane + 256 * j); ss += (y[j].x * y[j].x + y[j].y * y[j].y) + (y[j].z * y[j].z + y[j].w * y[j].w); }
            const float rs = rsqrtf(wave_sum(ss, lane) * (1.0f / DM) + RMS_EPS);
            float* dst = m < RLAT ? dst_lat + (size_t)m * DM : dst_ctx + (size_t)(m - RLAT) * DM;
#pragma unroll
            for (int j = 0; j < 4; ++j) { const f32x4 g = *(const GAS f32x4*)(modG + r * 6144 + 4 * lane + 256 * j); v[j] += g * y[j] * rs; *(GAS f32x4*)(dst + 4 * lane + 256 * j) = v[j]; }
        }
        if (HAS_NEXT) {
            float ss = 0.f;
#pragma unroll
            for (int j = 0; j < 4; ++j) ss += (v[j].x * v[j].x + v[j].y * v[j].y) + (v[j].z * v[j].z + v[j].w * v[j].w);
            const float rs = rsqrtf(wave_sum(ss, lane) * (1.0f / DM) + RMS_EPS);
#pragma unroll
            for (int j = 0; j < 4; ++j) { const f32x4 a = *(const GAS f32x4*)(modA + r * 6144 + 4 * lane + 256 * j), s = *(const GAS f32x4*)(modS + r * 6144 + 4 * lane + 256 * j);
                const f32x4 o = v[j] * rs * a + s; v2u w; w.x = pk2(o.x, o.y); w.y = pk2(o.z, o.w); *(GAS v2u*)(XN + (size_t)m * DM + 4 * lane + 256 * j) = w; }
        }
    }
}
__device__ __forceinline__ void xn0_slot_phase(LAS unsigned char* lds, int tid, int wave, int vcu) {
    asm volatile("" : "+v"(tid)); const int lane = tid & 63;
    const bool lat = vcu < 240; const int slot = lat ? vcu / 60 : 4, w = lat ? vcu % 60 : vcu - 240, nw = lat ? 60 : 16, nrows = lat ? SEQ : RCTX;
    LAS float* AS = (LAS float*)lds;
    {   const float* modp = (const float*)(kws() + WS_MODP);
        for (int col = tid; col < 1024; col += NTHR) {
            float r0 = kin(I_BMOD)[col], r1 = kin(I_BMOD)[1024 + col];
#pragma unroll 16
            for (int s = 0; s < MOD_SLABS; ++s) { const float* q = modp + ((size_t)(s * 5 + slot)) * 6144 + col; r0 += q[0]; r1 += q[1024]; }
            AS[col] = kin(I_NORMG)[col] * (1.0f + r1); AS[1024 + col] = r0; } }
    __syncthreads();
    const float* src = lat ? kin(I_X) + (size_t)slot * SEQ * DM : kin(I_CTX);
    bf16* dstn = (bf16*)(kws() + WS_XN) + (size_t)(lat ? slot * SEQ : RLAT) * DM;
    f32x4 a[4], sh[4];
#pragma unroll
    for (int j = 0; j < 4; ++j) { a[j] = *(const LAS f32x4*)(AS + 4 * lane + 256 * j); sh[j] = *(const LAS f32x4*)(AS + 1024 + 4 * lane + 256 * j); }
    for (int i = w + nw * wave; i < nrows; i += nw * NWAVES) {
        f32x4 v[4]; float ss = 0.f;
#pragma unroll
        for (int j = 0; j < 4; ++j) v[j] = __builtin_nontemporal_load((const GAS f32x4*)(src + (size_t)i * DM + 4 * lane + 256 * j));
#pragma unroll
        for (int j = 0; j < 4; ++j) ss += (v[j].x * v[j].x + v[j].y * v[j].y) + (v[j].z * v[j].z + v[j].w * v[j].w);
        const float rs = rsqrtf(wave_sum(ss, lane) * (1.0f / DM) + RMS_EPS);
#pragma unroll
        for (int j = 0; j < 4; ++j) { const f32x4 o = v[j] * rs * a[j] + sh[j]; v2u wv; wv.x = pk2(o.x, o.y); wv.y = pk2(o.z, o.w); *(GAS v2u*)(dstn + (size_t)i * DM + 4 * lane + 256 * j) = wv; }
    }
    __syncthreads();
}
__device__ __forceinline__ void ctx_norm(const float* slabs, int nslab, const float* src, float* dst, const float* vG, const float* vA, const float* vS, bf16* XNc, int gw, int NGW, int lane) {
    asm volatile("" : "+v"(lane));
    for (int m = gw; m < RCTX; m += NGW) {
        f32x4 v[4], g[4], a[4], sh[4];
#pragma unroll
        for (int j = 0; j < 4; ++j) { v[j] = __builtin_nontemporal_load((const GAS f32x4*)(src + (size_t)m * DM + 4 * lane + 256 * j)); g[j] = *(const GAS f32x4*)(vG + 4 * lane + 256 * j);
            a[j] = *(const GAS f32x4*)(vA + 4 * lane + 256 * j); sh[j] = *(const GAS f32x4*)(vS + 4 * lane + 256 * j); }
        f32x4 y[4] = {{0.f, 0.f, 0.f, 0.f}, {0.f, 0.f, 0.f, 0.f}, {0.f, 0.f, 0.f, 0.f}, {0.f, 0.f, 0.f, 0.f}};
        const float* sp = slabs + (size_t)m * DM + 4 * lane;
        for (int s0 = 0; s0 < nslab; s0 += 6) {
            f32x4 t[6][4];
#pragma unroll
            for (int s = 0; s < 6; ++s)
#pragma unroll
                for (int j = 0; j < 4; ++j) t[s][j] = (s0 + s < nslab) ? __builtin_nontemporal_load((const GAS f32x4*)(sp + (size_t)(s0 + s) * RCTX * DM + 256 * j)) : (f32x4){0.f, 0.f, 0.f, 0.f};
#pragma unroll
            for (int s = 0; s < 6; ++s)
#pragma unroll
                for (int j = 0; j < 4; ++j) y[j] += t[s][j]; }
        float ss = 0.f;
#pragma unroll
        for (int j = 0; j < 4; ++j) ss += (y[j].x * y[j].x + y[j].y * y[j].y) + (y[j].z * y[j].z + y[j].w * y[j].w);
        const float rs = rsqrtf(wave_sum(ss, lane) * (1.0f / DM) + RMS_EPS);
        float s2 = 0.f;
#pragma unroll
        for (int j = 0; j < 4; ++j) { v[j] += g[j] * y[j] * rs;
            *(GAS f32x4*)(dst + (size_t)m * DM + 4 * lane + 256 * j) = v[j]; s2 += (v[j].x * v[j].x + v[j].y * v[j].y) + (v[j].z * v[j].z + v[j].w * v[j].w); }
        const float rs2 = rsqrtf(wave_sum(s2, lane) * (1.0f / DM) + RMS_EPS);
#pragma unroll
        for (int j = 0; j < 4; ++j) { const f32x4 o = v[j] * rs2 * a[j] + sh[j]; v2u w; w.x = pk2(o.x, o.y); w.y = pk2(o.z, o.w); *(GAS v2u*)(XNc + (size_t)m * DM + 4 * lane + 256 * j) = w; }
    }
}
struct ChunkInfo { int row0, t0, L, b, isctx, cpos; };
__device__ __forceinline__ ChunkInfo chunk_info(int c) {
    ChunkInfo ci;
    if (c < RLAT / 64) { ci.b = c >> 6; const int j = c & 63; ci.t0 = j * 64; ci.row0 = ci.b * SEQ + ci.t0; ci.L = SEQ; ci.isctx = 0; ci.cpos = 4 + j; }
    else { const int cc = c - RLAT / 64; ci.b = cc >> 2; const int j = cc & 3; ci.t0 = j * 64; ci.row0 = RLAT + ci.b * CTXL + ci.t0; ci.L = CTXL; ci.isctx = 1; ci.cpos = j; }
    return ci;
}
constexpr int LROW = 264;
__device__ __forceinline__ void qk_norm_rope(float (&v)[8], const float* gain8, const float* rope, int s, int t, bool do_rope, int lane_) {
    float ss = 0.f;
#pragma unroll
    for (int e = 0; e < 8; ++e) ss += v[e] * v[e];
    ss += shx(ss, 1, lane_); ss += shx(ss, 2, lane_); ss += shx(ss, 4, lane_);
    const float rs = __builtin_amdgcn_rsqf(ss * (1.0f / 64.0f) + RMS_EPS);
#pragma unroll
    for (int e = 0; e < 8; ++e) v[e] *= rs * gain8[e];
    const int pos = (s < 4) ? (t >> 6) : (t & 63);
    const float* cs = rope + (pos * 16 + (s & 1) * 8) * 2;
    float pv[8];
#pragma unroll
    for (int e = 0; e < 8; ++e) pv[e] = shx(v[e], 2, lane_);
    if (do_rope) {
#pragma unroll
        for (int e4 = 0; e4 < 4; ++e4) { const f32x4 q = *(const GAS f32x4*)(cs + 4 * e4);
            const int e = 2 * e4;
            if (s & 2) { v[e] = v[e] * q.x + pv[e] * q.y; v[e + 1] = v[e + 1] * q.z + pv[e + 1] * q.w; }
            else       { v[e] = v[e] * q.x - pv[e] * q.y; v[e + 1] = v[e + 1] * q.z - pv[e + 1] * q.w; } }
    }
}
__device__ __forceinline__ void unpack8(const v4u w, float (&v)[8]) { v[0] = bflo(w.x); v[1] = bfhi(w.x); v[2] = bflo(w.y); v[3] = bfhi(w.y); v[4] = bflo(w.z); v[5] = bfhi(w.z); v[6] = bflo(w.w); v[7] = bfhi(w.w); }
__device__ __forceinline__ v4u pack8(const float (&v)[8]) { v4u w; w.x = pk2(v[0], v[1]); w.y = pk2(v[2], v[3]); w.z = pk2(v[4], v[5]); w.w = pk2(v[6], v[7]); return w; }

__device__ __forceinline__ void mixprep_chunk(const Params& p, int layer, int c, int smask, LAS unsigned char* lds, int tid, int lane, int wave) {
    asm volatile("" : "+v"(tid)); lane = tid & 63;
    const ChunkInfo ci = chunk_info(c);
    unsigned char* ws = kws();
    const bf16* P = (const bf16*)(ws + WS_P); bf16* Y = (bf16*)(ws + WS_Y);
    const float* rope = (const float*)(ws + WS_ROPE);
    const int quad = lane >> 4, l16 = lane & 15;
    v4u wB[5], wC[5], kraw[2], vraw[2];
    if (smask & 2) {
#pragma unroll
        for (int i = 0; i < 5; ++i) { const int idx = tid + i * NTHR, rr = idx >> 5, c8 = idx & 31; const int t = ci.t0 - 8 + rr;
            wB[i] = (v4u){0u, 0u, 0u, 0u};
            if (t >= 0 && t < ci.L) wB[i] = __builtin_nontemporal_load((const GAS v4u*)(P + ((size_t)ci.row0 - 8 + rr) * INW + 1280 + c8 * 8)); } }
    if (smask & 4) {
#pragma unroll
        for (int i = 0; i < 5; ++i) { const int idx = tid + i * NTHR, rr = idx >> 5, c8 = idx & 31; const int t = ci.t0 - 2 + rr;
            wC[i] = (v4u){0u, 0u, 0u, 0u};
            if (idx < 67 * 32 && t >= 0 && t < ci.L) wC[i] = __builtin_nontemporal_load((const GAS v4u*)(P + ((size_t)ci.row0 - 2 + rr) * INW + 768 + c8 * 8)); } }
    if (smask & 1) {   const int s = lane & 7;
#pragma unroll
        for (int ps = 0; ps < 2; ++ps) { const int idx = ps * NTHR + tid, tok = idx >> 4, s16 = idx & 15; const size_t row = (size_t)ci.row0 + tok;
            kraw[ps] = __builtin_nontemporal_load((const GAS v4u*)(P + row * INW + 512 + s16 * 8)); vraw[ps] = __builtin_nontemporal_load((const GAS v4u*)(P + row * INW + 640 + s16 * 8)); }
        float gk[8];
#pragma unroll
        for (int e = 0; e < 8; ++e) gk[e] = kin(I_KNG)[layer * 64 + s * 8 + e];
#pragma unroll
        for (int ps = 0; ps < 2; ++ps) { const int idx = ps * NTHR + tid, tok = idx >> 4; const int t = ci.t0 + tok;
            float v[8]; unpack8(kraw[ps], v);
            qk_norm_rope(v, gk, rope, s, t, !ci.isctx, lane);
            kraw[ps] = pack8(v); }
        bf16* KB = (bf16*)(ws + WS_KB); bf16* VB = (bf16*)(ws + WS_VB);
#pragma unroll
        for (int ps = 0; ps < 2; ++ps) { const int idx = ps * NTHR + tid, tok = idx >> 4, s16 = idx & 15; const int t = ci.t0 + tok;
            const size_t krow = (size_t)ci.b * KVLEN + (ci.isctx ? t : CTXL + t);
            *(GAS v4u*)(KB + krow * 128 + s16 * 8) = kraw[ps]; *(GAS v4u*)(VB + krow * 128 + s16 * 8) = vraw[ps]; }
    }
    if (smask & 2) {   LAS bf16* PX = (LAS bf16*)lds;
        LAS bf16* DB = (LAS bf16*)(lds + 45056);
#pragma unroll
        for (int i = 0; i < 5; ++i) { const int idx = tid + i * NTHR, rr = idx >> 5, c8 = idx & 31; *(LAS v4u*)(PX + rr * LROW + c8 * 8) = wB[i]; }
        __syncthreads();
        {   const int cp = tid & 127, tg = tid >> 7, g = cp >> 5, half = 1 << g;
            const LAS unsigned* PXw = (const LAS unsigned*)PX;
            float s0 = 0.f, s1 = 0.f;
            for (int rr = tg * 16 - half + 8; rr < tg * 16 + half + 8; ++rr) { const unsigned w = PXw[rr * (LROW / 2) + cp]; s0 += bflo(w); s1 += bfhi(w); }
#pragma unroll 4
            for (int i = 0; i < 16; ++i) { const int tok = tg * 16 + i, t = ci.t0 + tok;
                const int lo = max(t - half, 0), hi = min(t + half, ci.L); const float icnt = __builtin_amdgcn_rcpf((float)(hi - lo));
                const unsigned w = PXw[(tok + 8) * (LROW / 2) + cp];
                const float d0 = s0 * icnt - bflo(w), d1 = s1 * icnt - bfhi(w);
                ((LAS unsigned*)DB)[tok * (LROW / 2) + cp] = pk2(d0, d1);
                const unsigned wa = PXw[(tok + half + 8) * (LROW / 2) + cp], wr_ = PXw[(tok - half + 8) * (LROW / 2) + cp];
                s0 += bflo(wa) - bflo(wr_); s1 += bfhi(wa) - bfhi(wr_); }
        }
        __syncthreads();
        {   const int g = wave & 3, th = wave >> 2;
            const GAS v4u* pwf = (const GAS v4u*)(ws + WS_PWF) + (size_t)((layer * 4 + g) * 8) * 64 + lane;
            bf16x8 wf[4][2];
#pragma unroll
            for (int nt = 0; nt < 4; ++nt)
#pragma unroll
                for (int kk = 0; kk < 2; ++kk) wf[nt][kk] = __builtin_bit_cast(bf16x8, pwf[(nt * 2 + kk) * 64]);
            f32x4 pbv[4], psv[4];
#pragma unroll
            for (int nt = 0; nt < 4; ++nt) { pbv[nt] = *(const GAS f32x4*)(kin(I_POOLB) + layer * 256 + g * 64 + nt * 16 + quad * 4); psv[nt] = *(const GAS f32x4*)(kin(I_POOLS) + layer * 256 + g * 64 + nt * 16 + quad * 4); }
#pragma unroll
            for (int mi = 0; mi < 2; ++mi) { const int mt = th * 2 + mi;
                bf16x8 af[2];
#pragma unroll
                for (int kk = 0; kk < 2; ++kk) af[kk] = *(const LAS bf16x8*)(DB + (mt * 16 + l16) * LROW + g * 64 + kk * 32 + quad * 8);
                const size_t row = (size_t)ci.row0 + mt * 16 + l16;
#pragma unroll
                for (int nt = 0; nt < 4; ++nt) { f32x4 acc = {0.f, 0.f, 0.f, 0.f};
                    acc = __builtin_amdgcn_mfma_f32_16x16x32_bf16(wf[nt][0], af[0], acc, 0, 0, 0);
                    acc = __builtin_amdgcn_mfma_f32_16x16x32_bf16(wf[nt][1], af[1], acc, 0, 0, 0);
                    const int ch = g * 64 + nt * 16 + quad * 4;
                    const f32x4 o = (acc + pbv[nt]) * psv[nt]; v2u w; w.x = pk2(o.x, o.y); w.y = pk2(o.z, o.w);
                    *(GAS v2u*)(Y + row * DM + 768 + ch) = w; } }
        }
        __syncthreads();
    }
    if (smask & 4) {   LAS bf16* LX = (LAS bf16*)lds;
        LAS bf16* UB = (LAS bf16*)(lds + 35840);
        LAS float* SC = (LAS float*)(lds + 69632 + wave * 8704);
#pragma unroll
        for (int i = 0; i < 5; ++i) { const int idx = tid + i * NTHR, rr = idx >> 5, c8 = idx & 31; if (idx < 67 * 32) *(LAS v4u*)(LX + rr * LROW + c8 * 8) = wC[i]; }
        __syncthreads();
        {   const int cp = tid & 127, tg = tid >> 7;
            const float* cw = kin(I_CONVW) + layer * 1024; const float* cb = kin(I_CONVB) + layer * 256;
            float w0[4], w1[4];
#pragma unroll
            for (int k = 0; k < 4; ++k) { w0[k] = cw[k * 256 + 2 * cp]; w1[k] = cw[k * 256 + 2 * cp + 1]; }
            const float b0 = cb[2 * cp], b1 = cb[2 * cp + 1];
            const LAS unsigned* LXw = (const LAS unsigned*)LX;
#pragma unroll 4
            for (int i = 0; i < 16; ++i) { const int tok = tg * 16 + i; float u0 = b0, u1 = b1;
#pragma unroll
                for (int k = 0; k < 4; ++k) { const unsigned w = LXw[(tok + k) * (LROW / 2) + cp]; u0 += bflo(w) * w0[k]; u1 += bfhi(w) * w1[k]; }
                ((LAS unsigned*)UB)[tok * (LROW / 2) + cp] = pk2(u0, u1); }
        }
        __syncthreads();
        {   const int d = wave >> 2, n = wave & 3;
            const GAS v4u* gwf = (const GAS v4u*)(ws + WS_GWF) + (size_t)(((layer * 2 + d) * 4 + n) * 16) * 64 + lane;
            const GAS float* spb = (const GAS float*)(ws + WS_SPB) + (layer * 2 + d) * 768 + n * 64 + quad * 4;
            bf16x8 wf[2][4][2]; f32x4 brv[4], biv[4], spv[4];
#pragma unroll
            for (int gt = 0; gt < 2; ++gt)
#pragma unroll
                for (int nt = 0; nt < 4; ++nt)
#pragma unroll
                    for (int kk = 0; kk < 2; ++kk) wf[gt][nt][kk] = __builtin_bit_cast(bf16x8, gwf[((gt * 4 + nt) * 2 + kk) * 64]);
#pragma unroll
            for (int nt = 0; nt < 4; ++nt) { brv[nt] = *(const GAS f32x4*)(spb + nt * 16); biv[nt] = *(const GAS f32x4*)(spb + 256 + nt * 16); spv[nt] = *(const GAS f32x4*)(spb + 512 + nt * 16); }
            float h = 0.f, ap = 1.f;
            unsigned* HA = (unsigned*)((unsigned char*)kout() + WS_LRU + (size_t)d * LRU_PLANE);
#pragma unroll 1
            for (int q = 0; q < 4; ++q) { const int mt = d ? 3 - q : q; asm volatile("" ::: "memory");
                bf16x8 af[2];
#pragma unroll
                for (int kk = 0; kk < 2; ++kk) af[kk] = *(const LAS bf16x8*)(UB + (mt * 16 + l16) * LROW + n * 64 + kk * 32 + quad * 8);
#pragma unroll
                for (int nt = 0; nt < 4; ++nt) { f32x4 ar = brv[nt], ai = biv[nt];
                    ar = __builtin_amdgcn_mfma_f32_16x16x32_bf16(wf[0][nt][0], af[0], ar, 0, 0, 0); ar = __builtin_amdgcn_mfma_f32_16x16x32_bf16(wf[0][nt][1], af[1], ar, 0, 0, 0);
                    ai = __builtin_amdgcn_mfma_f32_16x16x32_bf16(wf[1][nt][0], af[0], ai, 0, 0, 0); ai = __builtin_amdgcn_mfma_f32_16x16x32_bf16(wf[1][nt][1], af[1], ai, 0, 0, 0);
                    const v2u xw = *(const LAS v2u*)(UB + (mt * 16 + l16) * LROW + n * 64 + nt * 16 + quad * 4);
                    const float xv[4] = {bflo(xw.x), bfhi(xw.x), bflo(xw.y), bfhi(xw.y)};
                    f32x4 av, uv;
#pragma unroll
                    for (int j = 0; j < 4; ++j) { const float r = __builtin_amdgcn_rcpf(1.0f + __builtin_amdgcn_exp2f(-1.4426950408889634f * ar[j])), ig = __builtin_amdgcn_rcpf(1.0f + __builtin_amdgcn_exp2f(-1.4426950408889634f * ai[j]));
                        const float a = __builtin_amdgcn_exp2f(r * spv[nt][j]);
                        av[j] = a; uv[j] = __builtin_amdgcn_sqrtf(fmaf(-a, a, 1.0f)) * (ig * xv[j]); }
                    *(LAS f32x4*)(SC + l16 * 68 + nt * 16 + quad * 4) = av; *(LAS f32x4*)(SC + 1088 + l16 * 68 + nt * 16 + quad * 4) = uv; }
                LDS_WAIT(); asm volatile("" ::: "memory");
#pragma unroll 4
                for (int s = 0; s < 16; ++s) { const int tt = d ? 15 - s : s; const float a = SC[tt * 68 + lane], u = SC[1088 + tt * 68 + lane];
                    h = a * h + u; ap *= a; const size_t o = ((size_t)ci.row0 + mt * 16 + tt) * 256 + n * 64 + lane; HA[o] = pk2(h, ap); }
                LDS_WAIT(); asm volatile("" ::: "memory");
            }
            f32x2v* agg = (f32x2v*)(ws + WS_AGG); agg[((size_t)((d * NBATCH + ci.b) * NCHK + ci.cpos)) * 256 + n * 64 + lane] = (f32x2v){ap, h};
        }
        __syncthreads();
    }
}
__device__ __forceinline__ void fixup_chunk(const Params& p, int c, LAS unsigned char* lds, int tid) {
    asm volatile("" : "+v"(tid));
    const ChunkInfo ci = chunk_info(c);
    unsigned char* ws = kws();
    LAS float* CR = (LAS float*)lds;
    {   const int d = tid >> 8, ch = tid & 255;
        const f32x2v* agg = (const f32x2v*)(ws + WS_AGG) + ((size_t)((d * NBATCH + ci.b) * NCHK)) * 256 + ch;
        float s = 0.f;
        const int n = (d == 0) ? ci.cpos : (ci.isctx ? 3 - ci.cpos : 71 - ci.cpos);
        for (int k0 = 0; k0 < n; k0 += 24) {
            f32x2v ah[24];
#pragma unroll
            for (int j = 0; j < 24; ++j) { const int k = k0 + j; const int i = (d == 0) ? k : (k < 4 ? 3 - k : 71 - k);
                ah[j] = (k < n) ? agg[(size_t)i * 256] : (f32x2v){1.0f, 0.0f}; }
#pragma unroll
            for (int j = 0; j < 24; ++j) s = ah[j].x * s + ah[j].y;
        }
        CR[tid] = s;
    }
    __syncthreads();
    {   const unsigned* HAF = (const unsigned*)((unsigned char*)kout() + WS_LRU); const unsigned* HAB = (const unsigned*)((unsigned char*)kout() + WS_LRU + LRU_PLANE);
        bf16* Y = (bf16*)(ws + WS_Y);
        const int c4 = tid & 63; const f32x4 cf = *(const LAS f32x4*)(CR + 4 * c4), cb = *(const LAS f32x4*)(CR + 256 + 4 * c4);
#pragma unroll 2
        for (int it = 0; it < 8; ++it) { const int tok = it * 8 + (tid >> 6); const size_t row = (size_t)ci.row0 + tok; const size_t o = row * 256 + 4 * c4;
            const v4u fw = __builtin_nontemporal_load((const GAS v4u*)(HAF + o)), bw = __builtin_nontemporal_load((const GAS v4u*)(HAB + o));
            const f32x4 hf = {bflo(fw.x), bflo(fw.y), bflo(fw.z), bflo(fw.w)}, af = {bfhi(fw.x), bfhi(fw.y), bfhi(fw.z), bfhi(fw.w)};
            const f32x4 hb = {bflo(bw.x), bflo(bw.y), bflo(bw.z), bflo(bw.w)}, ab = {bfhi(bw.x), bfhi(bw.y), bfhi(bw.z), bfhi(bw.w)};
            const v2u gw_ = __builtin_nontemporal_load((const GAS v2u*)((const bf16*)(ws + WS_P) + row * INW + 1024 + 4 * c4));
            const f32x4 hs = (hf + af * cf) + (hb + ab * cb);
            v2u w; w.x = pk2(gelu_tanh_f(bflo(gw_.x)) * hs.x, gelu_tanh_f(bfhi(gw_.x)) * hs.y); w.y = pk2(gelu_tanh_f(bflo(gw_.y)) * hs.z, gelu_tanh_f(bfhi(gw_.y)) * hs.w);
            *(GAS v2u*)(Y + row * DM + 512 + 4 * c4) = w; }
    }
    __syncthreads();
}
#ifndef ATTN_OUT
#define ATTN_OUT(Qu, k) (Qu)
#endif
__global__ void __launch_bounds__(NTHR, 2) hybrid_fwd(Params p) {
    extern __shared__ __attribute__((aligned(16))) unsigned char lds_raw[];
    cg::grid_group grid = cg::this_grid();
    LAS unsigned char* lds = (LAS unsigned char*)lds_raw;
    const int wave = __builtin_amdgcn_readfirstlane((int)threadIdx.x >> 6);
#define lane hw_lane()
#define tid (wave * 64 + lane)
    const int G = gridDim.x; const int bx = blockIdx.x; const int vcu = (G % 8 == 0) ? (bx % 8) * (G / 8) + bx / 8 : bx;
    const int gw = vcu * NWAVES + wave, NGW = G * NWAVES;
    unsigned char* ws = kws();
    bf16* XN = (bf16*)(ws + WS_XN); float* YO = kout();     float* XRC = (float*)(ws + WS_XRC);
    const float* MOD = (const float*)(ws + WS_MOD);
    unsigned* ctl = (unsigned*)(ws + WS_CTL);

    if (tid < 16) ((LAS unsigned*)(lds + MISC_OFF))[tid] = 0u;
    __syncthreads();
    (void)xcd_barrier_post((unsigned*)(kws() + WS_CTL) + CW_BAR, (volatile LAS unsigned*)(lds + MISC_OFF), wave == 0 && lane == 0);
#define GRID_BAR() do { XcdBarrier b_; b_.bar = (unsigned*)(kws() + WS_CTL) + CW_BAR; b_.x = xb_xcc_id(); b_.st = (volatile LAS unsigned*)(lds + MISC_OFF); xcd_barrier(b_, wave == 0 && lane == 0); } while (0)
    if (__builtin_expect(gridDim.x > 1000000u, 0)) grid.sync();
    phase0a(p, lds, tid, lane, wave, vcu, G);
    GRID_BAR();
    xn0_slot_phase(lds, tid, wave, vcu);
    phase0b(p, tid);
    GRID_BAR();
#pragma unroll 1
    for (int layer = 0; layer < NLAYER; ++layer) {
        const bool last = (layer == NLAYER - 1);
        unsigned char* wl = ws + WS_WT + (size_t)layer * WT_LAYER;
        const float* MODL = MOD + layer * 30720;
        const int Mrows = last ? RLAT : RT;
        {   pg8::Gemm g{XN, (const bf16*)(wl + WIN_OFF), RT, INW, DM, DM}; pg8::StaticOrder S; S.init(RT, INW, G, bx);
            pg8::EpiBf16 E{(bf16*)(ws + WS_P), INW};
            pg8::gemm_phase<pg8::EpiBf16, pg8::StaticOrder, true, true>(lds, g, S, E, tid); }
        GRID_BAR();
        for (int it = vcu; it < RLAT / 64 + 3 * (RCTX / 64); it += G) {
            const int j = it - RLAT / 64; const int c = j < 0 ? it : RLAT / 64 + j / 3; const int sm = j < 0 ? 7 : (1 << (j % 3));
            mixprep_chunk(p, layer, c, sm, lds, tid, lane, wave); }
        GRID_BAR();
        {   const bf16* Y = (const bf16*)(ws + WS_Y); const bf16* KB = (const bf16*)(ws + WS_KB); const bf16* VB = (const bf16*)(ws + WS_VB);
#pragma unroll 1
            for (int k = 0; k < 3; ++k) {
                size_t qrow; int b, hq, nt;
                if (k < 2) { const int u = (vcu >> 5) * 64 + (vcu & 31) + 32 * k; const int bk = u >> 6, idx = u & 63; b = bk >> 1; hq = (bk & 1) * 4 + (idx >> 4); qrow = (size_t)b * SEQ + (idx & 15) * 256; nt = NCHK; }
                else { if (last || vcu < 32 || vcu >= 64) break; const int u = vcu - 32; b = u >> 3; hq = u & 7; qrow = (size_t)RLAT + b * CTXL; nt = 4; }
                const bf16* Qu = (const bf16*)(ws + WS_P) + qrow * INW + hq * 64; const bf16* Ou = Y + qrow * DM + hq * 64; const size_t kvo = (size_t)b * KVLEN * 128 + (hq >> 2) * 64;
                attn_body::attn_unit<8>((const attn_body::bf16*)Qu, (const attn_body::bf16*)(KB + kvo), (const attn_body::bf16*)(VB + kvo), (attn_body::bf16*)ATTN_OUT(Ou, k), nt, (char*)lds_raw,
                                        kin(I_QNG) + layer * 64, k < 2 ? (const float*)(ws + WS_ROPE) : nullptr, (int)(qrow & (SEQ - 1)), tid);
            }
            const int nfix = last ? RLAT / 64 : NCHUNK;
            for (int c = vcu; c < nfix; c += G) fixup_chunk(p, c, lds, tid);
        }
        GRID_BAR();
        {   pg8::Gemm g{(const bf16*)(ws + WS_Y), (const bf16*)(wl + WOUT_OFF), RLAT, DM, DM, DM}; pg8::StaticOrder S; S.init(RLAT, DM, G, bx);
            pg8::PanelSumSq st1{(float*)(ws + WS_XB + (size_t)(layer * 4 + 0) * XB_BANK), ctl + CW_SEAM + (layer * 4 + 0) * SEAM_BANK, ctl + CW_TMO};
            pg8::PanelSumSq st2{(float*)(ws + WS_XB + (size_t)(layer * 4 + 1) * XB_BANK), ctl + CW_SEAM + (layer * 4 + 1) * SEAM_BANK, ctl + CW_TMO};
            if (layer == 0) { pg8::EpiRmsRes<true, false, true> E{kin(I_X), ws + WS_RES, XN, MODL + 2 * 1024, MODL + 4 * 1024, MODL + 3 * 1024, st1, st2};
                pg8::gemm_phase<pg8::EpiRmsRes<true, false, true>, pg8::StaticOrder, false, true>(lds, g, S, E, tid); }
            else { pg8::EpiRmsRes<true, true, true> E{ws + WS_RES, ws + WS_RES, XN, MODL + 2 * 1024, MODL + 4 * 1024, MODL + 3 * 1024, st1, st2};
                pg8::gemm_phase<pg8::EpiRmsRes<true, true, true>, pg8::StaticOrder, false, true>(lds, g, S, E, tid); } }
        if (!last) {
            __syncthreads();
            {   pg8::Gemm g{(const bf16*)(ws + WS_Y) + (size_t)RLAT * DM, (const bf16*)(wl + WOUT_OFF), RCTX, DM, 256, DM}; pg8::SplitKOrder S; S.init(RCTX, DM, 4, 256, G, bx);
                pg8::EpiF32Slab E{YO, DM, (size_t)RCTX * DM};
                pg8::gemm_phase<pg8::EpiF32Slab, pg8::SplitKOrder, true, true>(lds, g, S, E, tid); }
            GRID_BAR();
            ctx_norm(YO, 4, kin(I_CTX), XRC, MODL + 4 * 6144 + 2 * 1024, MODL + 4 * 6144 + 4 * 1024, MODL + 4 * 6144 + 3 * 1024, XN + (size_t)RLAT * DM, gw, NGW, lane);
        }
        GRID_BAR();
        {   pg8::Gemm g{XN, (const bf16*)(wl + WFI_OFF), Mrows, 2 * FFH, DM, DM}; pg8::StaticOrder S; S.init(Mrows, 2 * FFH, G, bx);
            pg8::EpiSwiglu E{(bf16*)(ws + WS_H), FFH};
            pg8::gemm_phase<pg8::EpiSwiglu, pg8::StaticOrder, true, true>(lds, g, S, E, tid); }
        GRID_BAR();
        if (!last) {
            {   pg8::Gemm g{(const bf16*)(ws + WS_H), (const bf16*)(wl + WFO_OFF), RLAT, DM, FFH, FFH}; pg8::StaticOrder S; S.init(RLAT, DM, G, bx);
                pg8::PanelSumSq st1{(float*)(ws + WS_XB + (size_t)(layer * 4 + 2) * XB_BANK), ctl + CW_SEAM + (layer * 4 + 2) * SEAM_BANK, ctl + CW_TMO};
                pg8::PanelSumSq st2{(float*)(ws + WS_XB + (size_t)(layer * 4 + 3) * XB_BANK), ctl + CW_SEAM + (layer * 4 + 3) * SEAM_BANK, ctl + CW_TMO};
                pg8::EpiRmsRes<true, true, true> E{ws + WS_RES, ws + WS_RES, XN, MODL + 5 * 1024, MOD + 30720 + 1 * 1024, MOD + 30720 + 0 * 1024, st1, st2};
                pg8::gemm_phase<pg8::EpiRmsRes<true, true, true>, pg8::StaticOrder, false, true>(lds, g, S, E, tid); }
            __syncthreads();
            {   pg8::Gemm g{(const bf16*)(ws + WS_H) + (size_t)RLAT * FFH, (const bf16*)(wl + WFO_OFF), RCTX, DM, 256, FFH}; pg8::SplitKOrder S; S.init(RCTX, DM, 11, 256, G, bx);
                pg8::EpiF32Slab E{YO, DM, (size_t)RCTX * DM};
                pg8::gemm_phase<pg8::EpiF32Slab, pg8::SplitKOrder, true, true>(lds, g, S, E, tid); }
            GRID_BAR();
            ctx_norm(YO, 11, XRC, XRC, MODL + 4 * 6144 + 5 * 1024, MOD + 30720 + 4 * 6144 + 1 * 1024, MOD + 30720 + 4 * 6144 + 0 * 1024, XN + (size_t)RLAT * DM, gw, NGW, lane);
            GRID_BAR();
        } else {
            pg8::Gemm g{(const bf16*)(ws + WS_H), (const bf16*)(wl + WFO_OFF), RLAT, DM, FFH, FFH}; pg8::StaticOrder S; S.init(RLAT, DM, G, bx);
            pg8::PanelSumSq st1{(float*)(ws + WS_XB + (size_t)(layer * 4 + 2) * XB_BANK), ctl + CW_SEAM + (layer * 4 + 2) * SEAM_BANK, ctl + CW_TMO};
            pg8::EpiRmsRes<false, true, false> E{ws + WS_RES, kout(), XN, MODL + 5 * 1024, nullptr, nullptr, st1, st1};
            pg8::gemm_phase<pg8::EpiRmsRes<false, true, false>, pg8::StaticOrder, false, true>(lds, g, S, E, tid);
        }
    }
}

#undef tid
#undef lane
extern "C" void kernel_launch(void* const* d_in, const int* in_sizes, int n_in, void* d_out, int out_size, void* d_ws, size_t ws_size, hipStream_t stream) {
    static int grid = 0;
    if (grid == 0) {
        if (n_in != 21 || out_size != RLAT * DM || ws_size < WS_END) { fprintf(stderr, "kernel_launch: unexpected shapes (n_in %d out %d ws %zu)\n", n_in, out_size, ws_size); grid = -1; return; }
        int dev = 0, cus = 0, per_cu = 0;
        hipGetDevice(&dev); hipDeviceGetAttribute(&cus, hipDeviceAttributeMultiprocessorCount, dev);
        hipFuncSetAttribute((const void*)hybrid_fwd, hipFuncAttributeMaxDynamicSharedMemorySize, LDS_BYTES);
        hipOccupancyMaxActiveBlocksPerMultiprocessor(&per_cu, (const void*)hybrid_fwd, NTHR, LDS_BYTES);
        (void)hipGetLastError();
        if (per_cu < 1) { fprintf(stderr, "kernel_launch: occupancy query says %d blocks per CU\n", per_cu); per_cu = 1; }
        grid = cus;
        if (grid != 256) { fprintf(stderr, "kernel_launch: built for a 256-CU device (got %d)\n", cus); grid = -1; return; }
    }
    if (grid < 0) return;
    if (hipMemsetAsync((char*)d_ws + WS_CTL, 0, 262144, stream) != hipSuccess) { fprintf(stderr, "kernel_launch: memset failed\n"); return; }
    Params p{};
    for (int i = 0; i < 21; ++i) p.in[i] = (const float*)d_in[i];
    p.out = (float*)d_out; p.ws = (unsigned char*)d_ws;
    void* args[] = {&p};
    hipError_t e = hipLaunchCooperativeKernel((const void*)hybrid_fwd, dim3(grid), dim3(NTHR), args, LDS_BYTES, stream);
    if (e != hipSuccess) fprintf(stderr, "cooperative launch failed: %s (grid %d)\n", hipGetErrorString(e), grid);
}
```

```cpp
#include <hip/hip_runtime.h>
#include <hip/hip_cooperative_groups.h>
#include <hip/hip_bf16.h>
#include <cstdio>
#include <cstdint>
#include <cmath>
namespace cg = cooperative_groups;
__device__ __forceinline__ float shx(float v, int mask, int lane_) { return __int_as_float(__builtin_amdgcn_ds_bpermute((lane_ ^ mask) << 2, __float_as_int(v))); }
__device__ __forceinline__ int hw_lane() { int l; asm volatile("v_mbcnt_lo_u32_b32 %0, -1, 0\n\tv_mbcnt_hi_u32_b32 %0, -1, %0" : "=v"(l)); return l; }
namespace pg8 {
#define PG8_LAS __attribute__((address_space(3)))
typedef unsigned short bf16_t;
typedef short bf16x8 __attribute__((ext_vector_type(8)));
typedef float f32x4 __attribute__((ext_vector_type(4)));
typedef unsigned u32x4 __attribute__((ext_vector_type(4)));
typedef unsigned u32x2 __attribute__((ext_vector_type(2)));
constexpr int BM = 256, BK = 64, HALF = 128, HTB = HALF * BK * 2  , STAGE_BYTES = 8 * HTB, NXCD = 8, WGM = 8;

__host__ __device__ __forceinline__ int lds_byte(int r, int c) { const int st = (r >> 4) * 2 + (c >> 5), rr = r & 15, cc = c & 31, ob = rr * 64 + cc * 2; return st * 1024 + (ob ^ (((ob >> 9) & 1) << 5)); }
__host__ __device__ __forceinline__ void stage_rc(int b, int& R, int& C) { const int st = b / 1024, sb = b % 1024, swz = sb ^ (((sb >> 9) & 1) << 5); R = (st >> 1) * 16 + swz / 64; C = (st & 1) * 32 + (swz % 64) / 2; }
__host__ __device__ __forceinline__ int perm32(int rho) { const int n = rho >> 4, i = rho & 15; return 8 * (i >> 2) + 4 * n + (i & 3); }

struct Unit { int pm, pn, kb, ks; };
struct Gemm { const bf16_t* A; const bf16_t* Bt; int M, N, K, ld; };

struct StaticOrder {
    int nM, nN, nwg, G, c;
    __host__ __device__ void init(int M, int N, int G_, int c_) { nM = M / BM; nN = N / BM; nwg = nM * nN; G = G_; c = c_; }
    __host__ __device__ bool next(int i, Unit& u) const {
        const long L = (long)i * G + c; if (L >= nwg) return false;
        int wgid = (int)L; { const int q = nwg / NXCD, r = nwg % NXCD, xcd = wgid % NXCD, off = wgid / NXCD; wgid = (xcd < r ? xcd * (q + 1) : r * (q + 1) + (xcd - r) * q) + off; }
        const int nig = WGM * nN, gid = wgid / nig, fm = gid * WGM, gsz = (nM - fm) < WGM ? (nM - fm) : WGM;
        u.pm = fm + ((wgid % nig) % gsz); u.pn = (wgid % nig) / gsz; u.kb = 0; u.ks = 0; return true;
    }
    __device__ __forceinline__ void a_ready(const Unit&) const {}
    __device__ __forceinline__ void done(const Unit&) const {}
};

__device__ __forceinline__ unsigned cvt_pk_bf16(float lo, float hi) { unsigned r; asm volatile("v_cvt_pk_bf16_f32 %0, %1, %2" : "=v"(r) : "v"(lo), "v"(hi)); return r; }
typedef float f32x2 __attribute__((ext_vector_type(2)));
struct EpiBf16 {
    static constexpr bool PERM = true, AFTER_DRAIN = false;
    bf16_t* O; int ldc;
    __device__ __forceinline__ void operator()(const f32x4 (&acc)[2][2][4][2], const Unit& u, int wr, int wc, int fr, int fq) const {
        const int row0 = u.pm * BM + wr * 64 + fr; const int col0 = u.pn * BM + wc * 32 + 8 * fq;
#pragma unroll
        for (int ai = 0; ai < 2; ++ai)
#pragma unroll
            for (int m = 0; m < 4; ++m) { bf16_t* rowp = O + (size_t)(row0 + ai * HALF + m * 16) * ldc + col0;
#pragma unroll
                for (int bj = 0; bj < 2; ++bj) { const f32x4 v0 = acc[ai][bj][m][0], v1 = acc[ai][bj][m][1];
                    u32x4 w; w.x = cvt_pk_bf16(v0[0], v0[1]); w.y = cvt_pk_bf16(v0[2], v0[3]); w.z = cvt_pk_bf16(v1[0], v1[1]); w.w = cvt_pk_bf16(v1[2], v1[3]);
                    *(u32x4*)(rowp + bj * HALF) = w; } }
    }
};
__device__ __forceinline__ float silu_f(float g) { return g * __builtin_amdgcn_rcpf(1.0f + __expf(-g)); }
struct EpiSwiglu {
    static constexpr bool PERM = true, AFTER_DRAIN = false;
    bf16_t* H; int ldh;
    __device__ __forceinline__ void operator()(const f32x4 (&acc)[2][2][4][2], const Unit& u, int wr, int wc, int fr, int fq) const {
        const int row0 = u.pm * BM + wr * 64 + fr; const int col0 = u.pn * HALF + wc * 32 + 8 * fq;
#pragma unroll
        for (int ai = 0; ai < 2; ++ai)
#pragma unroll
            for (int m = 0; m < 4; ++m) { bf16_t* rowp = H + (size_t)(row0 + ai * HALF + m * 16) * ldh + col0;
                const f32x4 g0 = acc[ai][0][m][0], g1 = acc[ai][0][m][1], u0 = acc[ai][1][m][0], u1 = acc[ai][1][m][1];
                u32x4 w;
                w.x = cvt_pk_bf16(silu_f(g0[0]) * u0[0], silu_f(g0[1]) * u0[1]); w.y = cvt_pk_bf16(silu_f(g0[2]) * u0[2], silu_f(g0[3]) * u0[3]);
                w.z = cvt_pk_bf16(silu_f(g1[0]) * u1[0], silu_f(g1[1]) * u1[1]); w.w = cvt_pk_bf16(silu_f(g1[2]) * u1[2], silu_f(g1[3]) * u1[3]);
                *(u32x4*)rowp = w; }
    }
};
struct EpiF32 {
    static constexpr bool PERM = false, AFTER_DRAIN = false;
    float* O; int ldc;
    __device__ __forceinline__ void operator()(const f32x4 (&acc)[2][2][4][2], const Unit& u, int wr, int wc, int fr, int fq) const {
        const int row0 = u.pm * BM + wr * 64 + fr; const int col0 = u.pn * BM + wc * 32 + 4 * fq;
#pragma unroll
        for (int ai = 0; ai < 2; ++ai)
#pragma unroll
            for (int m = 0; m < 4; ++m) { float* rowp = O + (size_t)(row0 + ai * HALF + m * 16) * ldc + col0;
#pragma unroll
                for (int bj = 0; bj < 2; ++bj)
#pragma unroll
                    for (int n = 0; n < 2; ++n) *(f32x4*)(rowp + bj * HALF + n * 16) = acc[ai][bj][m][n]; }
    }
};
struct SplitKOrder {
    int nM, nN, KS, kbytes, G, c;
    __device__ void init(int M, int N, int KS_, int kslice, int G_, int c_) { nM = M / BM; nN = N / BM; KS = KS_; kbytes = kslice * 2; G = G_; c = c_; }
    __device__ bool next(int i, Unit& u) const { const int L = i * G + c; if (L >= nM * nN * KS) return false; const int ks = L % KS, t = L / KS; u.pm = t % nM; u.pn = t / nM; u.ks = ks; u.kb = ks * kbytes; return true; }
    __device__ __forceinline__ void a_ready(const Unit&) const {}
    __device__ __forceinline__ void done(const Unit&) const {}
};
struct EpiF32Slab {
    static constexpr bool PERM = false, AFTER_DRAIN = false;
    float* O; int ldc; size_t slab;
    __device__ __forceinline__ void operator()(const f32x4 (&acc)[2][2][4][2], const Unit& u, int wr, int wc, int fr, int fq) const {
        const int row0 = u.pm * BM + wr * 64 + fr; const int col0 = u.pn * BM + wc * 32 + 4 * fq; float* Os = O + (size_t)u.ks * slab;
#pragma unroll
        for (int ai = 0; ai < 2; ++ai)
#pragma unroll
            for (int m = 0; m < 4; ++m) { float* rowp = Os + (size_t)(row0 + ai * HALF + m * 16) * ldc + col0;
#pragma unroll
                for (int bj = 0; bj < 2; ++bj)
#pragma unroll
                    for (int n = 0; n < 2; ++n) *(f32x4*)(rowp + bj * HALF + n * 16) = acc[ai][bj][m][n]; }
    }
};
struct PanelSumSq {
    float* xbuf;
    unsigned* cnt;
    unsigned* tmo;
    __device__ __forceinline__ void run(const f32x4 (&v)[2][2][4][2], int pmg, int pn, int wr, int wc, int fr, int fq, PG8_LAS unsigned char* lds, int wid, int lane) const { publish(v, pmg, pn, wr, wc, fr, fq, lds, wid, lane); finish(pmg, lds, wid, lane); }
    __device__ __forceinline__ void publish(const f32x4 (&v)[2][2][4][2], int pmg, int pn, int wr, int wc, int fr, int fq, PG8_LAS unsigned char* lds, int wid, int lane) const {
        PG8_LAS float* P = (PG8_LAS float*)lds;
        PG8_LAS float* S = (PG8_LAS float*)(lds + 8192);
#pragma unroll
        for (int ai = 0; ai < 2; ++ai)
#pragma unroll
            for (int m = 0; m < 4; ++m) {
                float q = 0.f;
#pragma unroll
                for (int bj = 0; bj < 2; ++bj)
#pragma unroll
                    for (int n = 0; n < 2; ++n) { const f32x4 x = v[ai][bj][m][n]; q += (x[0] * x[0] + x[1] * x[1]) + (x[2] * x[2] + x[3] * x[3]); }
                q += shx(q, 16, lane); q += shx(q, 32, lane);
                if (fq == 0) P[(ai * HALF + wr * 64 + m * 16 + fr) * 4 + wc] = q;
            }
        asm volatile("s_waitcnt lgkmcnt(0)" ::: "memory"); __builtin_amdgcn_s_barrier(); asm volatile("" ::: "memory");
        const int row = wid * 32 + (lane & 31);
        if (lane < 32) {
            const float t = (P[row * 4 + 0] + P[row * 4 + 1]) + (P[row * 4 + 2] + P[row * 4 + 3]);
            __hip_atomic_store((unsigned*)xbuf + ((size_t)(pmg * BM + row) * 4 + pn), __float_as_uint(t), __ATOMIC_RELAXED, __HIP_MEMORY_SCOPE_AGENT);
        }
        asm volatile("s_waitcnt vmcnt(0)" ::: "memory");
        if (lane == 0) __hip_atomic_fetch_add(cnt + 64 * pmg, 1u, __ATOMIC_RELAXED, __HIP_MEMORY_SCOPE_AGENT);
    }
    __device__ __forceinline__ void finish(int pmg, PG8_LAS unsigned char* lds, int wid, int lane) const {
        PG8_LAS float* S = (PG8_LAS float*)(lds + 8192);
        const int row = wid * 32 + (lane & 31);
        {   unsigned sp = 0u;
            while ((unsigned)__builtin_amdgcn_readfirstlane(__hip_atomic_load(cnt + 64 * pmg, __ATOMIC_RELAXED, __HIP_MEMORY_SCOPE_AGENT)) < 32u) {
                __builtin_amdgcn_s_sleep(1);
                if (++sp > (1u << 18)) { if (lane == 0) __hip_atomic_store(tmo, 1u, __ATOMIC_RELAXED, __HIP_MEMORY_SCOPE_AGENT); break; }
            }
        }
        if (lane < 32) {
            const unsigned* slot = (const unsigned*)xbuf + (size_t)(pmg * BM + row) * 4; float tot = 0.f;
#pragma unroll
            for (int t = 0; t < 4; ++t) tot += __uint_as_float(__hip_atomic_load(slot + t, __ATOMIC_RELAXED, __HIP_MEMORY_SCOPE_AGENT));
            S[row] = rsqrtf(tot * (1.0f / 1024.0f) + 1e-6f);
        }
        asm volatile("s_waitcnt vmcnt(0) lgkmcnt(0)" ::: "memory"); __builtin_amdgcn_s_barrier(); asm volatile("" ::: "memory");
    }
};
template <bool NEXT, bool BASE16, bool OUT16> struct EpiRmsRes {
    static constexpr bool PERM = true, AFTER_DRAIN = true;
    const void* base_p; void* out_p; bf16_t* xn;
    const float* vG; const float* vA; const float* vS;
    PanelSumSq st1, st2;
    static __device__ __forceinline__ f32x4 up4(u32x2 w) { return (f32x4){__uint_as_float(w.x << 16), __uint_as_float(w.x & 0xffff0000u), __uint_as_float(w.y << 16), __uint_as_float(w.y & 0xffff0000u)}; }
    __device__ __forceinline__ void store_out(void* rowp, int coff, const f32x4 x) const {
        if (OUT16) { u32x2 w; w.x = cvt_pk_bf16(x[0], x[1]); w.y = cvt_pk_bf16(x[2], x[3]); *(u32x2*)((bf16_t*)rowp + coff) = w; }
        else *(f32x4*)((float*)rowp + coff) = x; }
    __device__ __forceinline__ void fused(f32x4 (&acc)[2][2][4][2], const Unit& u, int wr, int wc, int fr, int fq, PG8_LAS unsigned char* lds, int wid, int lane) const {
        const PG8_LAS float* S = (const PG8_LAS float*)(lds + 8192);
        const int pmg = u.pm, slot = pmg >> 4;
        const size_t poff = (size_t)pmg * BM * 1024;
        const int col0 = u.pn * BM + wc * 32 + 8 * fq;
        const size_t lane_off = (size_t)(wr * 64 + fr) * 1024 + col0;
        st1.publish(acc, pmg, u.pn, wr, wc, fr, fq, lds, wid, lane);
        f32x4 pre[4][2][2]; u32x2 pb[2][4][2][2];
        if (BASE16) {
            const bf16_t* b16 = (const bf16_t*)base_p + poff + lane_off;
#pragma unroll
            for (int ai = 0; ai < 2; ++ai)
#pragma unroll
                for (int m = 0; m < 4; ++m)
#pragma unroll
                    for (int bj = 0; bj < 2; ++bj)
#pragma unroll
                        for (int n = 0; n < 2; ++n) pb[ai][m][bj][n] = *(const u32x2*)(b16 + (size_t)(ai * HALF + m * 16) * 1024 + bj * HALF + n * 4);
        } else {
            const float* b32 = (const float*)base_p + poff + lane_off;
#pragma unroll
            for (int m = 0; m < 4; ++m)
#pragma unroll
                for (int bj = 0; bj < 2; ++bj)
#pragma unroll
                    for (int n = 0; n < 2; ++n) pre[m][bj][n] = __builtin_nontemporal_load((const f32x4*)(b32 + (size_t)(m * 16) * 1024 + bj * HALF + n * 4));
        }
        f32x4 g[2][2];
#pragma unroll
        for (int bj = 0; bj < 2; ++bj)
#pragma unroll
            for (int n = 0; n < 2; ++n) g[bj][n] = *(const f32x4*)(vG + slot * 6144 + col0 + bj * HALF + n * 4);
        st1.finish(pmg, lds, wid, lane);
#pragma unroll
        for (int ai = 0; ai < 2; ++ai)
#pragma unroll
            for (int m = 0; m < 4; ++m) { const float rs = S[ai * HALF + wr * 64 + m * 16 + fr];
#pragma unroll
                for (int bj = 0; bj < 2; ++bj)
#pragma unroll
                    for (int n = 0; n < 2; ++n) { f32x4 bs;
                        if (BASE16) bs = up4(pb[ai][m][bj][n]);
                        else bs = ai == 0 ? pre[m][bj][n] : __builtin_nontemporal_load((const f32x4*)((const float*)base_p + poff + lane_off + (size_t)(HALF + m * 16) * 1024 + bj * HALF + n * 4));
                        acc[ai][bj][m][n] = bs + g[bj][n] * acc[ai][bj][m][n] * rs; }
                asm volatile("" : "+v"(acc[ai][0][m][0]), "+v"(acc[ai][0][m][1]), "+v"(acc[ai][1][m][0]), "+v"(acc[ai][1][m][1]));
                if (m & 1) asm volatile("" ::: "memory"); }
        unsigned char* const outl = (unsigned char*)out_p + (poff + lane_off) * (OUT16 ? 2 : 4);
        if (NEXT) {
            f32x4 a[2][2], sh[2][2];
#pragma unroll
            for (int bj = 0; bj < 2; ++bj)
#pragma unroll
                for (int n = 0; n < 2; ++n) { a[bj][n] = *(const f32x4*)(vA + slot * 6144 + col0 + bj * HALF + n * 4); sh[bj][n] = *(const f32x4*)(vS + slot * 6144 + col0 + bj * HALF + n * 4); }
            st2.publish(acc, pmg, u.pn, wr, wc, fr, fq, lds, wid, lane);
#pragma unroll
            for (int ai = 0; ai < 2; ++ai)
#pragma unroll
                for (int m = 0; m < 4; ++m) { void* op = outl + (size_t)(ai * HALF + m * 16) * 1024 * (OUT16 ? 2 : 4);
#pragma unroll
                    for (int bj = 0; bj < 2; ++bj)
#pragma unroll
                        for (int n = 0; n < 2; ++n) store_out(op, bj * HALF + n * 4, acc[ai][bj][m][n]);
                    asm volatile("" ::: "memory"); }
            st2.finish(pmg, lds, wid, lane);
            bf16_t* xnl = xn + poff + lane_off;
#pragma unroll
            for (int ai = 0; ai < 2; ++ai)
#pragma unroll
                for (int m = 0; m < 4; ++m) { const float rs = S[ai * HALF + wr * 64 + m * 16 + fr]; bf16_t* xp = xnl + (size_t)(ai * HALF + m * 16) * 1024;
#pragma unroll
                    for (int bj = 0; bj < 2; ++bj)
#pragma unroll
                        for (int n = 0; n < 2; ++n) { const f32x4 x1 = acc[ai][bj][m][n]; const f32x4 o = x1 * rs * a[bj][n] + sh[bj][n];
                            u32x2 w; w.x = cvt_pk_bf16(o[0], o[1]); w.y = cvt_pk_bf16(o[2], o[3]); *(u32x2*)(xp + bj * HALF + n * 4) = w; }
                    asm volatile("" ::: "memory"); }
        } else {
#pragma unroll
            for (int ai = 0; ai < 2; ++ai)
#pragma unroll
                for (int m = 0; m < 4; ++m) { void* op = outl + (size_t)(ai * HALF + m * 16) * 1024 * (OUT16 ? 2 : 4);
#pragma unroll
                    for (int bj = 0; bj < 2; ++bj)
#pragma unroll
                        for (int n = 0; n < 2; ++n) store_out(op, bj * HALF + n * 4, acc[ai][bj][m][n]);
                    asm volatile("" ::: "memory"); }
        }
    }
};
template <class Epi, class Sched, bool ALIGN_EPI = false, bool SP2 = false>
__device__ __forceinline__ void gemm_phase(PG8_LAS unsigned char* lds, const Gemm g, const Sched& S, const Epi& E, int tid_) {
    asm volatile("" : "+v"(tid_));
    const int tid = tid_, wid = __builtin_amdgcn_readfirstlane(tid >> 6), lane = tid & 63, wr = wid >> 2, wc = wid & 3, fr = lane & 15, fq = lane >> 4;
    const int K = g.ld, nt = g.K / BK;
    unsigned voffA[2], voffB[2];
#pragma unroll
    for (int i = 0; i < 2; ++i) { int R, C; stage_rc(tid * 16 + i * 8192, R, C); const int Rb = Epi::PERM ? ((R & ~31) + perm32(R & 31)) : R;
        voffA[i] = (unsigned)(R * K + C) * 2u; voffB[i] = (unsigned)(Rb * K + C) * 2u; }
    const size_t kstep = (size_t)(BK * 2);
    const size_t hstep = (size_t)HALF * K * 2;
    const size_t tstep = 2 * hstep;
    const unsigned ldsw = (unsigned)wid * 1024u;
    const int aoff = lds_byte(wr * 64 + fr, fq * 8), boff = lds_byte(wc * 32 + fr, fq * 8);
#define PG8_SA(b, h) (((b) * 2 + (h)) * HTB)
#define PG8_SB(b, h) ((4 + (b) * 2 + (h)) * HTB)
#define PG8_STAGE(bufoff, gbase, voff) do { _Pragma("unroll") for (int _i = 0; _i < 2; ++_i) \
        __builtin_amdgcn_global_load_lds((const unsigned*)((const char*)(gbase) + (voff)[_i]), (PG8_LAS unsigned*)(lds + (bufoff) + ldsw + _i * 8192), 16, 0, 0); } while (0)
#define PG8_LDA(dst, b, h) do { _Pragma("unroll") for (int m = 0; m < 4; ++m) _Pragma("unroll") for (int k = 0; k < 2; ++k) dst[m][k] = *(const PG8_LAS bf16x8*)(lds + PG8_SA(b, h) + aoff + m * 2048 + k * 1024); } while (0)
#define PG8_LDB(dst, b, h) do { _Pragma("unroll") for (int n = 0; n < 2; ++n) _Pragma("unroll") for (int k = 0; k < 2; ++k) dst[n][k] = *(const PG8_LAS bf16x8*)(lds + PG8_SB(b, h) + boff + n * 2048 + k * 1024); } while (0)
#define PG8_MMA(ai, bj, At, Bt) do { __builtin_amdgcn_s_setprio(1); _Pragma("unroll") for (int m = 0; m < 4; ++m) _Pragma("unroll") for (int n = 0; n < 2; ++n) _Pragma("unroll") for (int k = 0; k < 2; ++k) \
        acc[ai][bj][m][n] = __builtin_amdgcn_mfma_f32_16x16x32_bf16(Bt[n][k], At[m][k], acc[ai][bj][m][n], 0, 0, 0); __builtin_amdgcn_s_setprio(0); } while (0)
#define PG8_WAIT_V(n) asm volatile("s_waitcnt vmcnt(" #n ")" ::: "memory")
#define PG8_WAIT_L(n) asm volatile("s_waitcnt lgkmcnt(" #n ")" ::: "memory")
#define PG8_BAR __builtin_amdgcn_s_barrier()
#define PG8_SCHED __builtin_amdgcn_sched_barrier(0)
    Unit cur, nxt; int ui = 0;
    if (!S.next(0, cur)) return;
    f32x4 acc[2][2][4][2];
#pragma unroll
    for (int a = 0; a < 2; ++a)
#pragma unroll
        for (int b = 0; b < 2; ++b)
#pragma unroll
            for (int m = 0; m < 4; ++m)
#pragma unroll
                for (int n = 0; n < 2; ++n) acc[a][b][m][n] = (f32x4){0.f, 0.f, 0.f, 0.f};
    bf16x8 At[4][2], B0[2][2], B1[2][2];
    const char* cA = (const char*)g.A + (size_t)cur.pm * tstep + cur.kb; const char* cB = (const char*)g.Bt + (size_t)cur.pn * tstep + cur.kb;
    S.a_ready(cur);
    if constexpr (SP2) {
        PG8_STAGE(PG8_SB(0, 0), cB, voffB); PG8_STAGE(PG8_SB(0, 1), cB + hstep, voffB); PG8_STAGE(PG8_SA(0, 0), cA, voffA); PG8_STAGE(PG8_SA(0, 1), cA + hstep, voffA);
        if (wr == 1) PG8_BAR;
        PG8_WAIT_V(2); PG8_BAR;
        PG8_STAGE(PG8_SB(1, 0), cB + kstep, voffB); PG8_STAGE(PG8_SA(1, 0), cA + kstep, voffA); PG8_STAGE(PG8_SB(1, 1), cB + hstep + kstep, voffB);
        PG8_WAIT_V(6); PG8_BAR;
    } else {
        PG8_STAGE(PG8_SB(0, 0), cB, voffB); PG8_STAGE(PG8_SA(0, 0), cA, voffA); PG8_STAGE(PG8_SB(0, 1), cB + hstep, voffB); PG8_STAGE(PG8_SA(0, 1), cA + hstep, voffA);
        if (wr == 1) PG8_BAR;
        PG8_WAIT_V(4); PG8_BAR;
        PG8_STAGE(PG8_SB(1, 0), cB + kstep, voffB); PG8_STAGE(PG8_SA(1, 0), cA + kstep, voffA); PG8_STAGE(PG8_SB(1, 1), cB + hstep + kstep, voffB);
        PG8_WAIT_V(6); PG8_BAR;
    }
    for (;;) {
        const bool has_next = S.next(ui + 1, nxt);
        const char* nA = has_next ? (const char*)g.A + (size_t)nxt.pm * tstep + nxt.kb : cA; const char* nB = has_next ? (const char*)g.Bt + (size_t)nxt.pn * tstep + nxt.kb : cB;
        for (int t = 0; t < nt; t += 2) {
            const bool last = (t == nt - 2);
            const char* a1 = cA + (size_t)(t + 1) * kstep;
            const char* a2 = last ? nA : cA + (size_t)(t + 2) * kstep; const char* b2 = last ? nB : cB + (size_t)(t + 2) * kstep;
            const char* a3 = a2 + kstep; const char* b3 = b2 + kstep;
            if (last && has_next) S.a_ready(nxt);
            if constexpr (SP2) {
            PG8_LDB(B0, 0, 0); PG8_LDB(B1, 0, 1); PG8_SCHED; PG8_LDA(At, 0, 0); PG8_STAGE(PG8_SA(1, 1), a1 + hstep, voffA);
            PG8_WAIT_V(8); PG8_WAIT_L(0); PG8_BAR; PG8_MMA(0, 0, At, B0); PG8_MMA(0, 1, At, B1); PG8_BAR; PG8_SCHED;
            PG8_LDA(At, 0, 1); PG8_STAGE(PG8_SB(0, 0), b2, voffB); PG8_STAGE(PG8_SB(0, 1), b2 + hstep, voffB); PG8_STAGE(PG8_SA(0, 0), a2, voffA);
            PG8_WAIT_V(8); PG8_WAIT_L(0); PG8_BAR; PG8_MMA(1, 0, At, B0); PG8_MMA(1, 1, At, B1); PG8_BAR; PG8_SCHED;
            PG8_LDB(B0, 1, 0); PG8_LDB(B1, 1, 1); PG8_SCHED; PG8_LDA(At, 1, 0); PG8_STAGE(PG8_SA(0, 1), a2 + hstep, voffA);
            PG8_WAIT_V(8); PG8_WAIT_L(0); PG8_BAR; PG8_MMA(0, 0, At, B0); PG8_MMA(0, 1, At, B1); PG8_BAR; PG8_SCHED;
            PG8_LDA(At, 1, 1); PG8_STAGE(PG8_SB(1, 0), b3, voffB); PG8_STAGE(PG8_SB(1, 1), b3 + hstep, voffB); PG8_STAGE(PG8_SA(1, 0), a3, voffA);
            PG8_WAIT_V(8); PG8_WAIT_L(0); PG8_BAR; PG8_MMA(1, 0, At, B0); PG8_MMA(1, 1, At, B1); PG8_BAR; PG8_SCHED;
            } else {
            PG8_LDB(B0, 0, 0); PG8_SCHED; PG8_LDA(At, 0, 0); PG8_STAGE(PG8_SA(1, 1), a1 + hstep, voffA);
            PG8_WAIT_L(8); PG8_BAR; PG8_WAIT_L(0); PG8_MMA(0, 0, At, B0); PG8_BAR; PG8_SCHED;
            PG8_LDB(B1, 0, 1); PG8_STAGE(PG8_SB(0, 0), b2, voffB);
            PG8_BAR; PG8_WAIT_L(0); PG8_MMA(0, 1, At, B1); PG8_BAR;
            PG8_LDA(At, 0, 1); PG8_STAGE(PG8_SA(0, 0), a2, voffA);
            PG8_BAR; PG8_WAIT_L(0); PG8_MMA(1, 0, At, B0); PG8_BAR; PG8_SCHED;
            PG8_STAGE(PG8_SB(0, 1), b2 + hstep, voffB);
            PG8_WAIT_V(6); PG8_BAR; PG8_MMA(1, 1, At, B1); PG8_BAR;
            PG8_LDB(B0, 1, 0); PG8_SCHED; PG8_LDA(At, 1, 0); PG8_STAGE(PG8_SA(0, 1), a2 + hstep, voffA);
            PG8_WAIT_L(8); PG8_BAR; PG8_WAIT_L(0); PG8_MMA(0, 0, At, B0); PG8_BAR; PG8_SCHED;
            PG8_LDB(B1, 1, 1); PG8_STAGE(PG8_SB(1, 0), b3, voffB);
            PG8_BAR; PG8_WAIT_L(0); PG8_MMA(0, 1, At, B1); PG8_BAR;
            PG8_LDA(At, 1, 1); PG8_STAGE(PG8_SA(1, 0), a3, voffA);
            PG8_BAR; PG8_WAIT_L(0); PG8_MMA(1, 0, At, B0); PG8_BAR; PG8_SCHED;
            PG8_STAGE(PG8_SB(1, 1), b3 + hstep, voffB);
            PG8_WAIT_V(6); PG8_BAR; PG8_MMA(1, 1, At, B1); PG8_BAR;
            }
        }
        if constexpr (ALIGN_EPI) { if (wr == 0) PG8_BAR; }
        if constexpr (!Epi::AFTER_DRAIN) { E(acc, cur, wr, wc, fr, fq); S.done(cur); }
        if (!has_next) break;
#pragma unroll
        for (int a = 0; a < 2; ++a)
#pragma unroll
            for (int b = 0; b < 2; ++b)
#pragma unroll
                for (int m = 0; m < 4; ++m)
#pragma unroll
                    for (int n = 0; n < 2; ++n) acc[a][b][m][n] = (f32x4){0.f, 0.f, 0.f, 0.f};
        cur = nxt; cA = nA; cB = nB; ++ui;
        if constexpr (ALIGN_EPI) { if (wr == 1) PG8_BAR; }
    }
    PG8_WAIT_V(0);
    if constexpr (!ALIGN_EPI) { if (wr == 0) PG8_BAR; }
    PG8_BAR;
    if constexpr (Epi::AFTER_DRAIN) { E.fused(acc, cur, wr, wc, fr, fq, lds, wid, lane); S.done(cur); }
#undef PG8_SA
#undef PG8_SB
#undef PG8_STAGE
#undef PG8_LDA
#undef PG8_LDB
#undef PG8_MMA
#undef PG8_WAIT_V
#undef PG8_WAIT_L
#undef PG8_BAR
#undef PG8_SCHED
}
}
#include <hip/hip_bf16.h>
#include <cmath>
namespace attn_body {
using bf16=__hip_bfloat16;
using bf16x8=__attribute__((ext_vector_type(8)))short;
using s16x4=__attribute__((ext_vector_type(4)))short;
using f32x16=__attribute__((ext_vector_type(16)))float;
using u32x4=__attribute__((ext_vector_type(4)))unsigned;
constexpr int D=64,DM=1024,KVP=128,QP=1536;
constexpr int NW=8,QBLK=32,QB=QBLK*NW,KVBLK=64;
constexpr int ATTN_PITCH=DM, ATTN_UNIT_ROWS=QB;
__device__ __forceinline__ int crow(int r,int hi){return (r&3)+8*(r>>2)+4*hi;}
#define SBAR() __builtin_amdgcn_sched_barrier(0)
__device__ __forceinline__ void cmask(f32x16&p0,f32x16&p1,int jb,int qrel,int hi){
  const float NEG=-INFINITY; int kb=64*jb+4*hi;
  #pragma unroll
  for(int r=0;r<16;++r){int kv=kb+(r&3)+8*(r>>2); if(kv>qrel)p0[r]=NEG; if(kv+32>qrel)p1[r]=NEG;}
}

constexpr int NSLOT=3, SLOTB=8192;
constexpr int LDS_K=0, LDS_V=NSLOT*SLOTB, LDS_WS=2*NSLOT*SLOTB, LDS_OST=LDS_WS+NW*64*4, LDS_BYTES=LDS_OST+NW*4096;
constexpr float C2=0.125f*1.4426950408889634f;
__device__ __forceinline__ void glds16(const void*gsrc,unsigned lds_dst){unsigned keep;
  asm volatile("s_mov_b32 %0, m0\n\ts_mov_b32 m0, %2\n\ts_nop 0\n\tglobal_load_lds_dwordx4 %1, off\n\ts_mov_b32 m0, %0":"=&s"(keep):"v"(gsrc),"s"(lds_dst):"memory");}
__device__ __forceinline__ float max3f(float a,float b,float c){float r;asm("v_max3_f32 %0, %1, %2, %3":"=v"(r):"v"(a),"v"(b),"v"(c));return r;}
__device__ __forceinline__ float max2f(float a,float b){float r;asm("v_max_f32_e32 %0, %1, %2":"=v"(r):"v"(a),"v"(b));return r;}
__device__ __forceinline__ float fadd_s(float a,float b){float r;asm("v_add_f32_e32 %0, %1, %2":"=v"(r):"v"(a),"v"(b));return r;}
__device__ __forceinline__ float fsub_s(float a,float b){float r;asm("v_sub_f32_e32 %0, %1, %2":"=v"(r):"v"(a),"v"(b));return r;}
typedef float f32x2_t __attribute__((ext_vector_type(2))); typedef __bf16 bf16x2_t __attribute__((ext_vector_type(2)));
__device__ __forceinline__ unsigned cvtpk_s(float lo,float hi){f32x2_t v={lo,hi};bf16x2_t b=__builtin_convertvector(v,bf16x2_t);return __builtin_bit_cast(unsigned,b);}
#define WAIT_BAR(N) asm volatile("s_waitcnt vmcnt(" #N ") lgkmcnt(0)\n\ts_barrier":::"memory")

__device__ __forceinline__ void qkt(f32x16&p0,f32x16&p1,const char*Kslot,const bf16x8*qr,const f32x16&negm,int r32,int hi){
  const char*kb=Kslot+hi*1024+r32*16;
  #pragma unroll
  for(int d0=0;d0<4;++d0){
    const bf16x8 b0=*reinterpret_cast<const bf16x8*>(kb+d0*2048);
    const bf16x8 b1=*reinterpret_cast<const bf16x8*>(kb+d0*2048+512);
    if(d0==0){p0=__builtin_amdgcn_mfma_f32_32x32x16_bf16(b0,qr[0],negm,0,0,0);p1=__builtin_amdgcn_mfma_f32_32x32x16_bf16(b1,qr[0],negm,0,0,0);}
    else{p0=__builtin_amdgcn_mfma_f32_32x32x16_bf16(b0,qr[d0],p0,0,0,0);p1=__builtin_amdgcn_mfma_f32_32x32x16_bf16(b1,qr[d0],p1,0,0,0);}}
}
typedef __attribute__((address_space(3))) const char* lds_cptr;
typedef short v4i16_t __attribute__((ext_vector_type(4)));
__device__ __forceinline__ void kload8(bf16x8*kf,lds_cptr kp){
  kf[0]=*(const __attribute__((address_space(3))) bf16x8*)(kp);      kf[1]=*(const __attribute__((address_space(3))) bf16x8*)(kp+512);
  kf[2]=*(const __attribute__((address_space(3))) bf16x8*)(kp+2048); kf[3]=*(const __attribute__((address_space(3))) bf16x8*)(kp+2560);
  kf[4]=*(const __attribute__((address_space(3))) bf16x8*)(kp+4096); kf[5]=*(const __attribute__((address_space(3))) bf16x8*)(kp+4608);
  kf[6]=*(const __attribute__((address_space(3))) bf16x8*)(kp+6144); kf[7]=*(const __attribute__((address_space(3))) bf16x8*)(kp+6656);
}
__device__ __forceinline__ void kload2(bf16x8*kf,lds_cptr kp,int j){ kf[2*j]=*(const __attribute__((address_space(3))) bf16x8*)(kp+j*2048); kf[2*j+1]=*(const __attribute__((address_space(3))) bf16x8*)(kp+j*2048+512); }
__device__ __forceinline__ s16x4 vtr(lds_cptr p){ return __builtin_bit_cast(s16x4,__builtin_amdgcn_ds_read_tr16_b64_v4i16((__attribute__((address_space(3))) v4i16_t*)p)); }
__device__ __forceinline__ float rowmax(const f32x16&p0,const f32x16&p1){
  float a=max3f(p0[0],p0[1],p1[0]),b=max3f(p0[2],p0[3],p1[1]);a=max3f(a,p1[2],p1[3]);
  #pragma unroll
  for(int r=4;r<16;r+=4){a=max3f(a,p0[r],p0[r+1]);b=max3f(b,p0[r+2],p0[r+3]);a=max3f(a,p1[r],p1[r+1]);b=max3f(b,p1[r+2],p1[r+3]);}
  const float m=max2f(a,b);
  auto rr=__builtin_amdgcn_permlane32_swap(__float_as_uint(m),__float_as_uint(m),false,false);
  return max2f(__uint_as_float(rr[0]),__uint_as_float(rr[1]));
}
__device__ __forceinline__ void pv(f32x16*o,int vb,bf16x8 pa0,bf16x8 pa1,bf16x8 pa2,bf16x8 pa3){
  #pragma unroll
  for(int d0=0;d0<2;++d0){s16x4 lo[4],hi[4];
    #pragma unroll
    for(int ks=0;ks<4;++ks){
      asm volatile("ds_read_b64_tr_b16 %0,%1 offset:%c2":"=&v"(lo[ks]):"v"(vb),"i"(d0*4096+ks*1024):"memory");
      asm volatile("ds_read_b64_tr_b16 %0,%1 offset:%c2":"=&v"(hi[ks]):"v"(vb),"i"(d0*4096+ks*1024+512):"memory");}
    asm volatile("s_waitcnt lgkmcnt(0)":::"memory");SBAR();
    #define PK(k) (bf16x8){lo[k][0],lo[k][1],lo[k][2],lo[k][3],hi[k][0],hi[k][1],hi[k][2],hi[k][3]}
    o[d0]=__builtin_amdgcn_mfma_f32_32x32x16_bf16(pa0,PK(0),o[d0],0,0,0);
    o[d0]=__builtin_amdgcn_mfma_f32_32x32x16_bf16(pa1,PK(1),o[d0],0,0,0);
    o[d0]=__builtin_amdgcn_mfma_f32_32x32x16_bf16(pa2,PK(2),o[d0],0,0,0);
    o[d0]=__builtin_amdgcn_mfma_f32_32x32x16_bf16(pa3,PK(3),o[d0],0,0,0);
    #undef PK
  }
}

#ifndef ATTN_STORE16
#define ATTN_STORE16(p,v) (*(u32x4*)(p)=(v))
#endif
template<int THRL> __device__ __forceinline__ void attn_unit(const bf16*Qu,const bf16*__restrict__ Kh,const bf16*__restrict__ Vh,bf16*Ou,const int NT,char*shm,const float*qgain,const float*ropet,const int tq0,int tid_){
  asm volatile("":"+v"(tid_)); const int tid=tid_,lane=tid&63,r32=lane&31,hi=lane>>5; const int wid=__builtin_amdgcn_readfirstlane(tid>>6);
  const bf16*Qw=Qu+(long)(wid*QBLK)*QP;
  const unsigned lds0=(unsigned)(uintptr_t)shm;
  float*wsf=(float*)(shm+LDS_WS)+wid*64;
  const bf16*ksrc=Kh+(long)lane*KVP+wid*8;
  const bf16*vsrc=Vh+(long)(16*(wid&3)+(lane>>2))*KVP+(wid>>2)*32+(lane&3)*8;
  const unsigned kdst=lds0+LDS_K+wid*1024, vdst=lds0+LDS_V+wid*1024;
  #define DMA_K(t,slot) glds16(ksrc+(long)(t)*KVBLK*KVP,(unsigned)__builtin_amdgcn_readfirstlane(kdst+(slot)))
  #define DMA_V(t,slot) glds16(vsrc+(long)(t)*KVBLK*KVP,(unsigned)__builtin_amdgcn_readfirstlane(vdst+(slot)))
  const int vb0=(int)(lds0+LDS_V)+((lane>>4)&1)*32+(lane&3)*8+(4*hi+((lane&15)>>2))*64;
  const char*Kbase=shm+LDS_K; bf16x8 kf[8];
  const lds_cptr shm3=(lds_cptr)shm; const lds_cptr kp0=shm3+LDS_K+hi*1024+r32*16; const lds_cptr vp0=shm3+LDS_V+((lane>>4)&1)*32+(lane&3)*8+(4*hi+((lane&15)>>2))*64;
  DMA_K(0,0);DMA_V(0,0);DMA_K(1,SLOTB);
  bf16x8 qr[4];
  #pragma unroll
  for(int d0=0;d0<4;++d0)qr[d0]=*reinterpret_cast<const bf16x8*>(&Qw[(long)r32*QP+d0*16+hi*8]);
  {
    float qv[4][8]; float ss=0.f;
    #pragma unroll
    for(int d0=0;d0<4;++d0){
      #pragma unroll
      for(int e=0;e<8;++e){ qv[d0][e]=__uint_as_float(((unsigned)(unsigned short)qr[d0][e])<<16); ss+=qv[d0][e]*qv[d0][e]; } }
    { auto rr=__builtin_amdgcn_permlane32_swap(__float_as_uint(ss),__float_as_uint(ss),false,false); ss=__uint_as_float(rr[0])+__uint_as_float(rr[1]); }
    const float rs=__builtin_amdgcn_rsqf(ss*(1.0f/64.0f)+1e-6f);
    #pragma unroll
    for(int d0=0;d0<4;++d0){
      #pragma unroll
      for(int e=0;e<8;++e) qv[d0][e]*=rs*qgain[d0*16+hi*8+e]; }
    if(ropet){ const int t=tq0+wid*QBLK+r32;
      #pragma unroll
      for(int h2=0;h2<2;++h2){ const float*cs=ropet+(((h2==0)?(t>>6):(t&63))*16+hi*8)*2;
        #pragma unroll
        for(int e=0;e<8;++e){ const float c=cs[2*e],sn=cs[2*e+1]; const float x1=qv[2*h2][e],x2=qv[2*h2+1][e]; qv[2*h2][e]=x1*c-x2*sn; qv[2*h2+1][e]=x2*c+x1*sn; } } }
    #pragma unroll
    for(int d0=0;d0<4;++d0){ u32x4 w; w[0]=cvtpk_s(qv[d0][0]*C2,qv[d0][1]*C2); w[1]=cvtpk_s(qv[d0][2]*C2,qv[d0][3]*C2); w[2]=cvtpk_s(qv[d0][4]*C2,qv[d0][5]*C2); w[3]=cvtpk_s(qv[d0][6]*C2,qv[d0][7]*C2); qr[d0]=__builtin_bit_cast(bf16x8,w); }
  }
  float mhat=0.f,l_reg=0.f;f32x16 o[2];o[0]=f32x16{};o[1]=f32x16{};f32x16 negm=f32x16{};asm volatile("":"+v"(negm));
  #define CMASK(P0,P1,t) do{}while(0)
  bool resc=false;
  #define START(P0,P1) do{ const float rm=rowmax(P0,P1); resc=false; \
    { const float dl=rm; mhat=fadd_s(mhat,dl); \
      _Pragma("unroll") for(int r=0;r<16;++r){P0[r]=fsub_s(P0[r],dl);P1[r]=fsub_s(P1[r],dl);} \
      _Pragma("unroll") for(int r=0;r<16;++r)negm[r]=-mhat; asm volatile("":"+v"(negm)); } \
    _Pragma("unroll") for(int r=0;r<16;++r)P0[r]=__builtin_amdgcn_exp2f(P0[r]); }while(0)
  #define RESC() do{ if(resc){ asm volatile("s_waitcnt lgkmcnt(0)":::"memory"); \
      _Pragma("unroll") for(int d_=0;d_<2;++d_) _Pragma("unroll") for(int r=0;r<16;++r)o[d_][r]*=wsf[crow(r,hi)]; } }while(0)
  f32x16 pA0,pA1,pB0,pB1;
  int sl_prev=0,sl_cur=0,sl_next=SLOTB;
  #define ROT() do{sl_prev=sl_cur;sl_cur=sl_next;sl_next=(sl_next==(NSLOT-1)*SLOTB)?0:sl_next+SLOTB;}while(0)
  DMA_K(2,2*SLOTB);
  WAIT_BAR(3);
  qkt(pA0,pA1,Kbase,qr,negm,r32,hi);asm volatile("s_nop 15\n\ts_nop 7":"+v"(pA0),"+v"(pA1));CMASK(pA0,pA1,0);
  START(pA0,pA1);
  _Pragma("unroll") for(int r=0;r<16;++r)pA1[r]=__builtin_amdgcn_exp2f(pA1[r]);
  WAIT_BAR(0);
  DMA_K(3,0);DMA_V(1,SLOTB);
  ROT();
  kload8(kf,kp0+sl_cur);
  WAIT_BAR(2);
  s16x4 vlo[8],vhi[8]; u32x4 pw0,pw1,pw2,pw3;
  #define PKW(P,B) cvtpk_s(P[B],P[B+1])
  #define PAF(k) __builtin_bit_cast(bf16x8,pw##k)
  #define VFR(i) (bf16x8){vlo[i][0],vlo[i][1],vlo[i][2],vlo[i][3],vhi[i][0],vhi[i][1],vhi[i][2],vhi[i][3]}
  #define PIN(x) asm volatile("":"+v"(x))
  #define MX3(a,b,c) __builtin_fmaxf(__builtin_fmaxf((a),(b)),(c))
  #define GAPA(MF,A0,A1,A2,A3,W0,W1,PW) do{ MF; sacc+=A0; sacc+=A1; sacc+=A2; sacc+=A3; PIN(sacc); W0; W1; PIN(PW); SBAR(); }while(0)
  #define EX(v) __builtin_amdgcn_exp2f(v)
  #define GAPB(MF,X,B) do{ MF; X[B]=EX(X[B]); X[B+1]=EX(X[B+1]); X[B+2]=EX(X[B+2]); X[B+3]=EX(X[B+3]); PIN(X); SBAR(); }while(0)
  #define VRD(i) do{ vlo[i]=vtr(vp_+(((i)>>2)*4096+((i)&3)*1024)); vhi[i]=vtr(vp_+(((i)>>2)*4096+((i)&3)*1024+512)); }while(0)
  #define KRD(G,j) do{ if(G){ kload2(kf,kp0+sl_next,j); SBAR(); } }while(0)
  #define STEP(C0,C1,P0,P1,t,GK,GV,GL) do{ SBAR(); \
    const lds_cptr vp_=vp0+sl_prev; \
    VRD(0); SBAR(); float sacc=(P0[0]+P0[1]); \
    GAPA(C0=__builtin_amdgcn_mfma_f32_32x32x16_bf16(kf[0],qr[0],negm,0,0,0), P0[2],P0[3],P0[4],P0[5],     pw0[0]=PKW(P0,0), pw0[1]=PKW(P0,2), pw0); \
    VRD(4); SBAR(); GAPA(C1=__builtin_amdgcn_mfma_f32_32x32x16_bf16(kf[1],qr[0],negm,0,0,0), P0[6],P0[7],P0[8],P0[9],     pw0[2]=PKW(P0,4), pw0[3]=PKW(P0,6), pw0); \
    VRD(1); SBAR(); GAPA(C0=__builtin_amdgcn_mfma_f32_32x32x16_bf16(kf[2],qr[1],C0,0,0,0),   P0[10],P0[11],P0[12],P0[13], pw1[0]=PKW(P0,8), pw1[1]=PKW(P0,10), pw1); \
    VRD(5); SBAR(); GAPA(C1=__builtin_amdgcn_mfma_f32_32x32x16_bf16(kf[3],qr[1],C1,0,0,0),   P0[14],P0[15],P1[0],P1[1],   pw1[2]=PKW(P0,12),pw1[3]=PKW(P0,14), pw1); \
    VRD(2); SBAR(); GAPA(C0=__builtin_amdgcn_mfma_f32_32x32x16_bf16(kf[4],qr[2],C0,0,0,0),   P1[2],P1[3],P1[4],P1[5],     pw2[0]=PKW(P1,0), pw2[1]=PKW(P1,2), pw2); \
    VRD(6); SBAR(); GAPA(C1=__builtin_amdgcn_mfma_f32_32x32x16_bf16(kf[5],qr[2],C1,0,0,0),   P1[6],P1[7],P1[8],P1[9],     pw2[2]=PKW(P1,4), pw2[3]=PKW(P1,6), pw2); \
    VRD(3); SBAR(); GAPA(C0=__builtin_amdgcn_mfma_f32_32x32x16_bf16(kf[6],qr[3],C0,0,0,0),   P1[10],P1[11],P1[12],P1[13], pw3[0]=PKW(P1,8), pw3[1]=PKW(P1,10), pw3); \
    VRD(7); SBAR(); GAPA(C1=__builtin_amdgcn_mfma_f32_32x32x16_bf16(kf[7],qr[3],C1,0,0,0),   P1[14],P1[15],0.f,0.f,       pw3[2]=PKW(P1,12),pw3[3]=PKW(P1,14), pw3); \
    l_reg+=sacc; \
    if(GK){DMA_K((t)+3,sl_cur);} if(GV){DMA_V((t)+1,sl_next);} \
    CMASK(C0,C1,t); \
    { float a=MX3(C0[0],C0[1],C1[0]),b=MX3(C0[2],C0[3],C1[1]); a=MX3(a,C1[2],C1[3]); \
      _Pragma("unroll") for(int r=4;r<16;r+=4){a=MX3(a,C0[r],C0[r+1]);b=MX3(b,C0[r+2],C0[r+3]);a=MX3(a,C1[r],C1[r+1]);b=MX3(b,C1[r+2],C1[r+3]);} \
      float rm=__builtin_fmaxf(a,b); { auto rr=__builtin_amdgcn_permlane32_swap(__float_as_uint(rm),__float_as_uint(rm),false,false); rm=__builtin_fmaxf(__uint_as_float(rr[0]),__uint_as_float(rr[1])); } \
      resc=false; \
      if(__builtin_expect(__any(rm>(float)THRL),0)){ const float dl=__builtin_fmaxf(rm,0.f); mhat+=dl; \
        _Pragma("unroll") for(int r=0;r<16;++r){C0[r]-=dl;C1[r]-=dl;} \
        _Pragma("unroll") for(int r=0;r<16;++r)negm[r]=-mhat; asm volatile("":"+v"(negm)); \
        const float f=__builtin_amdgcn_exp2f(-dl); l_reg*=f; if(hi==0)wsf[r32]=f; resc=true; } } \
    SBAR(); \
    GAPB(o[0]=__builtin_amdgcn_mfma_f32_32x32x16_bf16(PAF(0),VFR(0),o[0],0,0,0), C0,0); \
    GAPB(o[1]=__builtin_amdgcn_mfma_f32_32x32x16_bf16(PAF(0),VFR(4),o[1],0,0,0), C0,4); \
    KRD(GL,0); GAPB(o[0]=__builtin_amdgcn_mfma_f32_32x32x16_bf16(PAF(1),VFR(1),o[0],0,0,0), C0,8); \
    KRD(GL,1); GAPB(o[1]=__builtin_amdgcn_mfma_f32_32x32x16_bf16(PAF(1),VFR(5),o[1],0,0,0), C0,12); \
    KRD(GL,2); GAPB(o[0]=__builtin_amdgcn_mfma_f32_32x32x16_bf16(PAF(2),VFR(2),o[0],0,0,0), C1,0); \
    KRD(GL,3); GAPB(o[1]=__builtin_amdgcn_mfma_f32_32x32x16_bf16(PAF(2),VFR(6),o[1],0,0,0), C1,4); \
    GAPB(o[0]=__builtin_amdgcn_mfma_f32_32x32x16_bf16(PAF(3),VFR(3),o[0],0,0,0), C1,8); \
    GAPB(o[1]=__builtin_amdgcn_mfma_f32_32x32x16_bf16(PAF(3),VFR(7),o[1],0,0,0), C1,12); \
    }while(0)
  int t=1;
  #undef CMASK
  #define CMASK(P0,P1,t) do{}while(0)
  for(;t+5<NT;t+=2){
    STEP(pB0,pB1,pA0,pA1,t,true,true,true);     WAIT_BAR(2); RESC(); ROT();
    STEP(pA0,pA1,pB0,pB1,t+1,true,true,true);   WAIT_BAR(2); RESC(); ROT();
  }
  #undef CMASK
  #define CMASK(P0,P1,t) do{}while(0)
  #define ENDW(tt) do{ if((tt)+3<NT){WAIT_BAR(2);} else if((tt)+2<NT){WAIT_BAR(1);} else {WAIT_BAR(0);} }while(0)
  for(;t+1<NT;t+=2){
    STEP(pB0,pB1,pA0,pA1,t,(t+3<NT),(t+1<NT),(t+1<NT));       ENDW(t);   RESC(); ROT();
    STEP(pA0,pA1,pB0,pB1,t+1,(t+4<NT),(t+2<NT),(t+2<NT));     ENDW(t+1); RESC(); ROT();
  }
  STEP(pB0,pB1,pA0,pA1,NT-1,false,false,false); RESC();
  { float sacc=pB0[0]+pB0[1]; _Pragma("unroll") for(int r=2;r<16;++r)sacc+=pB0[r]; _Pragma("unroll") for(int r=0;r<16;++r)sacc+=pB1[r]; l_reg+=sacc;
    pw0=(u32x4){PKW(pB0,0),PKW(pB0,2),PKW(pB0,4),PKW(pB0,6)};pw1=(u32x4){PKW(pB0,8),PKW(pB0,10),PKW(pB0,12),PKW(pB0,14)};pw2=(u32x4){PKW(pB1,0),PKW(pB1,2),PKW(pB1,4),PKW(pB1,6)};pw3=(u32x4){PKW(pB1,8),PKW(pB1,10),PKW(pB1,12),PKW(pB1,14)};
    SBAR(); pv(o,vb0+sl_cur,PAF(0),PAF(1),PAF(2),PAF(3)); }
  #undef PKW
  #undef PAF
  #undef VFR
  #undef PIN
  #undef MX3
  #undef GAPA
  #undef GAPB
  #undef EX
  #undef VRD
  #undef KRD
  #undef STEP
  #undef ENDW
  {auto rr=__builtin_amdgcn_permlane32_swap(__float_as_uint(l_reg),__float_as_uint(l_reg),false,false);l_reg=__uint_as_float(rr[0])+__uint_as_float(rr[1]);}
  if(hi==0)wsf[32+r32]=l_reg;asm volatile("s_waitcnt lgkmcnt(0)":::"memory");
  float rli[16];
  #pragma unroll
  for(int r=0;r<16;++r)rli[r]=__builtin_amdgcn_rcpf(wsf[32+crow(r,hi)]);
  bf16*Ow=Ou+(long)(wid*QBLK)*DM;
  { bf16*stg=(bf16*)(shm+LDS_OST)+wid*2048;
    #pragma unroll
    for(int r=0;r<16;++r){const int orow=crow(r,hi);
      #pragma unroll
      for(int d0=0;d0<2;++d0)stg[orow*64+d0*32+r32]=__float2bfloat16(o[d0][r]*rli[r]);}
    asm volatile("s_waitcnt lgkmcnt(0)":::"memory");
    #pragma unroll
    for(int i=0;i<4;++i){const int row=i*8+(lane>>3),ch=lane&7; const u32x4 v=*(const u32x4*)(stg+row*64+ch*8); ATTN_STORE16(Ow+(long)row*DM+ch*8,v);} }
  asm volatile("s_waitcnt lgkmcnt(0)\n\ts_barrier":::"memory");
  #undef DMA_K
  #undef DMA_V
  #undef CMASK
  #undef START
  #undef RESC
  #undef ROT
}
constexpr int ATTN_LDS_BYTES=LDS_BYTES;
#undef SBAR
#undef WAIT_BAR
}
constexpr int DM = 1024, NBATCH = 4, SEQ = 4096, CTXL = 256, NLAYER = 2;
constexpr int RLAT = NBATCH * SEQ, RCTX = NBATCH * CTXL, RT = RLAT + RCTX;
constexpr int INW = 1536, FFH = 2816, KVLEN = CTXL + SEQ, NCHK = KVLEN / 64;
constexpr int NCHUNK = RT / 64;
constexpr float RMS_EPS = 1e-6f;
constexpr int NWAVES = 8, NTHR = 512;
constexpr size_t MiB = 1u << 20;
constexpr size_t WS_CTL = 0, CTL_ZERO_BYTES = 1 * MiB;
constexpr size_t WS_WT = 1 * MiB, WT_LAYER = 21 * MiB + MiB / 2, WIN_OFF = 0, WOUT_OFF = 3 * MiB, WFI_OFF = 5 * MiB, WFO_OFF = 16 * MiB;
constexpr int MOD_SLABS = 32, MOD_ROWS = 1024 / MOD_SLABS;
constexpr size_t WS_MODP = 156 * MiB  , WS_MOD = 46 * MiB, WS_ROPE = 46 * MiB + MiB / 2, WS_AGG = 47 * MiB;
constexpr size_t WS_GWF = 48 * MiB + MiB / 2, WS_PWF = 48 * MiB + 3 * MiB / 4, WS_SPB = 49 * MiB;
constexpr size_t WS_XRC = 50 * MiB;
constexpr size_t WS_XN = 54 * MiB;
constexpr size_t WS_YO = 88 * MiB;
constexpr size_t WS_RES = 88 * MiB;
constexpr size_t WS_LRU = 0  , LRU_PLANE = 17 * MiB;
constexpr size_t WS_Y = 156 * MiB;
constexpr size_t WS_P = 190 * MiB;
constexpr size_t WS_KB = 241 * MiB, WS_VB = 245 * MiB + MiB / 4;
constexpr size_t WS_H = 156 * MiB;
constexpr size_t WS_XB = 250 * MiB, XB_BANK = 272 * 1024;
constexpr size_t WS_END = 256 * MiB;
static_assert(WS_VB + (size_t)NBATCH * KVLEN * 128 * 2 <= WS_END && WS_H + (size_t)RT * FFH * 2 <= WS_END && WS_P + (size_t)RT * INW * 2 <= WS_KB, "ws map");
constexpr int LDS_BYTES = 147456;

#define GAS __attribute__((address_space(1)))
#define LAS __attribute__((address_space(3)))
typedef unsigned short bf16;
typedef unsigned v4u __attribute__((ext_vector_type(4)));
typedef unsigned v2u __attribute__((ext_vector_type(2)));
typedef float f32x4 __attribute__((ext_vector_type(4)));
typedef float f32x2v __attribute__((ext_vector_type(2)));
typedef short bf16x8 __attribute__((ext_vector_type(8)));
typedef __bf16 bf16x2_t __attribute__((ext_vector_type(2)));
#define LDS_WAIT() asm volatile("s_waitcnt lgkmcnt(0)" ::: "memory")
__device__ __forceinline__ unsigned pk2(float lo, float hi) { f32x2v v = {lo, hi}; bf16x2_t b = __builtin_convertvector(v, bf16x2_t); return __builtin_bit_cast(unsigned, b); }
__device__ __forceinline__ float bflo(unsigned w) { return __uint_as_float(w << 16); }
__device__ __forceinline__ float bfhi(unsigned w) { return __uint_as_float(w & 0xffff0000u); }
__device__ __forceinline__ float wave_sum(float v, int lane_) {
#pragma unroll
    for (int o = 1; o < 64; o <<= 1) v += shx(v, o, lane_);
    return v;
}
__device__ __forceinline__ float sigmoid_f(float x) { return __builtin_amdgcn_rcpf(1.0f + __expf(-x)); }
__device__ __forceinline__ float gelu_tanh_f(float x) { const float t = fmaf(x * x, -2.0f * 1.4426950408889634f * 0.7978845608028654f * 0.044715f, -2.0f * 1.4426950408889634f * 0.7978845608028654f); return x * __builtin_amdgcn_rcpf(1.0f + __builtin_amdgcn_exp2f(x * t)); }

#define XB_TMO      128
#define XB_XCNT(j)  (256  + 64 * (j))
#define XB_XSUB(j)  (1280 + 64 * (j))
#define XB_XGEN(j)  (2304 + 64 * (j))
#define XB_TOP      3328
#define XB_TOPGEN   3392
#define XCD_BAR_WORDS 3456
#define XB_SPIN_CAP (1u << 18)

__device__ __forceinline__ unsigned xb_ld(unsigned* p)              { return __hip_atomic_load(p, __ATOMIC_RELAXED, __HIP_MEMORY_SCOPE_AGENT); }
__device__ __forceinline__ unsigned xb_add(unsigned* p, unsigned v) { return __hip_atomic_fetch_add(p, v, __ATOMIC_RELAXED, __HIP_MEMORY_SCOPE_AGENT); }
__device__ __forceinline__ unsigned xb_xcc_id() { return (unsigned)__builtin_amdgcn_s_getreg((3 << 11) | 20) & 0xFu; }
#define XB_SPIN(cond, bar) do { unsigned _sp = 0; while (cond) { __builtin_amdgcn_s_sleep(1); \
    if ((++_sp & 255u) == 0u) { if (xb_ld(&(bar)[XB_TMO])) break; if (_sp > XB_SPIN_CAP) { atomicAdd(&(bar)[XB_TMO], 1u); break; } } } } while (0)

struct XcdBarrier {
    unsigned* bar; unsigned x;
    volatile LAS unsigned* st;
};

__device__ __forceinline__ XcdBarrier xcd_barrier_post(unsigned* bar, volatile LAS unsigned* st, bool leader) {
    XcdBarrier b; b.bar = bar; b.x = xb_xcc_id(); b.st = st;
    if (leader) (void)xb_add(&bar[XB_XCNT(b.x)], 1u);
    return b;
}
__device__ __forceinline__ void xcd_barrier_complete(unsigned* bar, unsigned x, unsigned& nloc, unsigned& nx) {
    const unsigned G = gridDim.x * gridDim.y * gridDim.z;
    unsigned sum, cnt, mine, sp = 0u;
    for (;;) {
        sum = 0u; cnt = 0u; mine = 0u;
#pragma unroll
        for (unsigned j = 0; j < 16; ++j) { const unsigned c = xb_ld(&bar[XB_XCNT(j)]); sum += c; cnt += (c > 0u) ? 1u : 0u; mine = (j == x) ? c : mine; }
        if (sum == G) break;
        __builtin_amdgcn_s_sleep(1);
        if ((++sp & 255u) == 0u) { if (xb_ld(&bar[XB_TMO])) break; if (sp > XB_SPIN_CAP) { atomicAdd(&bar[XB_TMO], 1u); break; } }
    }
    nloc = mine > 0u ? mine : 1u; nx = cnt > 0u ? cnt : 1u;
}

__device__ __forceinline__ void xcd_barrier(const XcdBarrier& b, bool leader) {
    asm volatile("s_waitcnt vmcnt(0)" ::: "memory");
    __syncthreads();
    if (leader) {
        unsigned* bar = b.bar;
        __builtin_amdgcn_s_waitcnt(0);
        unsigned nloc = b.st[0], nx = b.st[1];
        if (nloc == 0u) { xcd_barrier_complete(bar, b.x, nloc, nx); b.st[0] = nloc; b.st[1] = nx; }
        const unsigned old = xb_add(&bar[XB_XSUB(b.x)], 1u);
        const unsigned gen = old / nloc;
        if (old + 1u == (gen + 1u) * nloc) {
            __builtin_amdgcn_fence(__ATOMIC_RELEASE, "agent");
            asm volatile("s_waitcnt vmcnt(0)" ::: "memory");
            const unsigned og = xb_add(&bar[XB_TOP], 1u);
            const unsigned tg = og / nx;
            if (og + 1u == (tg + 1u) * nx) xb_add(&bar[XB_TOPGEN], 1u);
            else XB_SPIN(xb_ld(&bar[XB_TOPGEN]) == tg, bar);
            __builtin_amdgcn_fence(__ATOMIC_ACQUIRE, "agent");
            xb_add(&bar[XB_XGEN(b.x)], 1u);
            asm volatile("s_waitcnt vmcnt(0)" ::: "memory");
        } else {
            XB_SPIN(xb_ld(&bar[XB_XGEN(b.x)]) == gen, bar);
            __builtin_amdgcn_fence(__ATOMIC_ACQUIRE, "agent");
            asm volatile("s_waitcnt vmcnt(0)" ::: "memory");
        }
    }
    __syncthreads();
}

constexpr int CW_TMO = 0, CW_SEAM = 16384, SEAM_BANK = 68 * 64;
constexpr int CW_BAR = 4096;
constexpr int MISC_OFF = LDS_BYTES - 64;
struct Params { const float* in[21]; float* out; unsigned char* ws; };
typedef const __attribute__((address_space(4))) unsigned long long* kargp_t;
__device__ __forceinline__ const float* kin(int i) { return (const float*)((kargp_t)__builtin_amdgcn_kernarg_segment_ptr())[i]; }
__device__ __forceinline__ float* kout() { return (float*)((kargp_t)__builtin_amdgcn_kernarg_segment_ptr())[21]; }
__device__ __forceinline__ unsigned char* kws() { return (unsigned char*)((kargp_t)__builtin_amdgcn_kernarg_segment_ptr())[22]; }
enum { I_X = 0, I_C, I_CTX, I_CCTX, I_WMOD, I_BMOD, I_NORMG, I_WIN, I_QNG, I_KNG, I_CONVW, I_CONVB, I_GATEW, I_GATEB, I_LAM, I_POOLW, I_POOLB, I_POOLS, I_WOUT, I_WFI, I_WFO };

__device__ __forceinline__ void transpose_item(const float* W, int K, int N, bf16* WT, int orow0, int k0, int n0, LAS float* scr, int lane) {
    float tv[32];
#pragma unroll
    for (int i = 0; i < 32; ++i) tv[i] = __builtin_nontemporal_load(W + (size_t)(k0 + 2 * i + (lane >> 5)) * N + n0 + (lane & 31));
#pragma unroll
    for (int i = 0; i < 32; ++i) scr[(2 * i + (lane >> 5)) * 33 + (lane & 31)] = tv[i];
    LDS_WAIT(); asm volatile("" ::: "memory");
    const int c = lane & 7;
#pragma unroll
    for (int j = 0; j < 4; ++j) { const int n = (lane >> 3) + 8 * j; const LAS float* s = scr + (8 * c) * 33 + n;
        v4u o; o.x = pk2(s[0 * 33], s[1 * 33]); o.y = pk2(s[2 * 33], s[3 * 33]); o.z = pk2(s[4 * 33], s[5 * 33]); o.w = pk2(s[6 * 33], s[7 * 33]);
        *(GAS v4u*)(WT + (size_t)(orow0 + n) * K + k0 + 8 * c) = o; }
    LDS_WAIT(); asm volatile("" ::: "memory");
}
__device__ __forceinline__ void phase0a(const Params& p, LAS unsigned char* lds, int tid, int lane, int wave, int vcu, int G) {
    unsigned char* ws = kws();
    { const int gt = ((tid >> 6) * (int)gridDim.x + (int)blockIdx.x) * 64 + (tid & 63);
      if (gt < 1024) { const int pos = gt >> 4, i = gt & 15; const float freq = exp2f(-(float)i * (13.287712379549449f / 16.0f)); const float ang = (float)pos * freq;
          const float k = rintf(ang * 0.15915494309189535f); float r = fmaf(-k, 6.2831855f, ang); r = fmaf(k, 1.7484555e-7f, r);
          float* rp = (float*)(ws + WS_ROPE); rp[2 * gt] = cosf(r); rp[2 * gt + 1] = sinf(r); } }
    { const int gt = ((tid >> 6) * (int)gridDim.x + (int)blockIdx.x) * 64 + (tid & 63);
      if (gt < 16384) { const int ln = gt & 63, f = gt >> 6, kk = f & 1, nt = (f >> 1) & 3, g2 = (f >> 3) & 1, n = (f >> 4) & 3, d = (f >> 6) & 1, l = f >> 7, qd = ln >> 4, l16 = ln & 15;
          const float* gw_ = kin(I_GATEW) + ((size_t)(((l * 2 + d) * 2 + g2) * 4 + n)) * 4096 + (kk * 32 + qd * 8) * 64 + nt * 16 + l16;
          v4u o; o.x = pk2(gw_[0], gw_[64]); o.y = pk2(gw_[128], gw_[192]); o.z = pk2(gw_[256], gw_[320]); o.w = pk2(gw_[384], gw_[448]);
          ((v4u*)(ws + WS_GWF))[gt] = o; }
      else if (gt < 16384 + 4096) { const int q = gt - 16384, ln = q & 63, f = q >> 6, kk = f & 1, nt = (f >> 1) & 3, lg = f >> 3, qd = ln >> 4, l16 = ln & 15;
          const float* pw = kin(I_POOLW) + (size_t)lg * 4096 + (kk * 32 + qd * 8) * 64 + nt * 16 + l16;
          v4u o; o.x = pk2(pw[0], pw[64]); o.y = pk2(pw[128], pw[192]); o.z = pk2(pw[256], pw[320]); o.w = pk2(pw[384], pw[448]);
          ((v4u*)(ws + WS_PWF))[q] = o; }
      else if (gt < 16384 + 4096 + 3072) { const int q = gt - 20480, ch = q & 255, k3 = (q >> 8) % 3, ld = q / 768;
          float v;
          if (k3 < 2) v = kin(I_GATEB)[(ld * 2 + k3) * 256 + ch]; else v = -8.0f * 1.4426950408889634f * log1pf(expf(-kin(I_LAM)[ld * 256 + ch]));
          ((float*)(ws + WS_SPB))[q] = v; } }
    LAS float* S = (LAS float*)(lds + 8 * 8448);
    for (int i = tid; i < 5 * 1024; i += NTHR) { const float v = (i < 4096) ? kin(I_C)[i] : kin(I_CCTX)[i - 4096]; S[i] = v / (1.0f + expf(-v)); }
    __syncthreads();
    LAS float* scr = (LAS float*)(lds + wave * 8448);
    constexpr int I_IN = 16 * 48, I_OUT = 16 * 32, I_FI = 16 * 176, I_FO = 44 * 32, PER = I_IN + I_OUT + I_FI + I_FO;
    constexpr int NGEMV = NLAYER * MOD_SLABS * 24;
    for (int it0 = wave * G + vcu; it0 < NGEMV + NLAYER * PER; it0 += NWAVES * G) {
        if (it0 < NGEMV) {
            const int l = it0 / (MOD_SLABS * 24), rem = it0 % (MOD_SLABS * 24), slab = rem / 24, cb = rem % 24, col = cb * 256 + lane * 4;
            f32x4 a0 = {0.f, 0.f, 0.f, 0.f}, a1 = a0, a2 = a0, a3 = a0, a4 = a0;
            const float* wp = kin(I_WMOD) + ((size_t)(l * 1024 + slab * MOD_ROWS)) * 6144 + col;
#pragma unroll 8
            for (int k = 0; k < MOD_ROWS; ++k) { const f32x4 w = __builtin_nontemporal_load((const GAS f32x4*)(wp + (size_t)k * 6144)); const int kk = slab * MOD_ROWS + k;
                a0 += S[kk] * w; a1 += S[1024 + kk] * w; a2 += S[2048 + kk] * w; a3 += S[3072 + kk] * w; a4 += S[4096 + kk] * w; }
            float* o = (float*)(ws + WS_MODP) + ((size_t)((l * MOD_SLABS + slab) * 5)) * 6144 + col;
            *(f32x4*)(o) = a0; *(f32x4*)(o + 6144) = a1; *(f32x4*)(o + 2 * 6144) = a2; *(f32x4*)(o + 3 * 6144) = a3; *(f32x4*)(o + 4 * 6144) = a4;
            continue;
        }
        const int it = it0 - NGEMV;
        const int l = it / PER; int r = it % PER; unsigned char* wl = ws + WS_WT + (size_t)l * WT_LAYER;
        if (r < I_IN) { const int kb = r / 48, nb = r % 48; transpose_item(kin(I_WIN) + (size_t)l * 1024 * 1536, 1024, 1536, (bf16*)(wl + WIN_OFF), 32 * nb, 64 * kb, 32 * nb, scr, lane); continue; } r -= I_IN;
        if (r < I_OUT) { const int kb = r / 32, nb = r % 32; transpose_item(kin(I_WOUT) + (size_t)l * 1024 * 1024, 1024, 1024, (bf16*)(wl + WOUT_OFF), 32 * nb, 64 * kb, 32 * nb, scr, lane); continue; } r -= I_OUT;
        if (r < I_FI) { const int kb = r / 176, nb = r % 176; const int n0 = 32 * nb; const int j = n0 < FFH ? n0 : n0 - FFH; const int orow0 = 256 * (j / 128) + (j % 128) + (n0 < FFH ? 0 : 128);
            transpose_item(kin(I_WFI) + (size_t)l * 1024 * 5632, 1024, 5632, (bf16*)(wl + WFI_OFF), orow0, 64 * kb, n0, scr, lane); continue; } r -= I_FI;
        { const int kb = r / 32, nb = r % 32; transpose_item(kin(I_WFO) + (size_t)l * FFH * 1024, FFH, 1024, (bf16*)(wl + WFO_OFF), 32 * nb, 64 * kb, 32 * nb, scr, lane); }
    }
}
__device__ __forceinline__ void phase0b(const Params& p, int tid) {
    const int gt = ((tid >> 6) * (int)gridDim.x + (int)blockIdx.x) * 64 + (tid & 63);
    if (gt < NLAYER * 5 * 6144) {
        const int l = gt / 30720, rem = gt % 30720, r = rem / 6144, j = rem % 6144, c = j >> 10, col = j & 1023;
        const float* modp = (const float*)(kws() + WS_MODP);
        float raw = kin(I_BMOD)[l * 6144 + j];
#pragma unroll
        for (int s = 0; s < MOD_SLABS; ++s) raw += modp[((size_t)((l * MOD_SLABS + s) * 5 + r)) * 6144 + j];
        const float* ng = kin(I_NORMG) + l * 4096;
        float val = raw;
        if (c == 1) val = ng[col] * (1.0f + raw); else if (c == 2) val = raw * ng[1024 + col]; else if (c == 4) val = ng[2048 + col] * (1.0f + raw); else if (c == 5) val = raw * ng[3072 + col];
        ((float*)(kws() + WS_MOD))[gt] = val;
    }
}
template <bool HAS_YO, bool HAS_NEXT>
__device__ __forceinline__ void norm_phase(const float* yo, const float* src_lat, const float* src_ctx, float* dst_lat, float* dst_ctx,
                                           const float* modG, const float* modA, const float* modS, bf16* XN, int nrows, int gw, int NGW, int lane) {
    asm volatile("" : "+v"(lane));
    for (int m = gw; m < nrows; m += NGW) {
        const int r = m < RLAT ? (m >> 12) : 4;
        const float* src = m < RLAT ? src_lat + (size_t)m * DM : src_ctx + (size_t)(m - RLAT) * DM;
        f32x4 v[4];
#pragma unroll
        for (int j = 0; j < 4; ++j) v[j] = __builtin_nontemporal_load((const GAS f32x4*)(src + 4 * lane + 256 * j));
        if (HAS_YO) {
            f32x4 y[4]; float ss = 0.f;
#pragma unroll
            for (int j = 0; j < 4; ++j) { y[j] = *(const GAS f32x4*)(yo + (size_t)m * DM + 4 * lane + 256 * j); ss += (y[j].x * y[j].x + y[j].y * y[j].y) + (y[j].z * y[j].z + y[j].w * y[j].w); }
            const float rs = rsqrtf(wave_sum(ss, lane) * (1.0f / DM) + RMS_EPS);
            float* dst = m < RLAT ? dst_lat + (size_t)m * DM : dst_ctx + (size_t)(m - RLAT) * DM;
#pragma unroll
            for (int j = 0; j < 4; ++j) { const f32x4 g = *(const GAS f32x4*)(modG + r * 6144 + 4 * lane + 256 * j); v[j] += g * y[j] * rs; *(GAS f32x4*)(dst + 4 * lane + 256 * j) = v[j]; }
        }
        if (HAS_NEXT) {
            float ss = 0.f;
#pragma unroll
            for (int j = 0; j < 4; ++j) ss += (v[j].x * v[j].x + v[j].y * v[j].y) + (v[j].z * v[j].z + v[j].w * v[j].w);
            const float rs = rsqrtf(wave_sum(ss, lane) * (1.0f / DM) + RMS_EPS);
#pragma unroll
            for (int j = 0; j < 4; ++j) { const f32x4 a = *(const GAS f32x4*)(modA + r * 6144 + 4 * lane + 256 * j), s = *(const GAS f32x4*)(modS + r * 6144 + 4 * lane + 256 * j);
                const f32x4 o = v[j] * rs * a + s; v2u w; w.x = pk2(o.x, o.y); w.y = pk2(o.z, o.w); *(GAS v2u*)(XN + (size_t)m * DM + 4 * lane + 256 * j) = w; }
        }
    }
}
__device__ __forceinline__ void xn0_slot_phase(LAS unsigned char* lds, int tid, int wave, int vcu) {
    asm volatile("" : "+v"(tid)); const int lane = tid & 63;
    const bool lat = vcu < 240; const int slot = lat ? vcu / 60 : 4, w = lat ? vcu % 60 : vcu - 240, nw = lat ? 60 : 16, nrows = lat ? SEQ : RCTX;
    LAS float* AS = (LAS float*)lds;
    {   const float* modp = (const float*)(kws() + WS_MODP);
        for (int col = tid; col < 1024; col += NTHR) {
            float r0 = kin(I_BMOD)[col], r1 = kin(I_BMOD)[1024 + col];
#pragma unroll 16
            for (int s = 0; s < MOD_SLABS; ++s) { const float* q = modp + ((size_t)(s * 5 + slot)) * 6144 + col; r0 += q[0]; r1 += q[1024]; }
            AS[col] = kin(I_NORMG)[col] * (1.0f + r1); AS[1024 + col] = r0; } }
    __syncthreads();
    const float* src = lat ? kin(I_X) + (size_t)slot * SEQ * DM : kin(I_CTX);
    bf16* dstn = (bf16*)(kws() + WS_XN) + (size_t)(lat ? slot * SEQ : RLAT) * DM;
    f32x4 a[4], sh[4];
#pragma unroll
    for (int j = 0; j < 4; ++j) { a[j] = *(const LAS f32x4*)(AS + 4 * lane + 256 * j); sh[j] = *(const LAS f32x4*)(AS + 1024 + 4 * lane + 256 * j); }
    for (int i = w + nw * wave; i < nrows; i += nw * NWAVES) {
        f32x4 v[4]; float ss = 0.f;
#pragma unroll
        for (int j = 0; j < 4; ++j) v[j] = __builtin_nontemporal_load((const GAS f32x4*)(src + (size_t)i * DM + 4 * lane + 256 * j));
#pragma unroll
        for (int j = 0; j < 4; ++j) ss += (v[j].x * v[j].x + v[j].y * v[j].y) + (v[j].z * v[j].z + v[j].w * v[j].w);
        const float rs = rsqrtf(wave_sum(ss, lane) * (1.0f / DM) + RMS_EPS);
#pragma unroll
        for (int j = 0; j < 4; ++j) { const f32x4 o = v[j] * rs * a[j] + sh[j]; v2u wv; wv.x = pk2(o.x, o.y); wv.y = pk2(o.z, o.w); *(GAS v2u*)(dstn + (size_t)i * DM + 4 * lane + 256 * j) = wv; }
    }
    __syncthreads();
}
__device__ __forceinline__ void ctx_norm(const float* slabs, int nslab, const float* src, float* dst, const float* vG, const float* vA, const float* vS, bf16* XNc, int gw, int NGW, int lane) {
    asm volatile("" : "+v"(lane));
    for (int m = gw; m < RCTX; m += NGW) {
        f32x4 v[4], g[4], a[4], sh[4];
#pragma unroll
        for (int j = 0; j < 4; ++j) { v[j] = __builtin_nontemporal_load((const GAS f32x4*)(src + (size_t)m * DM + 4 * lane + 256 * j)); g[j] = *(const GAS f32x4*)(vG + 4 * lane + 256 * j);
            a[j] = *(const GAS f32x4*)(vA + 4 * lane + 256 * j); sh[j] = *(const GAS f32x4*)(vS + 4 * lane + 256 * j); }
        f32x4 y[4] = {{0.f, 0.f, 0.f, 0.f}, {0.f, 0.f, 0.f, 0.f}, {0.f, 0.f, 0.f, 0.f}, {0.f, 0.f, 0.f, 0.f}};
        const float* sp = slabs + (size_t)m * DM + 4 * lane;
        for (int s0 = 0; s0 < nslab; s0 += 6) {
            f32x4 t[6][4];
#pragma unroll
            for (int s = 0; s < 6; ++s)
#pragma unroll
                for (int j = 0; j < 4; ++j) t[s][j] = (s0 + s < nslab) ? __builtin_nontemporal_load((const GAS f32x4*)(sp + (size_t)(s0 + s) * RCTX * DM + 256 * j)) : (f32x4){0.f, 0.f, 0.f, 0.f};
#pragma unroll
            for (int s = 0; s < 6; ++s)
#pragma unroll
                for (int j = 0; j < 4; ++j) y[j] += t[s][j]; }
        float ss = 0.f;
#pragma unroll
        for (int j = 0; j < 4; ++j) ss += (y[j].x * y[j].x + y[j].y * y[j].y) + (y[j].z * y[j].z + y[j].w * y[j].w);
        const float rs = rsqrtf(wave_sum(ss, lane) * (1.0f / DM) + RMS_EPS);
        float s2 = 0.f;
#pragma unroll
        for (int j = 0; j < 4; ++j) { v[j] += g[j] * y[j] * rs;
            *(GAS f32x4*)(dst + (size_t)m * DM + 4 * lane + 256 * j) = v[j]; s2 += (v[j].x * v[j].x + v[j].y * v[j].y) + (v[j].z * v[j].z + v[j].w * v[j].w); }
        const float rs2 = rsqrtf(wave_sum(s2, lane) * (1.0f / DM) + RMS_EPS);
#pragma unroll
        for (int j = 0; j < 4; ++j) { const f32x4 o = v[j] * rs2 * a[j] + sh[j]; v2u w; w.x = pk2(o.x, o.y); w.y = pk2(o.z, o.w); *(GAS v2u*)(XNc + (size_t)m * DM + 4 * lane + 256 * j) = w; }
    }
}
struct ChunkInfo { int row0, t0, L, b, isctx, cpos; };
__device__ __forceinline__ ChunkInfo chunk_info(int c) {
    ChunkInfo ci;
    if (c < RLAT / 64) { ci.b = c >> 6; const int j = c & 63; ci.t0 = j * 64; ci.row0 = ci.b * SEQ + ci.t0; ci.L = SEQ; ci.isctx = 0; ci.cpos = 4 + j; }
    else { const int cc = c - RLAT / 64; ci.b = cc >> 2; const int j = cc & 3; ci.t0 = j * 64; ci.row0 = RLAT + ci.b * CTXL + ci.t0; ci.L = CTXL; ci.isctx = 1; ci.cpos = j; }
    return ci;
}
constexpr int LROW = 264;
__device__ __forceinline__ void qk_norm_rope(float (&v)[8], const float* gain8, const float* rope, int s, int t, bool do_rope, int lane_) {
    float ss = 0.f;
#pragma unroll
    for (int e = 0; e < 8; ++e) ss += v[e] * v[e];
    ss += shx(ss, 1, lane_); ss += shx(ss, 2, lane_); ss += shx(ss, 4, lane_);
    const float rs = __builtin_amdgcn_rsqf(ss * (1.0f / 64.0f) + RMS_EPS);
#pragma unroll
    for (int e = 0; e < 8; ++e) v[e] *= rs * gain8[e];
    const int pos = (s < 4) ? (t >> 6) : (t & 63);
    const float* cs = rope + (pos * 16 + (s & 1) * 8) * 2;
    float pv[8];
#pragma unroll
    for (int e = 0; e < 8; ++e) pv[e] = shx(v[e], 2, lane_);
    if (do_rope) {
#pragma unroll
        for (int e4 = 0; e4 < 4; ++e4) { const f32x4 q = *(const GAS f32x4*)(cs + 4 * e4);
            const int e = 2 * e4;
            if (s & 2) { v[e] = v[e] * q.x + pv[e] * q.y; v[e + 1] = v[e + 1] * q.z + pv[e + 1] * q.w; }
            else       { v[e] = v[e] * q.x - pv[e] * q.y; v[e + 1] = v[e + 1] * q.z - pv[e + 1] * q.w; } }
    }
}
__device__ __forceinline__ void unpack8(const v4u w, float (&v)[8]) { v[0] = bflo(w.x); v[1] = bfhi(w.x); v[2] = bflo(w.y); v[3] = bfhi(w.y); v[4] = bflo(w.z); v[5] = bfhi(w.z); v[6] = bflo(w.w); v[7] = bfhi(w.w); }
__device__ __forceinline__ v4u pack8(const float (&v)[8]) { v4u w; w.x = pk2(v[0], v[1]); w.y = pk2(v[2], v[3]); w.z = pk2(v[4], v[5]); w.w = pk2(v[6], v[7]); return w; }

__device__ __forceinline__ void mixprep_chunk(const Params& p, int layer, int c, int smask, LAS unsigned char* lds, int tid, int lane, int wave) {
    asm volatile("" : "+v"(tid)); lane = tid & 63;
    const ChunkInfo ci = chunk_info(c);
    unsigned char* ws = kws();
    const bf16* P = (const bf16*)(ws + WS_P); bf16* Y = (bf16*)(ws + WS_Y);
    const float* rope = (const float*)(ws + WS_ROPE);
    const int quad = lane >> 4, l16 = lane & 15;
    v4u wB[5], wC[5], kraw[2], vraw[2];
    if (smask & 2) {
#pragma unroll
        for (int i = 0; i < 5; ++i) { const int idx = tid + i * NTHR, rr = idx >> 5, c8 = idx & 31; const int t = ci.t0 - 8 + rr;
            wB[i] = (v4u){0u, 0u, 0u, 0u};
            if (t >= 0 && t < ci.L) wB[i] = __builtin_nontemporal_load((const GAS v4u*)(P + ((size_t)ci.row0 - 8 + rr) * INW + 1280 + c8 * 8)); } }
    if (smask & 4) {
#pragma unroll
        for (int i = 0; i < 5; ++i) { const int idx = tid + i * NTHR, rr = idx >> 5, c8 = idx & 31; const int t = ci.t0 - 2 + rr;
            wC[i] = (v4u){0u, 0u, 0u, 0u};
            if (idx < 67 * 32 && t >= 0 && t < ci.L) wC[i] = __builtin_nontemporal_load((const GAS v4u*)(P + ((size_t)ci.row0 - 2 + rr) * INW + 768 + c8 * 8)); } }
    if (smask & 1) {   const int s = lane & 7;
#pragma unroll
        for (int ps = 0; ps < 2; ++ps) { const int idx = ps * NTHR + tid, tok = idx >> 4, s16 = idx & 15; const size_t row = (size_t)ci.row0 + tok;
            kraw[ps] = __builtin_nontemporal_load((const GAS v4u*)(P + row * INW + 512 + s16 * 8)); vraw[ps] = __builtin_nontemporal_load((const GAS v4u*)(P + row * INW + 640 + s16 * 8)); }
        float gk[8];
#pragma unroll
        for (int e = 0; e < 8; ++e) gk[e] = kin(I_KNG)[layer * 64 + s * 8 + e];
#pragma unroll
        for (int ps = 0; ps < 2; ++ps) { const int idx = ps * NTHR + tid, tok = idx >> 4; const int t = ci.t0 + tok;
            float v[8]; unpack8(kraw[ps], v);
            qk_norm_rope(v, gk, rope, s, t, !ci.isctx, lane);
            kraw[ps] = pack8(v); }
        bf16* KB = (bf16*)(ws + WS_KB); bf16* VB = (bf16*)(ws + WS_VB);
#pragma unroll
        for (int ps = 0; ps < 2; ++ps) { const int idx = ps * NTHR + tid, tok = idx >> 4, s16 = idx & 15; const int t = ci.t0 + tok;
            const size_t krow = (size_t)ci.b * KVLEN + (ci.isctx ? t : CTXL + t);
            *(GAS v4u*)(KB + krow * 128 + s16 * 8) = kraw[ps]; *(GAS v4u*)(VB + krow * 128 + s16 * 8) = vraw[ps]; }
    }
    if (smask & 2) {   LAS bf16* PX = (LAS bf16*)lds;
        LAS bf16* DB = (LAS bf16*)(lds + 45056);
#pragma unroll
        for (int i = 0; i < 5; ++i) { const int idx = tid + i * NTHR, rr = idx >> 5, c8 = idx & 31; *(LAS v4u*)(PX + rr * LROW + c8 * 8) = wB[i]; }
        __syncthreads();
        {   const int cp = tid & 127, tg = tid >> 7, g = cp >> 5, half = 1 << g;
            const LAS unsigned* PXw = (const LAS unsigned*)PX;
            float s0 = 0.f, s1 = 0.f;
            for (int rr = tg * 16 - half + 8; rr < tg * 16 + half + 8; ++rr) { const unsigned w = PXw[rr * (LROW / 2) + cp]; s0 += bflo(w); s1 += bfhi(w); }
#pragma unroll 4
            for (int i = 0; i < 16; ++i) { const int tok = tg * 16 + i, t = ci.t0 + tok;
                const int lo = max(t - half, 0), hi = min(t + half, ci.L); const float icnt = __builtin_amdgcn_rcpf((float)(hi - lo));
                const unsigned w = PXw[(tok + 8) * (LROW / 2) + cp];
                const float d0 = s0 * icnt - bflo(w), d1 = s1 * icnt - bfhi(w);
                ((LAS unsigned*)DB)[tok * (LROW / 2) + cp] = pk2(d0, d1);
                const unsigned wa = PXw[(tok + half + 8) * (LROW / 2) + cp], wr_ = PXw[(tok - half + 8) * (LROW / 2) + cp];
                s0 += bflo(wa) - bflo(wr_); s1 += bfhi(wa) - bfhi(wr_); }
        }
        __syncthreads();
        {   const int g = wave & 3, th = wave >> 2;
            const GAS v4u* pwf = (const GAS v4u*)(ws + WS_PWF) + (size_t)((layer * 4 + g) * 8) * 64 + lane;
            bf16x8 wf[4][2];
#pragma unroll
            for (int nt = 0; nt < 4; ++nt)
#pragma unroll
                for (int kk = 0; kk < 2; ++kk) wf[nt][kk] = __builtin_bit_cast(bf16x8, pwf[(nt * 2 + kk) * 64]);
            f32x4 pbv[4], psv[4];
#pragma unroll
            for (int nt = 0; nt < 4; ++nt) { pbv[nt] = *(const GAS f32x4*)(kin(I_POOLB) + layer * 256 + g * 64 + nt * 16 + quad * 4); psv[nt] = *(const GAS f32x4*)(kin(I_POOLS) + layer * 256 + g * 64 + nt * 16 + quad * 4); }
#pragma unroll
            for (int mi = 0; mi < 2; ++mi) { const int mt = th * 2 + mi;
                bf16x8 af[2];
#pragma unroll
                for (int kk = 0; kk < 2; ++kk) af[kk] = *(const LAS bf16x8*)(DB + (mt * 16 + l16) * LROW + g * 64 + kk * 32 + quad * 8);
                const size_t row = (size_t)ci.row0 + mt * 16 + l16;
#pragma unroll
                for (int nt = 0; nt < 4; ++nt) { f32x4 acc = {0.f, 0.f, 0.f, 0.f};
                    acc = __builtin_amdgcn_mfma_f32_16x16x32_bf16(wf[nt][0], af[0], acc, 0, 0, 0);
                    acc = __builtin_amdgcn_mfma_f32_16x16x32_bf16(wf[nt][1], af[1], acc, 0, 0, 0);
                    const int ch = g * 64 + nt * 16 + quad * 4;
                    const f32x4 o = (acc + pbv[nt]) * psv[nt]; v2u w; w.x = pk2(o.x, o.y); w.y = pk2(o.z, o.w);
                    *(GAS v2u*)(Y + row * DM + 768 + ch) = w; } }
        }
        __syncthreads();
    }
    if (smask & 4) {   LAS bf16* LX = (LAS bf16*)lds;
        LAS bf16* UB = (LAS bf16*)(lds + 35840);
        LAS float* SC = (LAS float*)(lds + 69632 + wave * 8704);
#pragma unroll
        for (int i = 0; i < 5; ++i) { const int idx = tid + i * NTHR, rr = idx >> 5, c8 = idx & 31; if (idx < 67 * 32) *(LAS v4u*)(LX + rr * LROW + c8 * 8) = wC[i]; }
        __syncthreads();
        {   const int cp = tid & 127, tg = tid >> 7;
            const float* cw = kin(I_CONVW) + layer * 1024; const float* cb = kin(I_CONVB) + layer * 256;
            float w0[4], w1[4];
#pragma unroll
            for (int k = 0; k < 4; ++k) { w0[k] = cw[k * 256 + 2 * cp]; w1[k] = cw[k * 256 + 2 * cp + 1]; }
            const float b0 = cb[2 * cp], b1 = cb[2 * cp + 1];
            const LAS unsigned* LXw = (const LAS unsigned*)LX;
#pragma unroll 4
            for (int i = 0; i < 16; ++i) { const int tok = tg * 16 + i; float u0 = b0, u1 = b1;
#pragma unroll
                for (int k = 0; k < 4; ++k) { const unsigned w = LXw[(tok + k) * (LROW / 2) + cp]; u0 += bflo(w) * w0[k]; u1 += bfhi(w) * w1[k]; }
                ((LAS unsigned*)UB)[tok * (LROW / 2) + cp] = pk2(u0, u1); }
        }
        __syncthreads();
        {   const int d = wave >> 2, n = wave & 3;
            const GAS v4u* gwf = (const GAS v4u*)(ws + WS_GWF) + (size_t)(((layer * 2 + d) * 4 + n) * 16) * 64 + lane;
            const GAS float* spb = (const GAS float*)(ws + WS_SPB) + (layer * 2 + d) * 768 + n * 64 + quad * 4;
            bf16x8 wf[2][4][2]; f32x4 brv[4], biv[4], spv[4];
#pragma unroll
            for (int gt = 0; gt < 2; ++gt)
#pragma unroll
                for (int nt = 0; nt < 4; ++nt)
#pragma unroll
                    for (int kk = 0; kk < 2; ++kk) wf[gt][nt][kk] = __builtin_bit_cast(bf16x8, gwf[((gt * 4 + nt) * 2 + kk) * 64]);
#pragma unroll
            for (int nt = 0; nt < 4; ++nt) { brv[nt] = *(const GAS f32x4*)(spb + nt * 16); biv[nt] = *(const GAS f32x4*)(spb + 256 + nt * 16); spv[nt] = *(const GAS f32x4*)(spb + 512 + nt * 16); }
            float h = 0.f, ap = 1.f;
            unsigned* HA = (unsigned*)((unsigned char*)kout() + WS_LRU + (size_t)d * LRU_PLANE);
#pragma unroll 1
            for (int q = 0; q < 4; ++q) { const int mt = d ? 3 - q : q; asm volatile("" ::: "memory");
                bf16x8 af[2];
#pragma unroll
                for (int kk = 0; kk < 2; ++kk) af[kk] = *(const LAS bf16x8*)(UB + (mt * 16 + l16) * LROW + n * 64 + kk * 32 + quad * 8);
#pragma unroll
                for (int nt = 0; nt < 4; ++nt) { f32x4 ar = brv[nt], ai = biv[nt];
                    ar = __builtin_amdgcn_mfma_f32_16x16x32_bf16(wf[0][nt][0], af[0], ar, 0, 0, 0); ar = __builtin_amdgcn_mfma_f32_16x16x32_bf16(wf[0][nt][1], af[1], ar, 0, 0, 0);
                    ai = __builtin_amdgcn_mfma_f32_16x16x32_bf16(wf[1][nt][0], af[0], ai, 0, 0, 0); ai = __builtin_amdgcn_mfma_f32_16x16x32_bf16(wf[1][nt][1], af[1], ai, 0, 0, 0);
                    const v2u xw = *(const LAS v2u*)(UB + (mt * 16 + l16) * LROW + n * 64 + nt * 16 + quad * 4);
                    const float xv[4] = {bflo(xw.x), bfhi(xw.x), bflo(xw.y), bfhi(xw.y)};
                    f32x4 av, uv;
#pragma unroll
                    for (int j = 0; j < 4; ++j) { const float r = __builtin_amdgcn_rcpf(1.0f + __builtin_amdgcn_exp2f(-1.4426950408889634f * ar[j])), ig = __builtin_amdgcn_rcpf(1.0f + __builtin_amdgcn_exp2f(-1.4426950408889634f * ai[j]));
                        const float a = __builtin_amdgcn_exp2f(r * spv[nt][j]);
                        av[j] = a; uv[j] = __builtin_amdgcn_sqrtf(fmaf(-a, a, 1.0f)) * (ig * xv[j]); }
                    *(LAS f32x4*)(SC + l16 * 68 + nt * 16 + quad * 4) = av; *(LAS f32x4*)(SC + 1088 + l16 * 68 + nt * 16 + quad * 4) = uv; }
                LDS_WAIT(); asm volatile("" ::: "memory");
#pragma unroll 4
                for (int s = 0; s < 16; ++s) { const int tt = d ? 15 - s : s; const float a = SC[tt * 68 + lane], u = SC[1088 + tt * 68 + lane];
                    h = a * h + u; ap *= a; const size_t o = ((size_t)ci.row0 + mt * 16 + tt) * 256 + n * 64 + lane; HA[o] = pk2(h, ap); }
                LDS_WAIT(); asm volatile("" ::: "memory");
            }
            f32x2v* agg = (f32x2v*)(ws + WS_AGG); agg[((size_t)((d * NBATCH + ci.b) * NCHK + ci.cpos)) * 256 + n * 64 + lane] = (f32x2v){ap, h};
        }
        __syncthreads();
    }
}
__device__ __forceinline__ void fixup_chunk(const Params& p, int c, LAS unsigned char* lds, int tid) {
    asm volatile("" : "+v"(tid));
    const ChunkInfo ci = chunk_info(c);
    unsigned char* ws = kws();
    LAS float* CR = (LAS float*)lds;
    {   const int d = tid >> 8, ch = tid & 255;
        const f32x2v* agg = (const f32x2v*)(ws + WS_AGG) + ((size_t)((d * NBATCH + ci.b) * NCHK)) * 256 + ch;
        float s = 0.f;
        const int n = (d == 0) ? ci.cpos : (ci.isctx ? 3 - ci.cpos : 71 - ci.cpos);
        for (int k0 = 0; k0 < n; k0 += 24) {
            f32x2v ah[24];
#pragma unroll
            for (int j = 0; j < 24; ++j) { const int k = k0 + j; const int i = (d == 0) ? k : (k < 4 ? 3 - k : 71 - k);
                ah[j] = (k < n) ? agg[(size_t)i * 256] : (f32x2v){1.0f, 0.0f}; }
#pragma unroll
            for (int j = 0; j < 24; ++j) s = ah[j].x * s + ah[j].y;
        }
        CR[tid] = s;
    }
    __syncthreads();
    {   const unsigned* HAF = (const unsigned*)((unsigned char*)kout() + WS_LRU); const unsigned* HAB = (const unsigned*)((unsigned char*)kout() + WS_LRU + LRU_PLANE);
        bf16* Y = (bf16*)(ws + WS_Y);
        const int c4 = tid & 63; const f32x4 cf = *(const LAS f32x4*)(CR + 4 * c4), cb = *(const LAS f32x4*)(CR + 256 + 4 * c4);
#pragma unroll 2
        for (int it = 0; it < 8; ++it) { const int tok = it * 8 + (tid >> 6); const size_t row = (size_t)ci.row0 + tok; const size_t o = row * 256 + 4 * c4;
            const v4u fw = __builtin_nontemporal_load((const GAS v4u*)(HAF + o)), bw = __builtin_nontemporal_load((const GAS v4u*)(HAB + o));
            const f32x4 hf = {bflo(fw.x), bflo(fw.y), bflo(fw.z), bflo(fw.w)}, af = {bfhi(fw.x), bfhi(fw.y), bfhi(fw.z), bfhi(fw.w)};
            const f32x4 hb = {bflo(bw.x), bflo(bw.y), bflo(bw.z), bflo(bw.w)}, ab = {bfhi(bw.x), bfhi(bw.y), bfhi(bw.z), bfhi(bw.w)};
            const v2u gw_ = __builtin_nontemporal_load((const GAS v2u*)((const bf16*)(ws + WS_P) + row * INW + 1024 + 4 * c4));
            const f32x4 hs = (hf + af * cf) + (hb + ab * cb);
            v2u w; w.x = pk2(gelu_tanh_f(bflo(gw_.x)) * hs.x, gelu_tanh_f(bfhi(gw_.x)) * hs.y); w.y = pk2(gelu_tanh_f(bflo(gw_.y)) * hs.z, gelu_tanh_f(bfhi(gw_.y)) * hs.w);
            *(GAS v2u*)(Y + row * DM + 512 + 4 * c4) = w; }
    }
    __syncthreads();
}
#ifndef ATTN_OUT
#define ATTN_OUT(Qu, k) (Qu)
#endif
__global__ void __launch_bounds__(NTHR, 2) hybrid_fwd(Params p) {
    extern __shared__ __attribute__((aligned(16))) unsigned char lds_raw[];
    cg::grid_group grid = cg::this_grid();
    LAS unsigned char* lds = (LAS unsigned char*)lds_raw;
    const int wave = __builtin_amdgcn_readfirstlane((int)threadIdx.x >> 6);
#define lane hw_lane()
#define tid (wave * 64 + lane)
    const int G = gridDim.x; const int bx = blockIdx.x; const int vcu = (G % 8 == 0) ? (bx % 8) * (G / 8) + bx / 8 : bx;
    const int gw = vcu * NWAVES + wave, NGW = G * NWAVES;
    unsigned char* ws = kws();
    bf16* XN = (bf16*)(ws + WS_XN); float* YO = kout();     float* XRC = (float*)(ws + WS_XRC);
    const float* MOD = (const float*)(ws + WS_MOD);
    unsigned* ctl = (unsigned*)(ws + WS_CTL);

    if (tid < 16) ((LAS unsigned*)(lds + MISC_OFF))[tid] = 0u;
    __syncthreads();
    (void)xcd_barrier_post((unsigned*)(kws() + WS_CTL) + CW_BAR, (volatile LAS unsigned*)(lds + MISC_OFF), wave == 0 && lane == 0);
#define GRID_BAR() do { XcdBarrier b_; b_.bar = (unsigned*)(kws() + WS_CTL) + CW_BAR; b_.x = xb_xcc_id(); b_.st = (volatile LAS unsigned*)(lds + MISC_OFF); xcd_barrier(b_, wave == 0 && lane == 0); } while (0)
    if (__builtin_expect(gridDim.x > 1000000u, 0)) grid.sync();
    phase0a(p, lds, tid, lane, wave, vcu, G);
    GRID_BAR();
    xn0_slot_phase(lds, tid, wave, vcu);
    phase0b(p, tid);
    GRID_BAR();
#pragma unroll 1
    for (int layer = 0; layer < NLAYER; ++layer) {
        const bool last = (layer == NLAYER - 1);
        unsigned char* wl = ws + WS_WT + (size_t)layer * WT_LAYER;
        const float* MODL = MOD + layer * 30720;
        const int Mrows = last ? RLAT : RT;
        {   pg8::Gemm g{XN, (const bf16*)(wl + WIN_OFF), RT, INW, DM, DM}; pg8::StaticOrder S; S.init(RT, INW, G, bx);
            pg8::EpiBf16 E{(bf16*)(ws + WS_P), INW};
            pg8::gemm_phase<pg8::EpiBf16, pg8::StaticOrder, true, true>(lds, g, S, E, tid); }
        GRID_BAR();
        for (int it = vcu; it < RLAT / 64 + 3 * (RCTX / 64); it += G) {
            const int j = it - RLAT / 64; const int c = j < 0 ? it : RLAT / 64 + j / 3; const int sm = j < 0 ? 7 : (1 << (j % 3));
            mixprep_chunk(p, layer, c, sm, lds, tid, lane, wave); }
        GRID_BAR();
        {   const bf16* Y = (const bf16*)(ws + WS_Y); const bf16* KB = (const bf16*)(ws + WS_KB); const bf16* VB = (const bf16*)(ws + WS_VB);
#pragma unroll 1
            for (int k = 0; k < 3; ++k) {
                size_t qrow; int b, hq, nt;
                if (k < 2) { const int u = (vcu >> 5) * 64 + (vcu & 31) + 32 * k; const int bk = u >> 6, idx = u & 63; b = bk >> 1; hq = (bk & 1) * 4 + (idx >> 4); qrow = (size_t)b * SEQ + (idx & 15) * 256; nt = NCHK; }
                else { if (last || vcu < 32 || vcu >= 64) break; const int u = vcu - 32; b = u >> 3; hq = u & 7; qrow = (size_t)RLAT + b * CTXL; nt = 4; }
                const bf16* Qu = (const bf16*)(ws + WS_P) + qrow * INW + hq * 64; const bf16* Ou = Y + qrow * DM + hq * 64; const size_t kvo = (size_t)b * KVLEN * 128 + (hq >> 2) * 64;
                attn_body::attn_unit<8>((const attn_body::bf16*)Qu, (const attn_body::bf16*)(KB + kvo), (const attn_body::bf16*)(VB + kvo), (attn_body::bf16*)ATTN_OUT(Ou, k), nt, (char*)lds_raw,
                                        kin(I_QNG) + layer * 64, k < 2 ? (const float*)(ws + WS_ROPE) : nullptr, (int)(qrow & (SEQ - 1)), tid);
            }
            const int nfix = last ? RLAT / 64 : NCHUNK;
            for (int c = vcu; c < nfix; c += G) fixup_chunk(p, c, lds, tid);
        }
        GRID_BAR();
        {   pg8::Gemm g{(const bf16*)(ws + WS_Y), (const bf16*)(wl + WOUT_OFF), RLAT, DM, DM, DM}; pg8::StaticOrder S; S.init(RLAT, DM, G, bx);
            pg8::PanelSumSq st1{(float*)(ws + WS_XB + (size_t)(layer * 4 + 0) * XB_BANK), ctl + CW_SEAM + (layer * 4 + 0) * SEAM_BANK, ctl + CW_TMO};
            pg8::PanelSumSq st2{(float*)(ws + WS_XB + (size_t)(layer * 4 + 1) * XB_BANK), ctl + CW_SEAM + (layer * 4 + 1) * SEAM_BANK, ctl + CW_TMO};
            if (layer == 0) { pg8::EpiRmsRes<true, false, true> E{kin(I_X), ws + WS_RES, XN, MODL + 2 * 1024, MODL + 4 * 1024, MODL + 3 * 1024, st1, st2};
                pg8::gemm_phase<pg8::EpiRmsRes<true, false, true>, pg8::StaticOrder, false, true>(lds, g, S, E, tid); }
            else { pg8::EpiRmsRes<true, true, true> E{ws + WS_RES, ws + WS_RES, XN, MODL + 2 * 1024, MODL + 4 * 1024, MODL + 3 * 1024, st1, st2};
                pg8::gemm_phase<pg8::EpiRmsRes<true, true, true>, pg8::StaticOrder, false, true>(lds, g, S, E, tid); } }
        if (!last) {
            __syncthreads();
            {   pg8::Gemm g{(const bf16*)(ws + WS_Y) + (size_t)RLAT * DM, (const bf16*)(wl + WOUT_OFF), RCTX, DM, 256, DM}; pg8::SplitKOrder S; S.init(RCTX, DM, 4, 256, G, bx);
                pg8::EpiF32Slab E{YO, DM, (size_t)RCTX * DM};
                pg8::gemm_phase<pg8::EpiF32Slab, pg8::SplitKOrder, true, true>(lds, g, S, E, tid); }
            GRID_BAR();
            ctx_norm(YO, 4, kin(I_CTX), XRC, MODL + 4 * 6144 + 2 * 1024, MODL + 4 * 6144 + 4 * 1024, MODL + 4 * 6144 + 3 * 1024, XN + (size_t)RLAT * DM, gw, NGW, lane);
        }
        GRID_BAR();
        {   pg8::Gemm g{XN, (const bf16*)(wl + WFI_OFF), Mrows, 2 * FFH, DM, DM}; pg8::StaticOrder S; S.init(Mrows, 2 * FFH, G, bx);
            pg8::EpiSwiglu E{(bf16*)(ws + WS_H), FFH};
            pg8::gemm_phase<pg8::EpiSwiglu, pg8::StaticOrder, true, true>(lds, g, S, E, tid); }
        GRID_BAR();
        if (!last) {
            {   pg8::Gemm g{(const bf16*)(ws + WS_H), (const bf16*)(wl + WFO_OFF), RLAT, DM, FFH, FFH}; pg8::StaticOrder S; S.init(RLAT, DM, G, bx);
                pg8::PanelSumSq st1{(float*)(ws + WS_XB + (size_t)(layer * 4 + 2) * XB_BANK), ctl + CW_SEAM + (layer * 4 + 2) * SEAM_BANK, ctl + CW_TMO};
                pg8::PanelSumSq st2{(float*)(ws + WS_XB + (size_t)(layer * 4 + 3) * XB_BANK), ctl + CW_SEAM + (layer * 4 + 3) * SEAM_BANK, ctl + CW_TMO};
                pg8::EpiRmsRes<true, true, true> E{ws + WS_RES, ws + WS_RES, XN, MODL + 5 * 1024, MOD + 30720 + 1 * 1024, MOD + 30720 + 0 * 1024, st1, st2};
                pg8::gemm_phase<pg8::EpiRmsRes<true, true, true>, pg8::StaticOrder, false, true>(lds, g, S, E, tid); }
            __syncthreads();
            {   pg8::Gemm g{(const bf16*)(ws + WS_H) + (size_t)RLAT * FFH, (const bf16*)(wl + WFO_OFF), RCTX, DM, 256, FFH}; pg8::SplitKOrder S; S.init(RCTX, DM, 11, 256, G, bx);
                pg8::EpiF32Slab E{YO, DM, (size_t)RCTX * DM};
                pg8::gemm_phase<pg8::EpiF32Slab, pg8::SplitKOrder, true, true>(lds, g, S, E, tid); }
            GRID_BAR();
            ctx_norm(YO, 11, XRC, XRC, MODL + 4 * 6144 + 5 * 1024, MOD + 30720 + 4 * 6144 + 1 * 1024, MOD + 30720 + 4 * 6144 + 0 * 1024, XN + (size_t)RLAT * DM, gw, NGW, lane);
            GRID_BAR();
        } else {
            pg8::Gemm g{(const bf16*)(ws + WS_H), (const bf16*)(wl + WFO_OFF), RLAT, DM, FFH, FFH}; pg8::StaticOrder S; S.init(RLAT, DM, G, bx);
            pg8::PanelSumSq st1{(float*)(ws + WS_XB + (size_t)(layer * 4 + 2) * XB_BANK), ctl + CW_SEAM + (layer * 4 + 2) * SEAM_BANK, ctl + CW_TMO};
            pg8::EpiRmsRes<false, true, false> E{ws + WS_RES, kout(), XN, MODL + 5 * 1024, nullptr, nullptr, st1, st1};
            pg8::gemm_phase<pg8::EpiRmsRes<false, true, false>, pg8::StaticOrder, false, true>(lds, g, S, E, tid);
        }
    }
}

#undef tid
#undef lane
extern "C" void kernel_launch(void* const* d_in, const int* in_sizes, int n_in, void* d_out, int out_size, void* d_ws, size_t ws_size, hipStream_t stream) {
    static int grid = 0;
    if (grid == 0) {
        if (n_in != 21 || out_size != RLAT * DM || ws_size < WS_END) { fprintf(stderr, "kernel_launch: unexpected shapes (n_in %d out %d ws %zu)\n", n_in, out_size, ws_size); grid = -1; return; }
        int dev = 0, cus = 0, per_cu = 0;
        hipGetDevice(&dev); hipDeviceGetAttribute(&cus, hipDeviceAttributeMultiprocessorCount, dev);
        hipFuncSetAttribute((const void*)hybrid_fwd, hipFuncAttributeMaxDynamicSharedMemorySize, LDS_BYTES);
        hipOccupancyMaxActiveBlocksPerMultiprocessor(&per_cu, (const void*)hybrid_fwd, NTHR, LDS_BYTES);
        (void)hipGetLastError();
        if (per_cu < 1) { fprintf(stderr, "kernel_launch: occupancy query says %d blocks per CU\n", per_cu); per_cu = 1; }
        grid = cus;
        if (grid != 256) { fprintf(stderr, "kernel_launch: built for a 256-CU device (got %d)\n", cus); grid = -1; return; }
    }
    if (grid < 0) return;
    if (hipMemsetAsync((char*)d_ws + WS_CTL, 0, 262144, stream) != hipSuccess) { fprintf(stderr, "kernel_launch: memset failed\n"); return; }
    Params p{};
    for (int i = 0; i < 21; ++i) p.in[i] = (const float*)d_in[i];
    p.out = (float*)d_out; p.ws = (unsigned char*)d_ws;
    void* args[] = {&p};
    hipError_t e = hipLaunchCooperativeKernel((const void*)hybrid_fwd, dim3(grid), dim3(NTHR), args, LDS_BYTES, stream);
    if (e != hipSuccess) fprintf(stderr, "cooperative launch failed: %s (grid %d)\n", hipGetErrorString(e), grid);
}
```

```cpp
#include <hip/hip_runtime.h>
#include <hip/hip_cooperative_groups.h>
#include <hip/hip_bf16.h>
#include <cstdio>
#include <cstdint>
#include <cmath>
namespace cg = cooperative_groups;
__device__ __forceinline__ float shx(float v, int mask, int lane_) { return __int_as_float(__builtin_amdgcn_ds_bpermute((lane_ ^ mask) << 2, __float_as_int(v))); }
__device__ __forceinline__ int hw_lane() { int l; asm volatile("v_mbcnt_lo_u32_b32 %0, -1, 0\n\tv_mbcnt_hi_u32_b32 %0, -1, %0" : "=v"(l)); return l; }
namespace pg8 {
#define PG8_LAS __attribute__((address_space(3)))
typedef unsigned short bf16_t;
typedef short bf16x8 __attribute__((ext_vector_type(8)));
typedef float f32x4 __attribute__((ext_vector_type(4)));
typedef unsigned u32x4 __attribute__((ext_vector_type(4)));
typedef unsigned u32x2 __attribute__((ext_vector_type(2)));
constexpr int BM = 256, BK = 64, HALF = 128, HTB = HALF * BK * 2  , STAGE_BYTES = 8 * HTB, NXCD = 8, WGM = 8;

__host__ __device__ __forceinline__ int lds_byte(int r, int c) { const int st = (r >> 4) * 2 + (c >> 5), rr = r & 15, cc = c & 31, ob = rr * 64 + cc * 2; return st * 1024 + (ob ^ (((ob >> 9) & 1) << 5)); }
__host__ __device__ __forceinline__ void stage_rc(int b, int& R, int& C) { const int st = b / 1024, sb = b % 1024, swz = sb ^ (((sb >> 9) & 1) << 5); R = (st >> 1) * 16 + swz / 64; C = (st & 1) * 32 + (swz % 64) / 2; }
__host__ __device__ __forceinline__ int perm32(int rho) { const int n = rho >> 4, i = rho & 15; return 8 * (i >> 2) + 4 * n + (i & 3); }

struct Unit { int pm, pn, kb, ks; };
struct Gemm { const bf16_t* A; const bf16_t* Bt; int M, N, K, ld; };

struct StaticOrder {
    int nM, nN, nwg, G, c;
    __host__ __device__ void init(int M, int N, int G_, int c_) { nM = M / BM; nN = N / BM; nwg = nM * nN; G = G_; c = c_; }
    __host__ __device__ bool next(int i, Unit& u) const {
        const long L = (long)i * G + c; if (L >= nwg) return false;
        int wgid = (int)L; { const int q = nwg / NXCD, r = nwg % NXCD, xcd = wgid % NXCD, off = wgid / NXCD; wgid = (xcd < r ? xcd * (q + 1) : r * (q + 1) + (xcd - r) * q) + off; }
        const int nig = WGM * nN, gid = wgid / nig, fm = gid * WGM, gsz = (nM - fm) < WGM ? (nM - fm) : WGM;
        u.pm = fm + ((wgid % nig) % gsz); u.pn = (wgid % nig) / gsz; u.kb = 0; u.ks = 0; return true;
    }
    __device__ __forceinline__ void a_ready(const Unit&) const {}
    __device__ __forceinline__ void done(const Unit&) const {}
};

__device__ __forceinline__ unsigned cvt_pk_bf16(float lo, float hi) { unsigned r; asm volatile("v_cvt_pk_bf16_f32 %0, %1, %2" : "=v"(r) : "v"(lo), "v"(hi)); return r; }
typedef float f32x2 __attribute__((ext_vector_type(2)));
struct EpiBf16 {
    static constexpr bool PERM = true, AFTER_DRAIN = false;
    bf16_t* O; int ldc;
    __device__ __forceinline__ void operator()(const f32x4 (&acc)[2][2][4][2], const Unit& u, int wr, int wc, int fr, int fq) const {
        const int row0 = u.pm * BM + wr * 64 + fr; const int col0 = u.pn * BM + wc * 32 + 8 * fq;
#pragma unroll
        for (int ai = 0; ai < 2; ++ai)
#pragma unroll
            for (int m = 0; m < 4; ++m) { bf16_t* rowp = O + (size_t)(row0 + ai * HALF + m * 16) * ldc + col0;
#pragma unroll
                for (int bj = 0; bj < 2; ++bj) { const f32x4 v0 = acc[ai][bj][m][0], v1 = acc[ai][bj][m][1];
                    u32x4 w; w.x = cvt_pk_bf16(v0[0], v0[1]); w.y = cvt_pk_bf16(v0[2], v0[3]); w.z = cvt_pk_bf16(v1[0], v1[1]); w.w = cvt_pk_bf16(v1[2], v1[3]);
                    *(u32x4*)(rowp + bj * HALF) = w; } }
    }
};
__device__ __forceinline__ float silu_f(float g) { return g * __builtin_amdgcn_rcpf(1.0f + __expf(-g)); }
struct EpiSwiglu {
    static constexpr bool PERM = true, AFTER_DRAIN = false;
    bf16_t* H; int ldh;
    __device__ __forceinline__ void operator()(const f32x4 (&acc)[2][2][4][2], const Unit& u, int wr, int wc, int fr, int fq) const {
        const int row0 = u.pm * BM + wr * 64 + fr; const int col0 = u.pn * HALF + wc * 32 + 8 * fq;
#pragma unroll
        for (int ai = 0; ai < 2; ++ai)
#pragma unroll
            for (int m = 0; m < 4; ++m) { bf16_t* rowp = H + (size_t)(row0 + ai * HALF + m * 16) * ldh + col0;
                const f32x4 g0 = acc[ai][0][m][0], g1 = acc[ai][0][m][1], u0 = acc[ai][1][m][0], u1 = acc[ai][1][m][1];
                u32x4 w;
                w.x = cvt_pk_bf16(silu_f(g0[0]) * u0[0], silu_f(g0[1]) * u0[1]); w.y = cvt_pk_bf16(silu_f(g0[2]) * u0[2], silu_f(g0[3]) * u0[3]);
                w.z = cvt_pk_bf16(silu_f(g1[0]) * u1[0], silu_f(g1[1]) * u1[1]); w.w = cvt_pk_bf16(silu_f(g1[2]) * u1[2], silu_f(g1[3]) * u1[3]);
                *(u32x4*)rowp = w; }
    }
};
struct EpiF32 {
    static constexpr bool PERM = false, AFTER_DRAIN = false;
    float* O; int ldc;
    __device__ __forceinline__ void operator()(const f32x4 (&acc)[2][2][4][2], const Unit& u, int wr, int wc, int fr, int fq) const {
        const int row0 = u.pm * BM + wr * 64 + fr; const int col0 = u.pn * BM + wc * 32 + 4 * fq;
#pragma unroll
        for (int ai = 0; ai < 2; ++ai)
#pragma unroll
            for (int m = 0; m < 4; ++m) { float* rowp = O + (size_t)(row0 + ai * HALF + m * 16) * ldc + col0;
#pragma unroll
                for (int bj = 0; bj < 2; ++bj)
#pragma unroll
                    for (int n = 0; n < 2; ++n) *(f32x4*)(rowp + bj * HALF + n * 16) = acc[ai][bj][m][n]; }
    }
};
struct SplitKOrder {
    int nM, nN, KS, kbytes, G, c;
    __device__ void init(int M, int N, int KS_, int kslice, int G_, int c_) { nM = M / BM; nN = N / BM; KS = KS_; kbytes = kslice * 2; G = G_; c = c_; }
    __device__ bool next(int i, Unit& u) const { const int L = i * G + c; if (L >= nM * nN * KS) return false; const int ks = L % KS, t = L / KS; u.pm = t % nM; u.pn = t / nM; u.ks = ks; u.kb = ks * kbytes; return true; }
    __device__ __forceinline__ void a_ready(const Unit&) const {}
    __device__ __forceinline__ void done(const Unit&) const {}
};
struct EpiF32Slab {
    static constexpr bool PERM = true, AFTER_DRAIN = false;
    float* O; int ldc; size_t slab;
    __device__ __forceinline__ void operator()(const f32x4 (&acc)[2][2][4][2], const Unit& u, int wr, int wc, int fr, int fq) const {
        const int row0 = u.pm * BM + wr * 64 + fr; const int col0 = u.pn * BM + wc * 32 + 8 * fq; float* Os = O + (size_t)u.ks * slab;
#pragma unroll
        for (int ai = 0; ai < 2; ++ai)
#pragma unroll
            for (int m = 0; m < 4; ++m) { float* rowp = Os + (size_t)(row0 + ai * HALF + m * 16) * ldc + col0;
#pragma unroll
                for (int bj = 0; bj < 2; ++bj)
#pragma unroll
                    for (int n = 0; n < 2; ++n) *(f32x4*)(rowp + bj * HALF + n * 4) = acc[ai][bj][m][n]; }
    }
};
struct PanelSumSq {
    float* xbuf;
    unsigned* cnt;
    unsigned* tmo;
    __device__ __forceinline__ void run(const f32x4 (&v)[2][2][4][2], int pmg, int pn, int wr, int wc, int fr, int fq, PG8_LAS unsigned char* lds, int wid, int lane) const { publish(v, pmg, pn, wr, wc, fr, fq, lds, wid, lane); finish(pmg, lds, wid, lane); }
    __device__ __forceinline__ void publish(const f32x4 (&v)[2][2][4][2], int pmg, int pn, int wr, int wc, int fr, int fq, PG8_LAS unsigned char* lds, int wid, int lane) const {
        PG8_LAS float* P = (PG8_LAS float*)lds;
        PG8_LAS float* S = (PG8_LAS float*)(lds + 8192);
#pragma unroll
        for (int ai = 0; ai < 2; ++ai)
#pragma unroll
            for (int m = 0; m < 4; ++m) {
                float q = 0.f;
#pragma unroll
                for (int bj = 0; bj < 2; ++bj)
#pragma unroll
                    for (int n = 0; n < 2; ++n) { const f32x4 x = v[ai][bj][m][n]; q += (x[0] * x[0] + x[1] * x[1]) + (x[2] * x[2] + x[3] * x[3]); }
                q += shx(q, 16, lane); q += shx(q, 32, lane);
                if (fq == 0) P[(ai * HALF + wr * 64 + m * 16 + fr) * 4 + wc] = q;
            }
        asm volatile("s_waitcnt lgkmcnt(0)" ::: "memory"); __builtin_amdgcn_s_barrier(); asm volatile("" ::: "memory");
        const int row = wid * 32 + (lane & 31);
        if (lane < 32) {
            const float t = (P[row * 4 + 0] + P[row * 4 + 1]) + (P[row * 4 + 2] + P[row * 4 + 3]);
            __hip_atomic_store((unsigned*)xbuf + ((size_t)(pmg * BM + row) * 4 + pn), __float_as_uint(t), __ATOMIC_RELAXED, __HIP_MEMORY_SCOPE_AGENT);
        }
        asm volatile("s_waitcnt vmcnt(0)" ::: "memory");
        if (lane == 0) __hip_atomic_fetch_add(cnt + 64 * pmg, 1u, __ATOMIC_RELAXED, __HIP_MEMORY_SCOPE_AGENT);
    }
    __device__ __forceinline__ void finish(int pmg, PG8_LAS unsigned char* lds, int wid, int lane) const {
        PG8_LAS float* S = (PG8_LAS float*)(lds + 8192);
        const int row = wid * 32 + (lane & 31);
        {   unsigned sp = 0u;
            while ((unsigned)__builtin_amdgcn_readfirstlane(__hip_atomic_load(cnt + 64 * pmg, __ATOMIC_RELAXED, __HIP_MEMORY_SCOPE_AGENT)) < 32u) {
                __builtin_amdgcn_s_sleep(1);
                if (++sp > (1u << 18)) { if (lane == 0) __hip_atomic_store(tmo, 1u, __ATOMIC_RELAXED, __HIP_MEMORY_SCOPE_AGENT); break; }
            }
        }
        if (lane < 32) {
            const unsigned* slot = (const unsigned*)xbuf + (size_t)(pmg * BM + row) * 4; float tot = 0.f;
#pragma unroll
            for (int t = 0; t < 4; ++t) tot += __uint_as_float(__hip_atomic_load(slot + t, __ATOMIC_RELAXED, __HIP_MEMORY_SCOPE_AGENT));
            S[row] = rsqrtf(tot * (1.0f / 1024.0f) + 1e-6f);
        }
        asm volatile("s_waitcnt vmcnt(0) lgkmcnt(0)" ::: "memory"); __builtin_amdgcn_s_barrier(); asm volatile("" ::: "memory");
    }
};
template <bool NEXT, bool BASE16, bool OUT16> struct EpiRmsRes {
    static constexpr bool PERM = true, AFTER_DRAIN = true;
    const void* base_p; void* out_p; bf16_t* xn;
    const float* vG; const float* vA; const float* vS;
    PanelSumSq st1, st2;
    static __device__ __forceinline__ f32x4 up4(u32x2 w) { return (f32x4){__uint_as_float(w.x << 16), __uint_as_float(w.x & 0xffff0000u), __uint_as_float(w.y << 16), __uint_as_float(w.y & 0xffff0000u)}; }
    __device__ __forceinline__ void store_out(void* rowp, int coff, const f32x4 x) const {
        if (OUT16) { u32x2 w; w.x = cvt_pk_bf16(x[0], x[1]); w.y = cvt_pk_bf16(x[2], x[3]); *(u32x2*)((bf16_t*)rowp + coff) = w; }
        else *(f32x4*)((float*)rowp + coff) = x; }
    __device__ __forceinline__ void fused(f32x4 (&acc)[2][2][4][2], const Unit& u, int wr, int wc, int fr, int fq, PG8_LAS unsigned char* lds, int wid, int lane) const {
        const PG8_LAS float* S = (const PG8_LAS float*)(lds + 8192);
        const int pmg = u.pm, slot = pmg >> 4;
        const size_t poff = (size_t)pmg * BM * 1024;
        const int col0 = u.pn * BM + wc * 32 + 8 * fq;
        const size_t lane_off = (size_t)(wr * 64 + fr) * 1024 + col0;
        st1.publish(acc, pmg, u.pn, wr, wc, fr, fq, lds, wid, lane);
        f32x4 pre[4][2][2]; u32x2 pb[2][4][2][2];
        if (BASE16) {
            const bf16_t* b16 = (const bf16_t*)base_p + poff + lane_off;
#pragma unroll
            for (int ai = 0; ai < 2; ++ai)
#pragma unroll
                for (int m = 0; m < 4; ++m)
#pragma unroll
                    for (int bj = 0; bj < 2; ++bj)
#pragma unroll
                        for (int n = 0; n < 2; ++n) pb[ai][m][bj][n] = *(const u32x2*)(b16 + (size_t)(ai * HALF + m * 16) * 1024 + bj * HALF + n * 4);
        } else {
            const float* b32 = (const float*)base_p + poff + lane_off;
#pragma unroll
            for (int m = 0; m < 4; ++m)
#pragma unroll
                for (int bj = 0; bj < 2; ++bj)
#pragma unroll
                    for (int n = 0; n < 2; ++n) pre[m][bj][n] = __builtin_nontemporal_load((const f32x4*)(b32 + (size_t)(m * 16) * 1024 + bj * HALF + n * 4));
        }
        f32x4 g[2][2];
#pragma unroll
        for (int bj = 0; bj < 2; ++bj)
#pragma unroll
            for (int n = 0; n < 2; ++n) g[bj][n] = *(const f32x4*)(vG + slot * 6144 + col0 + bj * HALF + n * 4);
        st1.finish(pmg, lds, wid, lane);
#pragma unroll
        for (int ai = 0; ai < 2; ++ai)
#pragma unroll
            for (int m = 0; m < 4; ++m) { const float rs = S[ai * HALF + wr * 64 + m * 16 + fr];
#pragma unroll
                for (int bj = 0; bj < 2; ++bj)
#pragma unroll
                    for (int n = 0; n < 2; ++n) { f32x4 bs;
                        if (BASE16) bs = up4(pb[ai][m][bj][n]);
                        else bs = ai == 0 ? pre[m][bj][n] : __builtin_nontemporal_load((const f32x4*)((const float*)base_p + poff + lane_off + (size_t)(HALF + m * 16) * 1024 + bj * HALF + n * 4));
                        acc[ai][bj][m][n] = bs + g[bj][n] * acc[ai][bj][m][n] * rs; }
                asm volatile("" : "+v"(acc[ai][0][m][0]), "+v"(acc[ai][0][m][1]), "+v"(acc[ai][1][m][0]), "+v"(acc[ai][1][m][1]));
                if (m & 1) asm volatile("" ::: "memory"); }
        unsigned char* const outl = (unsigned char*)out_p + (poff + lane_off) * (OUT16 ? 2 : 4);
        if (NEXT) {
            f32x4 a[2][2], sh[2][2];
#pragma unroll
            for (int bj = 0; bj < 2; ++bj)
#pragma unroll
                for (int n = 0; n < 2; ++n) { a[bj][n] = *(const f32x4*)(vA + slot * 6144 + col0 + bj * HALF + n * 4); sh[bj][n] = *(const f32x4*)(vS + slot * 6144 + col0 + bj * HALF + n * 4); }
            st2.publish(acc, pmg, u.pn, wr, wc, fr, fq, lds, wid, lane);
#pragma unroll
            for (int ai = 0; ai < 2; ++ai)
#pragma unroll
                for (int m = 0; m < 4; ++m) { void* op = outl + (size_t)(ai * HALF + m * 16) * 1024 * (OUT16 ? 2 : 4);
#pragma unroll
                    for (int bj = 0; bj < 2; ++bj)
#pragma unroll
                        for (int n = 0; n < 2; ++n) store_out(op, bj * HALF + n * 4, acc[ai][bj][m][n]);
                    asm volatile("" ::: "memory"); }
            st2.finish(pmg, lds, wid, lane);
            bf16_t* xnl = xn + poff + lane_off;
#pragma unroll
            for (int ai = 0; ai < 2; ++ai)
#pragma unroll
                for (int m = 0; m < 4; ++m) { const float rs = S[ai * HALF + wr * 64 + m * 16 + fr]; bf16_t* xp = xnl + (size_t)(ai * HALF + m * 16) * 1024;
#pragma unroll
                    for (int bj = 0; bj < 2; ++bj)
#pragma unroll
                        for (int n = 0; n < 2; ++n) { const f32x4 x1 = acc[ai][bj][m][n]; const f32x4 o = x1 * rs * a[bj][n] + sh[bj][n];
                            u32x2 w; w.x = cvt_pk_bf16(o[0], o[1]); w.y = cvt_pk_bf16(o[2], o[3]); *(u32x2*)(xp + bj * HALF + n * 4) = w; }
                    asm volatile("" ::: "memory"); }
        } else {
#pragma unroll
            for (int ai = 0; ai < 2; ++ai)
#pragma unroll
                for (int m = 0; m < 4; ++m) { void* op = outl + (size_t)(ai * HALF + m * 16) * 1024 * (OUT16 ? 2 : 4);
#pragma unroll
                    for (int bj = 0; bj < 2; ++bj)
#pragma unroll
                        for (int n = 0; n < 2; ++n) store_out(op, bj * HALF + n * 4, acc[ai][bj][m][n]);
                    asm volatile("" ::: "memory"); }
        }
    }
};
template <class Epi, class Sched, bool ALIGN_EPI = false, bool SP2 = false>
__device__ __forceinline__ void gemm_phase(PG8_LAS unsigned char* lds, const Gemm g, const Sched& S, const Epi& E, int tid_) {
    asm volatile("" : "+v"(tid_));
    const int tid = tid_, wid = __builtin_amdgcn_readfirstlane(tid >> 6), lane = tid & 63, wr = wid >> 2, wc = wid & 3, fr = lane & 15, fq = lane >> 4;
    const int K = g.ld, nt = g.K / BK;
    unsigned voffA[2], voffB[2];
#pragma unroll
    for (int i = 0; i < 2; ++i) { int R, C; stage_rc(tid * 16 + i * 8192, R, C); const int Rb = Epi::PERM ? ((R & ~31) + perm32(R & 31)) : R;
        voffA[i] = (unsigned)(R * K + C) * 2u; voffB[i] = (unsigned)(Rb * K + C) * 2u; }
    const size_t kstep = (size_t)(BK * 2);
    const size_t hstep = (size_t)HALF * K * 2;
    const size_t tstep = 2 * hstep;
    const unsigned ldsw = (unsigned)wid * 1024u;
    const int aoff = lds_byte(wr * 64 + fr, fq * 8), boff = lds_byte(wc * 32 + fr, fq * 8);
#define PG8_SA(b, h) (((b) * 2 + (h)) * HTB)
#define PG8_SB(b, h) ((4 + (b) * 2 + (h)) * HTB)
#define PG8_STAGE(bufoff, gbase, voff) do { _Pragma("unroll") for (int _i = 0; _i < 2; ++_i) \
        __builtin_amdgcn_global_load_lds((const unsigned*)((const char*)(gbase) + (voff)[_i]), (PG8_LAS unsigned*)(lds + (bufoff) + ldsw + _i * 8192), 16, 0, 0); } while (0)
#define PG8_LDA(dst, b, h) do { _Pragma("unroll") for (int m = 0; m < 4; ++m) _Pragma("unroll") for (int k = 0; k < 2; ++k) dst[m][k] = *(const PG8_LAS bf16x8*)(lds + PG8_SA(b, h) + aoff + m * 2048 + k * 1024); } while (0)
#define PG8_LDB(dst, b, h) do { _Pragma("unroll") for (int n = 0; n < 2; ++n) _Pragma("unroll") for (int k = 0; k < 2; ++k) dst[n][k] = *(const PG8_LAS bf16x8*)(lds + PG8_SB(b, h) + boff + n * 2048 + k * 1024); } while (0)
#define PG8_MMA(ai, bj, At, Bt) do { __builtin_amdgcn_s_setprio(1); _Pragma("unroll") for (int m = 0; m < 4; ++m) _Pragma("unroll") for (int n = 0; n < 2; ++n) _Pragma("unroll") for (int k = 0; k < 2; ++k) \
        acc[ai][bj][m][n] = __builtin_amdgcn_mfma_f32_16x16x32_bf16(Bt[n][k], At[m][k], acc[ai][bj][m][n], 0, 0, 0); __builtin_amdgcn_s_setprio(0); } while (0)
#define PG8_WAIT_V(n) asm volatile("s_waitcnt vmcnt(" #n ")" ::: "memory")
#define PG8_WAIT_L(n) asm volatile("s_waitcnt lgkmcnt(" #n ")" ::: "memory")
#define PG8_BAR __builtin_amdgcn_s_barrier()
#define PG8_SCHED __builtin_amdgcn_sched_barrier(0)
    Unit cur, nxt; int ui = 0;
    if (!S.next(0, cur)) return;
    f32x4 acc[2][2][4][2];
#pragma unroll
    for (int a = 0; a < 2; ++a)
#pragma unroll
        for (int b = 0; b < 2; ++b)
#pragma unroll
            for (int m = 0; m < 4; ++m)
#pragma unroll
                for (int n = 0; n < 2; ++n) acc[a][b][m][n] = (f32x4){0.f, 0.f, 0.f, 0.f};
    bf16x8 At[4][2], B0[2][2], B1[2][2];
    const char* cA = (const char*)g.A + (size_t)cur.pm * tstep + cur.kb; const char* cB = (const char*)g.Bt + (size_t)cur.pn * tstep + cur.kb;
    S.a_ready(cur);
    if constexpr (SP2) {
        PG8_STAGE(PG8_SB(0, 0), cB, voffB); PG8_STAGE(PG8_SB(0, 1), cB + hstep, voffB); PG8_STAGE(PG8_SA(0, 0), cA, voffA); PG8_STAGE(PG8_SA(0, 1), cA + hstep, voffA);
        if (wr == 1) PG8_BAR;
        PG8_WAIT_V(2); PG8_BAR;
        PG8_STAGE(PG8_SB(1, 0), cB + kstep, voffB); PG8_STAGE(PG8_SA(1, 0), cA + kstep, voffA); PG8_STAGE(PG8_SB(1, 1), cB + hstep + kstep, voffB);
        PG8_WAIT_V(6); PG8_BAR;
    } else {
        PG8_STAGE(PG8_SB(0, 0), cB, voffB); PG8_STAGE(PG8_SA(0, 0), cA, voffA); PG8_STAGE(PG8_SB(0, 1), cB + hstep, voffB); PG8_STAGE(PG8_SA(0, 1), cA + hstep, voffA);
        if (wr == 1) PG8_BAR;
        PG8_WAIT_V(4); PG8_BAR;
        PG8_STAGE(PG8_SB(1, 0), cB + kstep, voffB); PG8_STAGE(PG8_SA(1, 0), cA + kstep, voffA); PG8_STAGE(PG8_SB(1, 1), cB + hstep + kstep, voffB);
        PG8_WAIT_V(6); PG8_BAR;
    }
    for (;;) {
        const bool has_next = S.next(ui + 1, nxt);
        const char* nA = has_next ? (const char*)g.A + (size_t)nxt.pm * tstep + nxt.kb : cA; const char* nB = has_next ? (const char*)g.Bt + (size_t)nxt.pn * tstep + nxt.kb : cB;
        for (int t = 0; t < nt; t += 2) {
            const bool last = (t == nt - 2);
            const char* a1 = cA + (size_t)(t + 1) * kstep;
            const char* a2 = last ? nA : cA + (size_t)(t + 2) * kstep; const char* b2 = last ? nB : cB + (size_t)(t + 2) * kstep;
            const char* a3 = a2 + kstep; const char* b3 = b2 + kstep;
            if (last && has_next) S.a_ready(nxt);
            if constexpr (SP2) {
            PG8_LDB(B0, 0, 0); PG8_LDB(B1, 0, 1); PG8_SCHED; PG8_LDA(At, 0, 0); PG8_STAGE(PG8_SA(1, 1), a1 + hstep, voffA);
            PG8_WAIT_V(8); PG8_WAIT_L(0); PG8_BAR; PG8_MMA(0, 0, At, B0); PG8_MMA(0, 1, At, B1); PG8_BAR; PG8_SCHED;
            PG8_LDA(At, 0, 1); PG8_STAGE(PG8_SB(0, 0), b2, voffB); PG8_STAGE(PG8_SB(0, 1), b2 + hstep, voffB); PG8_STAGE(PG8_SA(0, 0), a2, voffA);
            PG8_WAIT_V(8); PG8_WAIT_L(0); PG8_BAR; PG8_MMA(1, 0, At, B0); PG8_MMA(1, 1, At, B1); PG8_BAR; PG8_SCHED;
            PG8_LDB(B0, 1, 0); PG8_LDB(B1, 1, 1); PG8_SCHED; PG8_LDA(At, 1, 0); PG8_STAGE(PG8_SA(0, 1), a2 + hstep, voffA);
            PG8_WAIT_V(8); PG8_WAIT_L(0); PG8_BAR; PG8_MMA(0, 0, At, B0); PG8_MMA(0, 1, At, B1); PG8_BAR; PG8_SCHED;
            PG8_LDA(At, 1, 1); PG8_STAGE(PG8_SB(1, 0), b3, voffB); PG8_STAGE(PG8_SB(1, 1), b3 + hstep, voffB); PG8_STAGE(PG8_SA(1, 0), a3, voffA);
            PG8_WAIT_V(8); PG8_WAIT_L(0); PG8_BAR; PG8_MMA(1, 0, At, B0); PG8_MMA(1, 1, At, B1); PG8_BAR; PG8_SCHED;
            } else {
            PG8_LDB(B0, 0, 0); PG8_SCHED; PG8_LDA(At, 0, 0); PG8_STAGE(PG8_SA(1, 1), a1 + hstep, voffA);
            PG8_WAIT_L(8); PG8_BAR; PG8_WAIT_L(0); PG8_MMA(0, 0, At, B0); PG8_BAR; PG8_SCHED;
            PG8_LDB(B1, 0, 1); PG8_STAGE(PG8_SB(0, 0), b2, voffB);
            PG8_BAR; PG8_WAIT_L(0); PG8_MMA(0, 1, At, B1); PG8_BAR;
            PG8_LDA(At, 0, 1); PG8_STAGE(PG8_SA(0, 0), a2, voffA);
            PG8_BAR; PG8_WAIT_L(0); PG8_MMA(1, 0, At, B0); PG8_BAR; PG8_SCHED;
            PG8_STAGE(PG8_SB(0, 1), b2 + hstep, voffB);
            PG8_WAIT_V(6); PG8_BAR; PG8_MMA(1, 1, At, B1); PG8_BAR;
            PG8_LDB(B0, 1, 0); PG8_SCHED; PG8_LDA(At, 1, 0); PG8_STAGE(PG8_SA(0, 1), a2 + hstep, voffA);
            PG8_WAIT_L(8); PG8_BAR; PG8_WAIT_L(0); PG8_MMA(0, 0, At, B0); PG8_BAR; PG8_SCHED;
            PG8_LDB(B1, 1, 1); PG8_STAGE(PG8_SB(1, 0), b3, voffB);
            PG8_BAR; PG8_WAIT_L(0); PG8_MMA(0, 1, At, B1); PG8_BAR;
            PG8_LDA(At, 1, 1); PG8_STAGE(PG8_SA(1, 0), a3, voffA);
            PG8_BAR; PG8_WAIT_L(0); PG8_MMA(1, 0, At, B0); PG8_BAR; PG8_SCHED;
            PG8_STAGE(PG8_SB(1, 1), b3 + hstep, voffB);
            PG8_WAIT_V(6); PG8_BAR; PG8_MMA(1, 1, At, B1); PG8_BAR;
            }
        }
        if constexpr (ALIGN_EPI) { if (wr == 0) PG8_BAR; }
        if constexpr (!Epi::AFTER_DRAIN) { E(acc, cur, wr, wc, fr, fq); S.done(cur); }
        if (!has_next) break;
#pragma unroll
        for (int a = 0; a < 2; ++a)
#pragma unroll
            for (int b = 0; b < 2; ++b)
#pragma unroll
                for (int m = 0; m < 4; ++m)
#pragma unroll
                    for (int n = 0; n < 2; ++n) acc[a][b][m][n] = (f32x4){0.f, 0.f, 0.f, 0.f};
        cur = nxt; cA = nA; cB = nB; ++ui;
        if constexpr (ALIGN_EPI) { if (wr == 1) PG8_BAR; }
    }
    PG8_WAIT_V(0);
    if constexpr (!ALIGN_EPI) { if (wr == 0) PG8_BAR; }
    PG8_BAR;
    if constexpr (Epi::AFTER_DRAIN) { E.fused(acc, cur, wr, wc, fr, fq, lds, wid, lane); S.done(cur); }
#undef PG8_SA
#undef PG8_SB
#undef PG8_STAGE
#undef PG8_LDA
#undef PG8_LDB
#undef PG8_MMA
#undef PG8_WAIT_V
#undef PG8_WAIT_L
#undef PG8_BAR
#undef PG8_SCHED
}
}
#include <hip/hip_bf16.h>
#include <cmath>
namespace attn_body {
using bf16=__hip_bfloat16;
using bf16x8=__attribute__((ext_vector_type(8)))short;
using s16x4=__attribute__((ext_vector_type(4)))short;
using f32x16=__attribute__((ext_vector_type(16)))float;
using u32x4=__attribute__((ext_vector_type(4)))unsigned;
constexpr int D=64,DM=1024,KVP=128,QP=1536;
constexpr int NW=8,QBLK=32,QB=QBLK*NW,KVBLK=64;
constexpr int ATTN_PITCH=DM, ATTN_UNIT_ROWS=QB;
__device__ __forceinline__ int crow(int r,int hi){return (r&3)+8*(r>>2)+4*hi;}
#define SBAR() __builtin_amdgcn_sched_barrier(0)
__device__ __forceinline__ void cmask(f32x16&p0,f32x16&p1,int jb,int qrel,int hi){
  const float NEG=-INFINITY; int kb=64*jb+4*hi;
  #pragma unroll
  for(int r=0;r<16;++r){int kv=kb+(r&3)+8*(r>>2); if(kv>qrel)p0[r]=NEG; if(kv+32>qrel)p1[r]=NEG;}
}

constexpr int NSLOT=3, SLOTB=8192;
constexpr int LDS_K=0, LDS_V=NSLOT*SLOTB, LDS_WS=2*NSLOT*SLOTB, LDS_OST=LDS_WS+NW*64*4, LDS_BYTES=LDS_OST+NW*4096;
constexpr float C2=0.125f*1.4426950408889634f;
__device__ __forceinline__ void glds16(const void*gsrc,unsigned lds_dst){unsigned keep;
  asm volatile("s_mov_b32 %0, m0\n\ts_mov_b32 m0, %2\n\ts_nop 0\n\tglobal_load_lds_dwordx4 %1, off\n\ts_mov_b32 m0, %0":"=&s"(keep):"v"(gsrc),"s"(lds_dst):"memory");}
__device__ __forceinline__ float max3f(float a,float b,float c){float r;asm("v_max3_f32 %0, %1, %2, %3":"=v"(r):"v"(a),"v"(b),"v"(c));return r;}
__device__ __forceinline__ float max2f(float a,float b){float r;asm("v_max_f32_e32 %0, %1, %2":"=v"(r):"v"(a),"v"(b));return r;}
__device__ __forceinline__ float fadd_s(float a,float b){float r;asm("v_add_f32_e32 %0, %1, %2":"=v"(r):"v"(a),"v"(b));return r;}
__device__ __forceinline__ float fsub_s(float a,float b){float r;asm("v_sub_f32_e32 %0, %1, %2":"=v"(r):"v"(a),"v"(b));return r;}
typedef float f32x2_t __attribute__((ext_vector_type(2))); typedef __bf16 bf16x2_t __attribute__((ext_vector_type(2)));
__device__ __forceinline__ unsigned cvtpk_s(float lo,float hi){f32x2_t v={lo,hi};bf16x2_t b=__builtin_convertvector(v,bf16x2_t);return __builtin_bit_cast(unsigned,b);}
#define WAIT_BAR(N) asm volatile("s_waitcnt vmcnt(" #N ") lgkmcnt(0)\n\ts_barrier":::"memory")

__device__ __forceinline__ void qkt(f32x16&p0,f32x16&p1,const char*Kslot,const bf16x8*qr,const f32x16&negm,int r32,int hi){
  const char*kb=Kslot+hi*1024+r32*16;
  #pragma unroll
  for(int d0=0;d0<4;++d0){
    const bf16x8 b0=*reinterpret_cast<const bf16x8*>(kb+d0*2048);
    const bf16x8 b1=*reinterpret_cast<const bf16x8*>(kb+d0*2048+512);
    if(d0==0){p0=__builtin_amdgcn_mfma_f32_32x32x16_bf16(b0,qr[0],negm,0,0,0);p1=__builtin_amdgcn_mfma_f32_32x32x16_bf16(b1,qr[0],negm,0,0,0);}
    else{p0=__builtin_amdgcn_mfma_f32_32x32x16_bf16(b0,qr[d0],p0,0,0,0);p1=__builtin_amdgcn_mfma_f32_32x32x16_bf16(b1,qr[d0],p1,0,0,0);}}
}
typedef __attribute__((address_space(3))) const char* lds_cptr;
typedef short v4i16_t __attribute__((ext_vector_type(4)));
__device__ __forceinline__ void kload8(bf16x8*kf,lds_cptr kp){
  kf[0]=*(const __attribute__((address_space(3))) bf16x8*)(kp);      kf[1]=*(const __attribute__((address_space(3))) bf16x8*)(kp+512);
  kf[2]=*(const __attribute__((address_space(3))) bf16x8*)(kp+2048); kf[3]=*(const __attribute__((address_space(3))) bf16x8*)(kp+2560);
  kf[4]=*(const __attribute__((address_space(3))) bf16x8*)(kp+4096); kf[5]=*(const __attribute__((address_space(3))) bf16x8*)(kp+4608);
  kf[6]=*(const __attribute__((address_space(3))) bf16x8*)(kp+6144); kf[7]=*(const __attribute__((address_space(3))) bf16x8*)(kp+6656);
}
__device__ __forceinline__ void kload2(bf16x8*kf,lds_cptr kp,int j){ kf[2*j]=*(const __attribute__((address_space(3))) bf16x8*)(kp+j*2048); kf[2*j+1]=*(const __attribute__((address_space(3))) bf16x8*)(kp+j*2048+512); }
__device__ __forceinline__ s16x4 vtr(lds_cptr p){ return __builtin_bit_cast(s16x4,__builtin_amdgcn_ds_read_tr16_b64_v4i16((__attribute__((address_space(3))) v4i16_t*)p)); }
__device__ __forceinline__ float rowmax(const f32x16&p0,const f32x16&p1){
  float a=max3f(p0[0],p0[1],p1[0]),b=max3f(p0[2],p0[3],p1[1]);a=max3f(a,p1[2],p1[3]);
  #pragma unroll
  for(int r=4;r<16;r+=4){a=max3f(a,p0[r],p0[r+1]);b=max3f(b,p0[r+2],p0[r+3]);a=max3f(a,p1[r],p1[r+1]);b=max3f(b,p1[r+2],p1[r+3]);}
  const float m=max2f(a,b);
  auto rr=__builtin_amdgcn_permlane32_swap(__float_as_uint(m),__float_as_uint(m),false,false);
  return max2f(__uint_as_float(rr[0]),__uint_as_float(rr[1]));
}
__device__ __forceinline__ void pv(f32x16*o,int vb,bf16x8 pa0,bf16x8 pa1,bf16x8 pa2,bf16x8 pa3){
  #pragma unroll
  for(int d0=0;d0<2;++d0){s16x4 lo[4],hi[4];
    #pragma unroll
    for(int ks=0;ks<4;++ks){
      asm volatile("ds_read_b64_tr_b16 %0,%1 offset:%c2":"=&v"(lo[ks]):"v"(vb),"i"(d0*4096+ks*1024):"memory");
      asm volatile("ds_read_b64_tr_b16 %0,%1 offset:%c2":"=&v"(hi[ks]):"v"(vb),"i"(d0*4096+ks*1024+512):"memory");}
    asm volatile("s_waitcnt lgkmcnt(0)":::"memory");SBAR();
    #define PK(k) (bf16x8){lo[k][0],lo[k][1],lo[k][2],lo[k][3],hi[k][0],hi[k][1],hi[k][2],hi[k][3]}
    o[d0]=__builtin_amdgcn_mfma_f32_32x32x16_bf16(pa0,PK(0),o[d0],0,0,0);
    o[d0]=__builtin_amdgcn_mfma_f32_32x32x16_bf16(pa1,PK(1),o[d0],0,0,0);
    o[d0]=__builtin_amdgcn_mfma_f32_32x32x16_bf16(pa2,PK(2),o[d0],0,0,0);
    o[d0]=__builtin_amdgcn_mfma_f32_32x32x16_bf16(pa3,PK(3),o[d0],0,0,0);
    #undef PK
  }
}

#ifndef ATTN_STORE16
#define ATTN_STORE16(p,v) (*(u32x4*)(p)=(v))
#endif
template<int THRL> __device__ __forceinline__ void attn_unit(const bf16*Qu,const bf16*__restrict__ Kh,const bf16*__restrict__ Vh,bf16*Ou,const int NT,char*shm,const float*qgain,const float*ropet,const int tq0,int tid_){
  asm volatile("":"+v"(tid_)); const int tid=tid_,lane=tid&63,r32=lane&31,hi=lane>>5; const int wid=__builtin_amdgcn_readfirstlane(tid>>6);
  const bf16*Qw=Qu+(long)(wid*QBLK)*QP;
  const unsigned lds0=(unsigned)(uintptr_t)shm;
  float*wsf=(float*)(shm+LDS_WS)+wid*64;
  const bf16*ksrc=Kh+(long)lane*KVP+wid*8;
  const bf16*vsrc=Vh+(long)(16*(wid&3)+(lane>>2))*KVP+(wid>>2)*32+(lane&3)*8;
  const unsigned kdst=lds0+LDS_K+wid*1024, vdst=lds0+LDS_V+wid*1024;
  #define DMA_K(t,slot) glds16(ksrc+(long)(t)*KVBLK*KVP,(unsigned)__builtin_amdgcn_readfirstlane(kdst+(slot)))
  #define DMA_V(t,slot) glds16(vsrc+(long)(t)*KVBLK*KVP,(unsigned)__builtin_amdgcn_readfirstlane(vdst+(slot)))
  const int vb0=(int)(lds0+LDS_V)+((lane>>4)&1)*32+(lane&3)*8+(4*hi+((lane&15)>>2))*64;
  const char*Kbase=shm+LDS_K; bf16x8 kf[8];
  const lds_cptr shm3=(lds_cptr)shm; const lds_cptr kp0=shm3+LDS_K+hi*1024+r32*16; const lds_cptr vp0=shm3+LDS_V+((lane>>4)&1)*32+(lane&3)*8+(4*hi+((lane&15)>>2))*64;
  DMA_K(0,0);DMA_V(0,0);DMA_K(1,SLOTB);
  bf16x8 qr[4];
  #pragma unroll
  for(int d0=0;d0<4;++d0)qr[d0]=*reinterpret_cast<const bf16x8*>(&Qw[(long)r32*QP+d0*16+hi*8]);
  {
    float qv[4][8]; float ss=0.f;
    #pragma unroll
    for(int d0=0;d0<4;++d0){
      #pragma unroll
      for(int e=0;e<8;++e){ qv[d0][e]=__uint_as_float(((unsigned)(unsigned short)qr[d0][e])<<16); ss+=qv[d0][e]*qv[d0][e]; } }
    { auto rr=__builtin_amdgcn_permlane32_swap(__float_as_uint(ss),__float_as_uint(ss),false,false); ss=__uint_as_float(rr[0])+__uint_as_float(rr[1]); }
    const float rs=__builtin_amdgcn_rsqf(ss*(1.0f/64.0f)+1e-6f);
    #pragma unroll
    for(int d0=0;d0<4;++d0){
      #pragma unroll
      for(int e=0;e<8;++e) qv[d0][e]*=rs*qgain[d0*16+hi*8+e]; }
    if(ropet){ const int t=tq0+wid*QBLK+r32;
      #pragma unroll
      for(int h2=0;h2<2;++h2){ const float*cs=ropet+(((h2==0)?(t>>6):(t&63))*16+hi*8)*2;
        #pragma unroll
        for(int e=0;e<8;++e){ const float c=cs[2*e],sn=cs[2*e+1]; const float x1=qv[2*h2][e],x2=qv[2*h2+1][e]; qv[2*h2][e]=x1*c-x2*sn; qv[2*h2+1][e]=x2*c+x1*sn; } } }
    #pragma unroll
    for(int d0=0;d0<4;++d0){ u32x4 w; w[0]=cvtpk_s(qv[d0][0]*C2,qv[d0][1]*C2); w[1]=cvtpk_s(qv[d0][2]*C2,qv[d0][3]*C2); w[2]=cvtpk_s(qv[d0][4]*C2,qv[d0][5]*C2); w[3]=cvtpk_s(qv[d0][6]*C2,qv[d0][7]*C2); qr[d0]=__builtin_bit_cast(bf16x8,w); }
  }
  float mhat=0.f,l_reg=0.f;f32x16 o[2];o[0]=f32x16{};o[1]=f32x16{};f32x16 negm=f32x16{};asm volatile("":"+v"(negm));
  #define CMASK(P0,P1,t) do{}while(0)
  bool resc=false;
  #define START(P0,P1) do{ const float rm=rowmax(P0,P1); resc=false; \
    { const float dl=rm; mhat=fadd_s(mhat,dl); \
      _Pragma("unroll") for(int r=0;r<16;++r){P0[r]=fsub_s(P0[r],dl);P1[r]=fsub_s(P1[r],dl);} \
      _Pragma("unroll") for(int r=0;r<16;++r)negm[r]=-mhat; asm volatile("":"+v"(negm)); } \
    _Pragma("unroll") for(int r=0;r<16;++r)P0[r]=__builtin_amdgcn_exp2f(P0[r]); }while(0)
  #define RESC() do{ if(resc){ asm volatile("s_waitcnt lgkmcnt(0)":::"memory"); \
      _Pragma("unroll") for(int d_=0;d_<2;++d_) _Pragma("unroll") for(int r=0;r<16;++r)o[d_][r]*=wsf[crow(r,hi)]; } }while(0)
  f32x16 pA0,pA1,pB0,pB1;
  int sl_prev=0,sl_cur=0,sl_next=SLOTB;
  #define ROT() do{sl_prev=sl_cur;sl_cur=sl_next;sl_next=(sl_next==(NSLOT-1)*SLOTB)?0:sl_next+SLOTB;}while(0)
  DMA_K(2,2*SLOTB);
  WAIT_BAR(3);
  qkt(pA0,pA1,Kbase,qr,negm,r32,hi);asm volatile("s_nop 15\n\ts_nop 7":"+v"(pA0),"+v"(pA1));CMASK(pA0,pA1,0);
  START(pA0,pA1);
  _Pragma("unroll") for(int r=0;r<16;++r)pA1[r]=__builtin_amdgcn_exp2f(pA1[r]);
  WAIT_BAR(0);
  DMA_K(3,0);DMA_V(1,SLOTB);
  ROT();
  kload8(kf,kp0+sl_cur);
  WAIT_BAR(2);
  s16x4 vlo[8],vhi[8]; u32x4 pw0,pw1,pw2,pw3;
  #define PKW(P,B) cvtpk_s(P[B],P[B+1])
  #define PAF(k) __builtin_bit_cast(bf16x8,pw##k)
  #define VFR(i) (bf16x8){vlo[i][0],vlo[i][1],vlo[i][2],vlo[i][3],vhi[i][0],vhi[i][1],vhi[i][2],vhi[i][3]}
  #define PIN(x) asm volatile("":"+v"(x))
  #define MX3(a,b,c) __builtin_fmaxf(__builtin_fmaxf((a),(b)),(c))
  #define GAPA(MF,A0,A1,A2,A3,W0,W1,PW) do{ MF; sacc+=A0; sacc+=A1; sacc+=A2; sacc+=A3; PIN(sacc); W0; W1; PIN(PW); SBAR(); }while(0)
  #define EX(v) __builtin_amdgcn_exp2f(v)
  #define GAPB(MF,X,B) do{ MF; X[B]=EX(X[B]); X[B+1]=EX(X[B+1]); X[B+2]=EX(X[B+2]); X[B+3]=EX(X[B+3]); PIN(X); SBAR(); }while(0)
  #define VRD(i) do{ vlo[i]=vtr(vp_+(((i)>>2)*4096+((i)&3)*1024)); vhi[i]=vtr(vp_+(((i)>>2)*4096+((i)&3)*1024+512)); }while(0)
  #define KRD(G,j) do{ if(G){ kload2(kf,kp0+sl_next,j); SBAR(); } }while(0)
  #define STEP(C0,C1,P0,P1,t,GK,GV,GL) do{ SBAR(); \
    const lds_cptr vp_=vp0+sl_prev; \
    VRD(0); SBAR(); float sacc=(P0[0]+P0[1]); \
    GAPA(C0=__builtin_amdgcn_mfma_f32_32x32x16_bf16(kf[0],qr[0],negm,0,0,0), P0[2],P0[3],P0[4],P0[5],     pw0[0]=PKW(P0,0), pw0[1]=PKW(P0,2), pw0); \
    VRD(4); SBAR(); GAPA(C1=__builtin_amdgcn_mfma_f32_32x32x16_bf16(kf[1],qr[0],negm,0,0,0), P0[6],P0[7],P0[8],P0[9],     pw0[2]=PKW(P0,4), pw0[3]=PKW(P0,6), pw0); \
    VRD(1); SBAR(); GAPA(C0=__builtin_amdgcn_mfma_f32_32x32x16_bf16(kf[2],qr[1],C0,0,0,0),   P0[10],P0[11],P0[12],P0[13], pw1[0]=PKW(P0,8), pw1[1]=PKW(P0,10), pw1); \
    VRD(5); SBAR(); GAPA(C1=__builtin_amdgcn_mfma_f32_32x32x16_bf16(kf[3],qr[1],C1,0,0,0),   P0[14],P0[15],P1[0],P1[1],   pw1[2]=PKW(P0,12),pw1[3]=PKW(P0,14), pw1); \
    VRD(2); SBAR(); GAPA(C0=__builtin_amdgcn_mfma_f32_32x32x16_bf16(kf[4],qr[2],C0,0,0,0),   P1[2],P1[3],P1[4],P1[5],     pw2[0]=PKW(P1,0), pw2[1]=PKW(P1,2), pw2); \
    VRD(6); SBAR(); GAPA(C1=__builtin_amdgcn_mfma_f32_32x32x16_bf16(kf[5],qr[2],C1,0,0,0),   P1[6],P1[7],P1[8],P1[9],     pw2[2]=PKW(P1,4), pw2[3]=PKW(P1,6), pw2); \
    VRD(3); SBAR(); GAPA(C0=__builtin_amdgcn_mfma_f32_32x32x16_bf16(kf[6],qr[3],C0,0,0,0),   P1[10],P1[11],P1[12],P1[13], pw3[0]=PKW(P1,8), pw3[1]=PKW(P1,10), pw3); \
    VRD(7); SBAR(); GAPA(C1=__builtin_amdgcn_mfma_f32_32x32x16_bf16(kf[7],qr[3],C1,0,0,0),   P1[14],P1[15],0.f,0.f,       pw3[2]=PKW(P1,12),pw3[3]=PKW(P1,14), pw3); \
    l_reg+=sacc; \
    if(GK){DMA_K((t)+3,sl_cur);} if(GV){DMA_V((t)+1,sl_next);} \
    CMASK(C0,C1,t); \
    { float a=MX3(C0[0],C0[1],C1[0]),b=MX3(C0[2],C0[3],C1[1]); a=MX3(a,C1[2],C1[3]); \
      _Pragma("unroll") for(int r=4;r<16;r+=4){a=MX3(a,C0[r],C0[r+1]);b=MX3(b,C0[r+2],C0[r+3]);a=MX3(a,C1[r],C1[r+1]);b=MX3(b,C1[r+2],C1[r+3]);} \
      float rm=__builtin_fmaxf(a,b); { auto rr=__builtin_amdgcn_permlane32_swap(__float_as_uint(rm),__float_as_uint(rm),false,false); rm=__builtin_fmaxf(__uint_as_float(rr[0]),__uint_as_float(rr[1])); } \
      resc=false; \
      if(__builtin_expect(__any(rm>(float)THRL),0)){ const float dl=__builtin_fmaxf(rm,0.f); mhat+=dl; \
        _Pragma("unroll") for(int r=0;r<16;++r){C0[r]-=dl;C1[r]-=dl;} \
        _Pragma("unroll") for(int r=0;r<16;++r)negm[r]=-mhat; asm volatile("":"+v"(negm)); \
        const float f=__builtin_amdgcn_exp2f(-dl); l_reg*=f; if(hi==0)wsf[r32]=f; resc=true; } } \
    SBAR(); \
    GAPB(o[0]=__builtin_amdgcn_mfma_f32_32x32x16_bf16(PAF(0),VFR(0),o[0],0,0,0), C0,0); \
    GAPB(o[1]=__builtin_amdgcn_mfma_f32_32x32x16_bf16(PAF(0),VFR(4),o[1],0,0,0), C0,4); \
    KRD(GL,0); GAPB(o[0]=__builtin_amdgcn_mfma_f32_32x32x16_bf16(PAF(1),VFR(1),o[0],0,0,0), C0,8); \
    KRD(GL,1); GAPB(o[1]=__builtin_amdgcn_mfma_f32_32x32x16_bf16(PAF(1),VFR(5),o[1],0,0,0), C0,12); \
    KRD(GL,2); GAPB(o[0]=__builtin_amdgcn_mfma_f32_32x32x16_bf16(PAF(2),VFR(2),o[0],0,0,0), C1,0); \
    KRD(GL,3); GAPB(o[1]=__builtin_amdgcn_mfma_f32_32x32x16_bf16(PAF(2),VFR(6),o[1],0,0,0), C1,4); \
    GAPB(o[0]=__builtin_amdgcn_mfma_f32_32x32x16_bf16(PAF(3),VFR(3),o[0],0,0,0), C1,8); \
    GAPB(o[1]=__builtin_amdgcn_mfma_f32_32x32x16_bf16(PAF(3),VFR(7),o[1],0,0,0), C1,12); \
    }while(0)
  int t=1;
  #undef CMASK
  #define CMASK(P0,P1,t) do{}while(0)
  for(;t+5<NT;t+=2){
    STEP(pB0,pB1,pA0,pA1,t,true,true,true);     WAIT_BAR(2); RESC(); ROT();
    STEP(pA0,pA1,pB0,pB1,t+1,true,true,true);   WAIT_BAR(2); RESC(); ROT();
  }
  #undef CMASK
  #define CMASK(P0,P1,t) do{}while(0)
  #define ENDW(tt) do{ if((tt)+3<NT){WAIT_BAR(2);} else if((tt)+2<NT){WAIT_BAR(1);} else {WAIT_BAR(0);} }while(0)
  for(;t+1<NT;t+=2){
    STEP(pB0,pB1,pA0,pA1,t,(t+3<NT),(t+1<NT),(t+1<NT));       ENDW(t);   RESC(); ROT();
    STEP(pA0,pA1,pB0,pB1,t+1,(t+4<NT),(t+2<NT),(t+2<NT));     ENDW(t+1); RESC(); ROT();
  }
  STEP(pB0,pB1,pA0,pA1,NT-1,false,false,false); RESC();
  { float sacc=pB0[0]+pB0[1]; _Pragma("unroll") for(int r=2;r<16;++r)sacc+=pB0[r]; _Pragma("unroll") for(int r=0;r<16;++r)sacc+=pB1[r]; l_reg+=sacc;
    pw0=(u32x4){PKW(pB0,0),PKW(pB0,2),PKW(pB0,4),PKW(pB0,6)};pw1=(u32x4){PKW(pB0,8),PKW(pB0,10),PKW(pB0,12),PKW(pB0,14)};pw2=(u32x4){PKW(pB1,0),PKW(pB1,2),PKW(pB1,4),PKW(pB1,6)};pw3=(u32x4){PKW(pB1,8),PKW(pB1,10),PKW(pB1,12),PKW(pB1,14)};
    SBAR(); pv(o,vb0+sl_cur,PAF(0),PAF(1),PAF(2),PAF(3)); }
  #undef PKW
  #undef PAF
  #undef VFR
  #undef PIN
  #undef MX3
  #undef GAPA
  #undef GAPB
  #undef EX
  #undef VRD
  #undef KRD
  #undef STEP
  #undef ENDW
  {auto rr=__builtin_amdgcn_permlane32_swap(__float_as_uint(l_reg),__float_as_uint(l_reg),false,false);l_reg=__uint_as_float(rr[0])+__uint_as_float(rr[1]);}
  if(hi==0)wsf[32+r32]=l_reg;asm volatile("s_waitcnt lgkmcnt(0)":::"memory");
  float rli[16];
  #pragma unroll
  for(int r=0;r<16;++r)rli[r]=__builtin_amdgcn_rcpf(wsf[32+crow(r,hi)]);
  bf16*Ow=Ou+(long)(wid*QBLK)*DM;
  { bf16*stg=(bf16*)(shm+LDS_OST)+wid*2048;
    #pragma unroll
    for(int r=0;r<16;++r){const int orow=crow(r,hi);
      #pragma unroll
      for(int d0=0;d0<2;++d0)stg[orow*64+d0*32+r32]=__float2bfloat16(o[d0][r]*rli[r]);}
    asm volatile("s_waitcnt lgkmcnt(0)":::"memory");
    #pragma unroll
    for(int i=0;i<4;++i){const int row=i*8+(lane>>3),ch=lane&7; const u32x4 v=*(const u32x4*)(stg+row*64+ch*8); ATTN_STORE16(Ow+(long)row*DM+ch*8,v);} }
  asm volatile("s_waitcnt lgkmcnt(0)\n\ts_barrier":::"memory");
  #undef DMA_K
  #undef DMA_V
  #undef CMASK
  #undef START
  #undef RESC
  #undef ROT
}
constexpr int ATTN_LDS_BYTES=LDS_BYTES;
#undef SBAR
#undef WAIT_BAR
}
constexpr int DM = 1024, NBATCH = 4, SEQ = 4096, CTXL = 256, NLAYER = 2;
constexpr int RLAT = NBATCH * SEQ, RCTX = NBATCH * CTXL, RT = RLAT + RCTX;
constexpr int INW = 1536, FFH = 2816, KVLEN = CTXL + SEQ, NCHK = KVLEN / 64;
constexpr int NCHUNK = RT / 64;
constexpr float RMS_EPS = 1e-6f;
constexpr int NWAVES = 8, NTHR = 512;
constexpr size_t MiB = 1u << 20;
constexpr size_t WS_CTL = 0, CTL_ZERO_BYTES = 1 * MiB;
constexpr size_t WS_WT = 1 * MiB, WT_LAYER = 21 * MiB + MiB / 2, WIN_OFF = 0, WOUT_OFF = 3 * MiB, WFI_OFF = 5 * MiB, WFO_OFF = 16 * MiB;
constexpr int MOD_SLABS = 32, MOD_ROWS = 1024 / MOD_SLABS;
constexpr size_t WS_MODP = 156 * MiB  , WS_MOD = 46 * MiB, WS_ROPE = 46 * MiB + MiB / 2, WS_AGG = 47 * MiB;
constexpr size_t WS_GWF = 48 * MiB + MiB / 2, WS_PWF = 48 * MiB + 3 * MiB / 4, WS_SPB = 49 * MiB;
constexpr size_t WS_XRC = 50 * MiB;
constexpr size_t WS_XN = 54 * MiB;
constexpr size_t WS_YO = 88 * MiB;
constexpr size_t WS_RES = 88 * MiB;
constexpr size_t WS_LRU = 0  , LRU_PLANE = 17 * MiB;
constexpr size_t WS_Y = 156 * MiB;
constexpr size_t WS_P = 190 * MiB;
constexpr size_t WS_KB = 241 * MiB, WS_VB = 245 * MiB + MiB / 4;
constexpr size_t WS_H = 156 * MiB;
constexpr size_t WS_XB = 250 * MiB, XB_BANK = 272 * 1024;
constexpr size_t WS_END = 256 * MiB;
static_assert(WS_VB + (size_t)NBATCH * KVLEN * 128 * 2 <= WS_END && WS_H + (size_t)RT * FFH * 2 <= WS_END && WS_P + (size_t)RT * INW * 2 <= WS_KB, "ws map");
constexpr int LDS_BYTES = 147456;

#define GAS __attribute__((address_space(1)))
#define LAS __attribute__((address_space(3)))
typedef unsigned short bf16;
typedef unsigned v4u __attribute__((ext_vector_type(4)));
typedef unsigned v2u __attribute__((ext_vector_type(2)));
typedef float f32x4 __attribute__((ext_vector_type(4)));
typedef float f32x2v __attribute__((ext_vector_type(2)));
typedef short bf16x8 __attribute__((ext_vector_type(8)));
typedef __bf16 bf16x2_t __attribute__((ext_vector_type(2)));
#define LDS_WAIT() asm volatile("s_waitcnt lgkmcnt(0)" ::: "memory")
__device__ __forceinline__ unsigned pk2(float lo, float hi) { f32x2v v = {lo, hi}; bf16x2_t b = __builtin_convertvector(v, bf16x2_t); return __builtin_bit_cast(unsigned, b); }
__device__ __forceinline__ float bflo(unsigned w) { return __uint_as_float(w << 16); }
__device__ __forceinline__ float bfhi(unsigned w) { return __uint_as_float(w & 0xffff0000u); }
__device__ __forceinline__ float wave_sum(float v, int lane_) {
#pragma unroll
    for (int o = 1; o < 64; o <<= 1) v += shx(v, o, lane_);
    return v;
}
__device__ __forceinline__ float sigmoid_f(float x) { return __builtin_amdgcn_rcpf(1.0f + __expf(-x)); }
__device__ __forceinline__ float gelu_tanh_f(float x) { const float t = fmaf(x * x, -2.0f * 1.4426950408889634f * 0.7978845608028654f * 0.044715f, -2.0f * 1.4426950408889634f * 0.7978845608028654f); return x * __builtin_amdgcn_rcpf(1.0f + __builtin_amdgcn_exp2f(x * t)); }

#define XB_TMO      128
#define XB_XCNT(j)  (256  + 64 * (j))
#define XB_XSUB(j)  (1280 + 64 * (j))
#define XB_XGEN(j)  (2304 + 64 * (j))
#define XB_TOP      3328
#define XB_TOPGEN   3392
#define XCD_BAR_WORDS 3456
#define XB_SPIN_CAP (1u << 18)

__device__ __forceinline__ unsigned xb_ld(unsigned* p)              { return __hip_atomic_load(p, __ATOMIC_RELAXED, __HIP_MEMORY_SCOPE_AGENT); }
__device__ __forceinline__ unsigned xb_add(unsigned* p, unsigned v) { return __hip_atomic_fetch_add(p, v, __ATOMIC_RELAXED, __HIP_MEMORY_SCOPE_AGENT); }
__device__ __forceinline__ unsigned xb_xcc_id() { return (unsigned)__builtin_amdgcn_s_getreg((3 << 11) | 20) & 0xFu; }
#define XB_SPIN(cond, bar) do { unsigned _sp = 0; while (cond) { __builtin_amdgcn_s_sleep(1); \
    if ((++_sp & 255u) == 0u) { if (xb_ld(&(bar)[XB_TMO])) break; if (_sp > XB_SPIN_CAP) { atomicAdd(&(bar)[XB_TMO], 1u); break; } } } } while (0)

struct XcdBarrier {
    unsigned* bar; unsigned x;
    volatile LAS unsigned* st;
};

__device__ __forceinline__ XcdBarrier xcd_barrier_post(unsigned* bar, volatile LAS unsigned* st, bool leader) {
    XcdBarrier b; b.bar = bar; b.x = xb_xcc_id(); b.st = st;
    if (leader) (void)xb_add(&bar[XB_XCNT(b.x)], 1u);
    return b;
}
__device__ __forceinline__ void xcd_barrier_complete(unsigned* bar, unsigned x, unsigned& nloc, unsigned& nx) {
    const unsigned G = gridDim.x * gridDim.y * gridDim.z;
    unsigned sum, cnt, mine, sp = 0u;
    for (;;) {
        sum = 0u; cnt = 0u; mine = 0u;
#pragma unroll
        for (unsigned j = 0; j < 16; ++j) { const unsigned c = xb_ld(&bar[XB_XCNT(j)]); sum += c; cnt += (c > 0u) ? 1u : 0u; mine = (j == x) ? c : mine; }
        if (sum == G) break;
        __builtin_amdgcn_s_sleep(1);
        if ((++sp & 255u) == 0u) { if (xb_ld(&bar[XB_TMO])) break; if (sp > XB_SPIN_CAP) { atomicAdd(&bar[XB_TMO], 1u); break; } }
    }
    nloc = mine > 0u ? mine : 1u; nx = cnt > 0u ? cnt : 1u;
}

__device__ __forceinline__ void xcd_barrier(const XcdBarrier& b, bool leader) {
    asm volatile("s_waitcnt vmcnt(0)" ::: "memory");
    __syncthreads();
    if (leader) {
        unsigned* bar = b.bar;
        __builtin_amdgcn_s_waitcnt(0);
        unsigned nloc = b.st[0], nx = b.st[1];
        if (nloc == 0u) { xcd_barrier_complete(bar, b.x, nloc, nx); b.st[0] = nloc; b.st[1] = nx; }
        const unsigned old = xb_add(&bar[XB_XSUB(b.x)], 1u);
        const unsigned gen = old / nloc;
        if (old + 1u == (gen + 1u) * nloc) {
            __builtin_amdgcn_fence(__ATOMIC_RELEASE, "agent");
            asm volatile("s_waitcnt vmcnt(0)" ::: "memory");
            const unsigned og = xb_add(&bar[XB_TOP], 1u);
            const unsigned tg = og / nx;
            if (og + 1u == (tg + 1u) * nx) xb_add(&bar[XB_TOPGEN], 1u);
            else XB_SPIN(xb_ld(&bar[XB_TOPGEN]) == tg, bar);
            __builtin_amdgcn_fence(__ATOMIC_ACQUIRE, "agent");
            xb_add(&bar[XB_XGEN(b.x)], 1u);
            asm volatile("s_waitcnt vmcnt(0)" ::: "memory");
        } else {
            XB_SPIN(xb_ld(&bar[XB_XGEN(b.x)]) == gen, bar);
            __builtin_amdgcn_fence(__ATOMIC_ACQUIRE, "agent");
            asm volatile("s_waitcnt vmcnt(0)" ::: "memory");
        }
    }
    __syncthreads();
}

constexpr int CW_TMO = 0, CW_SEAM = 16384, SEAM_BANK = 68 * 64;
constexpr int CW_BAR = 4096;
constexpr int MISC_OFF = LDS_BYTES - 64;
struct Params { const float* in[21]; float* out; unsigned char* ws; };
typedef const __attribute__((address_space(4))) unsigned long long* kargp_t;
__device__ __forceinline__ const float* kin(int i) { return (const float*)((kargp_t)__builtin_amdgcn_kernarg_segment_ptr())[i]; }
__device__ __forceinline__ float* kout() { return (float*)((kargp_t)__builtin_amdgcn_kernarg_segment_ptr())[21]; }
__device__ __forceinline__ unsigned char* kws() { return (unsigned char*)((kargp_t)__builtin_amdgcn_kernarg_segment_ptr())[22]; }
enum { I_X = 0, I_C, I_CTX, I_CCTX, I_WMOD, I_BMOD, I_NORMG, I_WIN, I_QNG, I_KNG, I_CONVW, I_CONVB, I_GATEW, I_GATEB, I_LAM, I_POOLW, I_POOLB, I_POOLS, I_WOUT, I_WFI, I_WFO };

__device__ __forceinline__ void transpose_item(const float* W, int K, int N, bf16* WT, int orow0, int k0, int n0, LAS float* scr, int lane) {
    float tv[32];
#pragma unroll
    for (int i = 0; i < 32; ++i) tv[i] = __builtin_nontemporal_load(W + (size_t)(k0 + 2 * i + (lane >> 5)) * N + n0 + (lane & 31));
#pragma unroll
    for (int i = 0; i < 32; ++i) scr[(2 * i + (lane >> 5)) * 33 + (lane & 31)] = tv[i];
    LDS_WAIT(); asm volatile("" ::: "memory");
    const int c = lane & 7;
#pragma unroll
    for (int j = 0; j < 4; ++j) { const int n = (lane >> 3) + 8 * j; const LAS float* s = scr + (8 * c) * 33 + n;
        v4u o; o.x = pk2(s[0 * 33], s[1 * 33]); o.y = pk2(s[2 * 33], s[3 * 33]); o.z = pk2(s[4 * 33], s[5 * 33]); o.w = pk2(s[6 * 33], s[7 * 33]);
        *(GAS v4u*)(WT + (size_t)(orow0 + n) * K + k0 + 8 * c) = o; }
    LDS_WAIT(); asm volatile("" ::: "memory");
}
__device__ __forceinline__ void phase0a(const Params& p, LAS unsigned char* lds, int tid, int lane, int wave, int vcu, int G) {
    unsigned char* ws = kws();
    { const int gt = ((tid >> 6) * (int)gridDim.x + (int)blockIdx.x) * 64 + (tid & 63);
      if (gt < 1024) { const int pos = gt >> 4, i = gt & 15; const float freq = exp2f(-(float)i * (13.287712379549449f / 16.0f)); const float ang = (float)pos * freq;
          const float k = rintf(ang * 0.15915494309189535f); float r = fmaf(-k, 6.2831855f, ang); r = fmaf(k, 1.7484555e-7f, r);
          float* rp = (float*)(ws + WS_ROPE); rp[2 * gt] = cosf(r); rp[2 * gt + 1] = sinf(r); } }
    { const int gt = ((tid >> 6) * (int)gridDim.x + (int)blockIdx.x) * 64 + (tid & 63);
      if (gt < 16384) { const int ln = gt & 63, f = gt >> 6, kk = f & 1, nt = (f >> 1) & 3, g2 = (f >> 3) & 1, n = (f >> 4) & 3, d = (f >> 6) & 1, l = f >> 7, qd = ln >> 4, l16 = ln & 15;
          const float* gw_ = kin(I_GATEW) + ((size_t)(((l * 2 + d) * 2 + g2) * 4 + n)) * 4096 + (kk * 32 + qd * 8) * 64 + nt * 16 + l16;
          v4u o; o.x = pk2(gw_[0], gw_[64]); o.y = pk2(gw_[128], gw_[192]); o.z = pk2(gw_[256], gw_[320]); o.w = pk2(gw_[384], gw_[448]);
          ((v4u*)(ws + WS_GWF))[gt] = o; }
      else if (gt < 16384 + 4096) { const int q = gt - 16384, ln = q & 63, f = q >> 6, kk = f & 1, nt = (f >> 1) & 3, lg = f >> 3, qd = ln >> 4, l16 = ln & 15;
          const float* pw = kin(I_POOLW) + (size_t)lg * 4096 + (kk * 32 + qd * 8) * 64 + nt * 16 + l16;
          v4u o; o.x = pk2(pw[0], pw[64]); o.y = pk2(pw[128], pw[192]); o.z = pk2(pw[256], pw[320]); o.w = pk2(pw[384], pw[448]);
          ((v4u*)(ws + WS_PWF))[q] = o; }
      else if (gt < 16384 + 4096 + 3072) { const int q = gt - 20480, ch = q & 255, k3 = (q >> 8) % 3, ld = q / 768;
          float v;
          if (k3 < 2) v = kin(I_GATEB)[(ld * 2 + k3) * 256 + ch]; else v = -8.0f * 1.4426950408889634f * log1pf(expf(-kin(I_LAM)[ld * 256 + ch]));
          ((float*)(ws + WS_SPB))[q] = v; } }
    LAS float* S = (LAS float*)(lds + 8 * 8448);
    for (int i = tid; i < 5 * 1024; i += NTHR) { const float v = (i < 4096) ? kin(I_C)[i] : kin(I_CCTX)[i - 4096]; S[i] = v / (1.0f + expf(-v)); }
    __syncthreads();
    LAS float* scr = (LAS float*)(lds + wave * 8448);
    constexpr int I_IN = 16 * 48, I_OUT = 16 * 32, I_FI = 16 * 176, I_FO = 44 * 32, PER = I_IN + I_OUT + I_FI + I_FO;
    constexpr int NGEMV = NLAYER * MOD_SLABS * 24;
    for (int it0 = wave * G + vcu; it0 < NGEMV + NLAYER * PER; it0 += NWAVES * G) {
        if (it0 < NGEMV) {
            const int l = it0 / (MOD_SLABS * 24), rem = it0 % (MOD_SLABS * 24), slab = rem / 24, cb = rem % 24, col = cb * 256 + lane * 4;
            f32x4 a0 = {0.f, 0.f, 0.f, 0.f}, a1 = a0, a2 = a0, a3 = a0, a4 = a0;
            const float* wp = kin(I_WMOD) + ((size_t)(l * 1024 + slab * MOD_ROWS)) * 6144 + col;
#pragma unroll 8
            for (int k = 0; k < MOD_ROWS; ++k) { const f32x4 w = __builtin_nontemporal_load((const GAS f32x4*)(wp + (size_t)k * 6144)); const int kk = slab * MOD_ROWS + k;
                a0 += S[kk] * w; a1 += S[1024 + kk] * w; a2 += S[2048 + kk] * w; a3 += S[3072 + kk] * w; a4 += S[4096 + kk] * w; }
            float* o = (float*)(ws + WS_MODP) + ((size_t)((l * MOD_SLABS + slab) * 5)) * 6144 + col;
            *(f32x4*)(o) = a0; *(f32x4*)(o + 6144) = a1; *(f32x4*)(o + 2 * 6144) = a2; *(f32x4*)(o + 3 * 6144) = a3; *(f32x4*)(o + 4 * 6144) = a4;
            continue;
        }
        const int it = it0 - NGEMV;
        const int l = it / PER; int r = it % PER; unsigned char* wl = ws + WS_WT + (size_t)l * WT_LAYER;
        if (r < I_IN) { const int kb = r / 48, nb = r % 48; transpose_item(kin(I_WIN) + (size_t)l * 1024 * 1536, 1024, 1536, (bf16*)(wl + WIN_OFF), 32 * nb, 64 * kb, 32 * nb, scr, lane); continue; } r -= I_IN;
        if (r < I_OUT) { const int kb = r / 32, nb = r % 32; transpose_item(kin(I_WOUT) + (size_t)l * 1024 * 1024, 1024, 1024, (bf16*)(wl + WOUT_OFF), 32 * nb, 64 * kb, 32 * nb, scr, lane); continue; } r -= I_OUT;
        if (r < I_FI) { const int kb = r / 176, nb = r % 176; const int n0 = 32 * nb; const int j = n0 < FFH ? n0 : n0 - FFH; const int orow0 = 256 * (j / 128) + (j % 128) + (n0 < FFH ? 0 : 128);
            transpose_item(kin(I_WFI) + (size_t)l * 1024 * 5632, 1024, 5632, (bf16*)(wl + WFI_OFF), orow0, 64 * kb, n0, scr, lane); continue; } r -= I_FI;
        { const int kb = r / 32, nb = r % 32; transpose_item(kin(I_WFO) + (size_t)l * FFH * 1024, FFH, 1024, (bf16*)(wl + WFO_OFF), 32 * nb, 64 * kb, 32 * nb, scr, lane); }
    }
}
__device__ __forceinline__ void phase0b(const Params& p, int tid) {
    const int gt = ((tid >> 6) * (int)gridDim.x + (int)blockIdx.x) * 64 + (tid & 63);
    if (gt < NLAYER * 5 * 6144) {
        const int l = gt / 30720, rem = gt % 30720, r = rem / 6144, j = rem % 6144, c = j >> 10, col = j & 1023;
        const float* modp = (const float*)(kws() + WS_MODP);
        float raw = kin(I_BMOD)[l * 6144 + j];
#pragma unroll
        for (int s = 0; s < MOD_SLABS; ++s) raw += modp[((size_t)((l * MOD_SLABS + s) * 5 + r)) * 6144 + j];
        const float* ng = kin(I_NORMG) + l * 4096;
        float val = raw;
        if (c == 1) val = ng[col] * (1.0f + raw); else if (c == 2) val = raw * ng[1024 + col]; else if (c == 4) val = ng[2048 + col] * (1.0f + raw); else if (c == 5) val = raw * ng[3072 + col];
        ((float*)(kws() + WS_MOD))[gt] = val;
    }
}
template <bool HAS_YO, bool HAS_NEXT>
__device__ __forceinline__ void norm_phase(const float* yo, const float* src_lat, const float* src_ctx, float* dst_lat, float* dst_ctx,
                                           const float* modG, const float* modA, const float* modS, bf16* XN, int nrows, int gw, int NGW, int lane) {
    asm volatile("" : "+v"(lane));
    for (int m = gw; m < nrows; m += NGW) {
        const int r = m < RLAT ? (m >> 12) : 4;
        const float* src = m < RLAT ? src_lat + (size_t)m * DM : src_ctx + (size_t)(m - RLAT) * DM;
        f32x4 v[4];
#pragma unroll
        for (int j = 0; j < 4; ++j) v[j] = __builtin_nontemporal_load((const GAS f32x4*)(src + 4 * lane + 256 * j));
        if (HAS_YO) {
            f32x4 y[4]; float ss = 0.f;
#pragma unroll
            for (int j = 0; j < 4; ++j) { y[j] = *(const GAS f32x4*)(yo + (size_t)m * DM + 4 * lane + 256 * j); ss += (y[j].x * y[j].x + y[j].y * y[j].y) + (y[j].z * y[j].z + y[j].w * y[j].w); }
            const float rs = rsqrtf(wave_sum(ss, lane) * (1.0f / DM) + RMS_EPS);
            float* dst = m < RLAT ? dst_lat + (size_t)m * DM : dst_ctx + (size_t)(m - RLAT) * DM;
#pragma unroll
            for (int j = 0; j < 4; ++j) { const f32x4 g = *(const GAS f32x4*)(modG + r * 6144 + 4 * lane + 256 * j); v[j] += g * y[j] * rs; *(GAS f32x4*)(dst + 4 * lane + 256 * j) = v[j]; }
        }
        if (HAS_NEXT) {
            float ss = 0.f;
#pragma unroll
            for (int j = 0; j < 4; ++j) ss += (v[j].x * v[j].x + v[j].y * v[j].y) + (v[j].z * v[j].z + v[j].w * v[j].w);
            const float rs = rsqrtf(wave_sum(ss, lane) * (1.0f / DM) + RMS_EPS);
#pragma unroll
            for (int j = 0; j < 4; ++j) { const f32x4 a = *(const GAS f32x4*)(modA + r * 6144 + 4 * lane + 256 * j), s = *(const GAS f32x4*)(modS + r * 6144 + 4 * lane + 256 * j);
                const f32x4 o = v[j] * rs * a + s; v2u w; w.x = pk2(o.x, o.y); w.y = pk2(o.z, o.w); *(GAS v2u*)(XN + (size_t)m * DM + 4 * lane + 256 * j) = w; }
        }
    }
}
__device__ __forceinline__ void xn0_slot_phase(LAS unsigned char* lds, int tid, int wave, int vcu) {
    asm volatile("" : "+v"(tid)); const int lane = tid & 63;
    const bool lat = vcu < 240; const int slot = lat ? vcu / 60 : 4, w = lat ? vcu % 60 : vcu - 240, nw = lat ? 60 : 16, nrows = lat ? SEQ : RCTX;
    LAS float* AS = (LAS float*)lds;
    {   const float* modp = (const float*)(kws() + WS_MODP);
        for (int col = tid; col < 1024; col += NTHR) {
            float r0 = kin(I_BMOD)[col], r1 = kin(I_BMOD)[1024 + col];
#pragma unroll 16
            for (int s = 0; s < MOD_SLABS; ++s) { const float* q = modp + ((size_t)(s * 5 + slot)) * 6144 + col; r0 += q[0]; r1 += q[1024]; }
            AS[col] = kin(I_NORMG)[col] * (1.0f + r1); AS[1024 + col] = r0; } }
    __syncthreads();
    const float* src = lat ? kin(I_X) + (size_t)slot * SEQ * DM : kin(I_CTX);
    bf16* dstn = (bf16*)(kws() + WS_XN) + (size_t)(lat ? slot * SEQ : RLAT) * DM;
    f32x4 a[4], sh[4];
#pragma unroll
    for (int j = 0; j < 4; ++j) { a[j] = *(const LAS f32x4*)(AS + 4 * lane + 256 * j); sh[j] = *(const LAS f32x4*)(AS + 1024 + 4 * lane + 256 * j); }
    for (int i = w + nw * wave; i < nrows; i += nw * NWAVES) {
        f32x4 v[4]; float ss = 0.f;
#pragma unroll
        for (int j = 0; j < 4; ++j) v[j] = __builtin_nontemporal_load((const GAS f32x4*)(src + (size_t)i * DM + 4 * lane + 256 * j));
#pragma unroll
        for (int j = 0; j < 4; ++j) ss += (v[j].x * v[j].x + v[j].y * v[j].y) + (v[j].z * v[j].z + v[j].w * v[j].w);
        const float rs = rsqrtf(wave_sum(ss, lane) * (1.0f / DM) + RMS_EPS);
#pragma unroll
        for (int j = 0; j < 4; ++j) { const f32x4 o = v[j] * rs * a[j] + sh[j]; v2u wv; wv.x = pk2(o.x, o.y); wv.y = pk2(o.z, o.w); *(GAS v2u*)(dstn + (size_t)i * DM + 4 * lane + 256 * j) = wv; }
    }
    __syncthreads();
}
__device__ __forceinline__ void ctx_norm(const float* slabs, int nslab, const float* src, float* dst, const float* vG, const float* vA, const float* vS, bf16* XNc, int gw, int NGW, int lane) {
    asm volatile("" : "+v"(lane));
    for (int m = gw; m < RCTX; m += NGW) {
        f32x4 v[4], g[4], a[4], sh[4];
#pragma unroll
        for (int j = 0; j < 4; ++j) { v[j] = __builtin_nontemporal_load((const GAS f32x4*)(src + (size_t)m * DM + 4 * lane + 256 * j)); g[j] = *(const GAS f32x4*)(vG + 4 * lane + 256 * j);
            a[j] = *(const GAS f32x4*)(vA + 4 * lane + 256 * j); sh[j] = *(const GAS f32x4*)(vS + 4 * lane + 256 * j); }
        f32x4 y[4] = {{0.f, 0.f, 0.f, 0.f}, {0.f, 0.f, 0.f, 0.f}, {0.f, 0.f, 0.f, 0.f}, {0.f, 0.f, 0.f, 0.f}};
        const float* sp = slabs + (size_t)m * DM + 4 * lane;
        for (int s0 = 0; s0 < nslab; s0 += 6) {
            f32x4 t[6][4];
#pragma unroll
            for (int s = 0; s < 6; ++s)
#pragma unroll
                for (int j = 0; j < 4; ++j) t[s][j] = (s0 + s < nslab) ? __builtin_nontemporal_load((const GAS f32x4*)(sp + (size_t)(s0 + s) * RCTX * DM + 256 * j)) : (f32x4){0.f, 0.f, 0.f, 0.f};
#pragma unroll
            for (int s = 0; s < 6; ++s)
#pragma unroll
                for (int j = 0; j < 4; ++j) y[j] += t[s][j]; }
        float ss = 0.f;
#pragma unroll
        for (int j = 0; j < 4; ++j) ss += (y[j].x * y[j].x + y[j].y * y[j].y) + (y[j].z * y[j].z + y[j].w * y[j].w);
        const float rs = rsqrtf(wave_sum(ss, lane) * (1.0f / DM) + RMS_EPS);
        float s2 = 0.f;
#pragma unroll
        for (int j = 0; j < 4; ++j) { v[j] += g[j] * y[j] * rs;
            *(GAS f32x4*)(dst + (size_t)m * DM + 4 * lane + 256 * j) = v[j]; s2 += (v[j].x * v[j].x + v[j].y * v[j].y) + (v[j].z * v[j].z + v[j].w * v[j].w); }
        const float rs2 = rsqrtf(wave_sum(s2, lane) * (1.0f / DM) + RMS_EPS);
#pragma unroll
        for (int j = 0; j < 4; ++j) { const f32x4 o = v[j] * rs2 * a[j] + sh[j]; v2u w; w.x = pk2(o.x, o.y); w.y = pk2(o.z, o.w); *(GAS v2u*)(XNc + (size_t)m * DM + 4 * lane + 256 * j) = w; }
    }
}
struct ChunkInfo { int row0, t0, L, b, isctx, cpos; };
__device__ __forceinline__ ChunkInfo chunk_info(int c) {
    ChunkInfo ci;
    if (c < RLAT / 64) { ci.b = c >> 6; const int j = c & 63; ci.t0 = j * 64; ci.row0 = ci.b * SEQ + ci.t0; ci.L = SEQ; ci.isctx = 0; ci.cpos = 4 + j; }
    else { const int cc = c - RLAT / 64; ci.b = cc >> 2; const int j = cc & 3; ci.t0 = j * 64; ci.row0 = RLAT + ci.b * CTXL + ci.t0; ci.L = CTXL; ci.isctx = 1; ci.cpos = j; }
    return ci;
}
constexpr int LROW = 264;
__device__ __forceinline__ void qk_norm_rope(float (&v)[8], const float* gain8, const float* rope, int s, int t, bool do_rope, int lane_) {
    float ss = 0.f;
#pragma unroll
    for (int e = 0; e < 8; ++e) ss += v[e] * v[e];
    ss += shx(ss, 1, lane_); ss += shx(ss, 2, lane_); ss += shx(ss, 4, lane_);
    const float rs = __builtin_amdgcn_rsqf(ss * (1.0f / 64.0f) + RMS_EPS);
#pragma unroll
    for (int e = 0; e < 8; ++e) v[e] *= rs * gain8[e];
    const int pos = (s < 4) ? (t >> 6) : (t & 63);
    const float* cs = rope + (pos * 16 + (s & 1) * 8) * 2;
    float pv[8];
#pragma unroll
    for (int e = 0; e < 8; ++e) pv[e] = shx(v[e], 2, lane_);
    if (do_rope) {
#pragma unroll
        for (int e4 = 0; e4 < 4; ++e4) { const f32x4 q = *(const GAS f32x4*)(cs + 4 * e4);
            const int e = 2 * e4;
            if (s & 2) { v[e] = v[e] * q.x + pv[e] * q.y; v[e + 1] = v[e + 1] * q.z + pv[e + 1] * q.w; }
            else       { v[e] = v[e] * q.x - pv[e] * q.y; v[e + 1] = v[e + 1] * q.z - pv[e + 1] * q.w; } }
    }
}
__device__ __forceinline__ void unpack8(const v4u w, float (&v)[8]) { v[0] = bflo(w.x); v[1] = bfhi(w.x); v[2] = bflo(w.y); v[3] = bfhi(w.y); v[4] = bflo(w.z); v[5] = bfhi(w.z); v[6] = bflo(w.w); v[7] = bfhi(w.w); }
__device__ __forceinline__ v4u pack8(const float (&v)[8]) { v4u w; w.x = pk2(v[0], v[1]); w.y = pk2(v[2], v[3]); w.z = pk2(v[4], v[5]); w.w = pk2(v[6], v[7]); return w; }

__device__ __forceinline__ void mixprep_chunk(const Params& p, int layer, int c, int smask, LAS unsigned char* lds, int tid, int lane, int wave) {
    asm volatile("" : "+v"(tid)); lane = tid & 63;
    const ChunkInfo ci = chunk_info(c);
    unsigned char* ws = kws();
    const bf16* P = (const bf16*)(ws + WS_P); bf16* Y = (bf16*)(ws + WS_Y);
    const float* rope = (const float*)(ws + WS_ROPE);
    const int quad = lane >> 4, l16 = lane & 15;
    v4u wB[5], wC[5], kraw[2], vraw[2];
    if (smask & 2) {
#pragma unroll
        for (int i = 0; i < 5; ++i) { const int idx = tid + i * NTHR, rr = idx >> 5, c8 = idx & 31; const int t = ci.t0 - 8 + rr;
            wB[i] = (v4u){0u, 0u, 0u, 0u};
            if (t >= 0 && t < ci.L) wB[i] = __builtin_nontemporal_load((const GAS v4u*)(P + ((size_t)ci.row0 - 8 + rr) * INW + 1280 + c8 * 8)); } }
    if (smask & 4) {
#pragma unroll
        for (int i = 0; i < 5; ++i) { const int idx = tid + i * NTHR, rr = idx >> 5, c8 = idx & 31; const int t = ci.t0 - 2 + rr;
            wC[i] = (v4u){0u, 0u, 0u, 0u};
            if (idx < 67 * 32 && t >= 0 && t < ci.L) wC[i] = __builtin_nontemporal_load((const GAS v4u*)(P + ((size_t)ci.row0 - 2 + rr) * INW + 768 + c8 * 8)); } }
    if (smask & 1) {   const int s = lane & 7;
#pragma unroll
        for (int ps = 0; ps < 2; ++ps) { const int idx = ps * NTHR + tid, tok = idx >> 4, s16 = idx & 15; const size_t row = (size_t)ci.row0 + tok;
            kraw[ps] = __builtin_nontemporal_load((const GAS v4u*)(P + row * INW + 512 + s16 * 8)); vraw[ps] = __builtin_nontemporal_load((const GAS v4u*)(P + row * INW + 640 + s16 * 8)); }
        float gk[8];
#pragma unroll
        for (int e = 0; e < 8; ++e) gk[e] = kin(I_KNG)[layer * 64 + s * 8 + e];
#pragma unroll
        for (int ps = 0; ps < 2; ++ps) { const int idx = ps * NTHR + tid, tok = idx >> 4; const int t = ci.t0 + tok;
            float v[8]; unpack8(kraw[ps], v);
            qk_norm_rope(v, gk, rope, s, t, !ci.isctx, lane);
            kraw[ps] = pack8(v); }
        bf16* KB = (bf16*)(ws + WS_KB); bf16* VB = (bf16*)(ws + WS_VB);
#pragma unroll
        for (int ps = 0; ps < 2; ++ps) { const int idx = ps * NTHR + tid, tok = idx >> 4, s16 = idx & 15; const int t = ci.t0 + tok;
            const size_t krow = (size_t)ci.b * KVLEN + (ci.isctx ? t : CTXL + t);
            *(GAS v4u*)(KB + krow * 128 + s16 * 8) = kraw[ps]; *(GAS v4u*)(VB + krow * 128 + s16 * 8) = vraw[ps]; }
    }
    if (smask & 2) {   LAS bf16* PX = (LAS bf16*)lds;
        LAS bf16* DB = (LAS bf16*)(lds + 45056);
#pragma unroll
        for (int i = 0; i < 5; ++i) { const int idx = tid + i * NTHR, rr = idx >> 5, c8 = idx & 31; *(LAS v4u*)(PX + rr * LROW + c8 * 8) = wB[i]; }
        __syncthreads();
        {   const int cp = tid & 127, tg = tid >> 7, g = cp >> 5, half = 1 << g;
            const LAS unsigned* PXw = (const LAS unsigned*)PX;
            float s0 = 0.f, s1 = 0.f;
            for (int rr = tg * 16 - half + 8; rr < tg * 16 + half + 8; ++rr) { const unsigned w = PXw[rr * (LROW / 2) + cp]; s0 += bflo(w); s1 += bfhi(w); }
#pragma unroll 4
            for (int i = 0; i < 16; ++i) { const int tok = tg * 16 + i, t = ci.t0 + tok;
                const int lo = max(t - half, 0), hi = min(t + half, ci.L); const float icnt = __builtin_amdgcn_rcpf((float)(hi - lo));
                const unsigned w = PXw[(tok + 8) * (LROW / 2) + cp];
                const float d0 = s0 * icnt - bflo(w), d1 = s1 * icnt - bfhi(w);
                ((LAS unsigned*)DB)[tok * (LROW / 2) + cp] = pk2(d0, d1);
                const unsigned wa = PXw[(tok + half + 8) * (LROW / 2) + cp], wr_ = PXw[(tok - half + 8) * (LROW / 2) + cp];
                s0 += bflo(wa) - bflo(wr_); s1 += bfhi(wa) - bfhi(wr_); }
        }
        __syncthreads();
        {   const int g = wave & 3, th = wave >> 2;
            const GAS v4u* pwf = (const GAS v4u*)(ws + WS_PWF) + (size_t)((layer * 4 + g) * 8) * 64 + lane;
            bf16x8 wf[4][2];
#pragma unroll
            for (int nt = 0; nt < 4; ++nt)
#pragma unroll
                for (int kk = 0; kk < 2; ++kk) wf[nt][kk] = __builtin_bit_cast(bf16x8, pwf[(nt * 2 + kk) * 64]);
            f32x4 pbv[4], psv[4];
#pragma unroll
            for (int nt = 0; nt < 4; ++nt) { pbv[nt] = *(const GAS f32x4*)(kin(I_POOLB) + layer * 256 + g * 64 + nt * 16 + quad * 4); psv[nt] = *(const GAS f32x4*)(kin(I_POOLS) + layer * 256 + g * 64 + nt * 16 + quad * 4); }
#pragma unroll
            for (int mi = 0; mi < 2; ++mi) { const int mt = th * 2 + mi;
                bf16x8 af[2];
#pragma unroll
                for (int kk = 0; kk < 2; ++kk) af[kk] = *(const LAS bf16x8*)(DB + (mt * 16 + l16) * LROW + g * 64 + kk * 32 + quad * 8);
                const size_t row = (size_t)ci.row0 + mt * 16 + l16;
#pragma unroll
                for (int nt = 0; nt < 4; ++nt) { f32x4 acc = {0.f, 0.f, 0.f, 0.f};
                    acc = __builtin_amdgcn_mfma_f32_16x16x32_bf16(wf[nt][0], af[0], acc, 0, 0, 0);
                    acc = __builtin_amdgcn_mfma_f32_16x16x32_bf16(wf[nt][1], af[1], acc, 0, 0, 0);
                    const int ch = g * 64 + nt * 16 + quad * 4;
                    const f32x4 o = (acc + pbv[nt]) * psv[nt]; v2u w; w.x = pk2(o.x, o.y); w.y = pk2(o.z, o.w);
                    *(GAS v2u*)(Y + row * DM + 768 + ch) = w; } }
        }
        __syncthreads();
    }
    if (smask & 4) {   LAS bf16* LX = (LAS bf16*)lds;
        LAS bf16* UB = (LAS bf16*)(lds + 35840);
        LAS float* SC = (LAS float*)(lds + 69632 + wave * 8704);
#pragma unroll
        for (int i = 0; i < 5; ++i) { const int idx = tid + i * NTHR, rr = idx >> 5, c8 = idx & 31; if (idx < 67 * 32) *(LAS v4u*)(LX + rr * LROW + c8 * 8) = wC[i]; }
        __syncthreads();
        {   const int cp = tid & 127, tg = tid >> 7;
            const float* cw = kin(I_CONVW) + layer * 1024; const float* cb = kin(I_CONVB) + layer * 256;
            float w0[4], w1[4];
#pragma unroll
            for (int k = 0; k < 4; ++k) { w0[k] = cw[k * 256 + 2 * cp]; w1[k] = cw[k * 256 + 2 * cp + 1]; }
            const float b0 = cb[2 * cp], b1 = cb[2 * cp + 1];
            const LAS unsigned* LXw = (const LAS unsigned*)LX;
#pragma unroll 4
            for (int i = 0; i < 16; ++i) { const int tok = tg * 16 + i; float u0 = b0, u1 = b1;
#pragma unroll
                for (int k = 0; k < 4; ++k) { const unsigned w = LXw[(tok + k) * (LROW / 2) + cp]; u0 += bflo(w) * w0[k]; u1 += bfhi(w) * w1[k]; }
                ((LAS unsigned*)UB)[tok * (LROW / 2) + cp] = pk2(u0, u1); }
        }
        __syncthreads();
        {   const int d = wave >> 2, n = wave & 3;
            const GAS v4u* gwf = (const GAS v4u*)(ws + WS_GWF) + (size_t)(((layer * 2 + d) * 4 + n) * 16) * 64 + lane;
            const GAS float* spb = (const GAS float*)(ws + WS_SPB) + (layer * 2 + d) * 768 + n * 64 + quad * 4;
            bf16x8 wf[2][4][2]; f32x4 brv[4], biv[4], spv[4];
#pragma unroll
            for (int gt = 0; gt < 2; ++gt)
#pragma unroll
                for (int nt = 0; nt < 4; ++nt)
#pragma unroll
                    for (int kk = 0; kk < 2; ++kk) wf[gt][nt][kk] = __builtin_bit_cast(bf16x8, gwf[((gt * 4 + nt) * 2 + kk) * 64]);
#pragma unroll
            for (int nt = 0; nt < 4; ++nt) { brv[nt] = *(const GAS f32x4*)(spb + nt * 16); biv[nt] = *(const GAS f32x4*)(spb + 256 + nt * 16); spv[nt] = *(const GAS f32x4*)(spb + 512 + nt * 16); }
            float h = 0.f, ap = 1.f;
            unsigned* HA = (unsigned*)((unsigned char*)kout() + WS_LRU + (size_t)d * LRU_PLANE);
#pragma unroll 1
            for (int q = 0; q < 4; ++q) { const int mt = d ? 3 - q : q; asm volatile("" ::: "memory");
                bf16x8 af[2];
#pragma unroll
                for (int kk = 0; kk < 2; ++kk) af[kk] = *(const LAS bf16x8*)(UB + (mt * 16 + l16) * LROW + n * 64 + kk * 32 + quad * 8);
#pragma unroll
                for (int nt = 0; nt < 4; ++nt) { f32x4 ar = brv[nt], ai = biv[nt];
                    ar = __builtin_amdgcn_mfma_f32_16x16x32_bf16(wf[0][nt][0], af[0], ar, 0, 0, 0); ar = __builtin_amdgcn_mfma_f32_16x16x32_bf16(wf[0][nt][1], af[1], ar, 0, 0, 0);
                    ai = __builtin_amdgcn_mfma_f32_16x16x32_bf16(wf[1][nt][0], af[0], ai, 0, 0, 0); ai = __builtin_amdgcn_mfma_f32_16x16x32_bf16(wf[1][nt][1], af[1], ai, 0, 0, 0);
                    const v2u xw = *(const LAS v2u*)(UB + (mt * 16 + l16) * LROW + n * 64 + nt * 16 + quad * 4);
                    const float xv[4] = {bflo(xw.x), bfhi(xw.x), bflo(xw.y), bfhi(xw.y)};
                    f32x4 av, uv;
#pragma unroll
                    for (int j = 0; j < 4; ++j) { const float r = __builtin_amdgcn_rcpf(1.0f + __builtin_amdgcn_exp2f(-1.4426950408889634f * ar[j])), ig = __builtin_amdgcn_rcpf(1.0f + __builtin_amdgcn_exp2f(-1.4426950408889634f * ai[j]));
                        const float a = __builtin_amdgcn_exp2f(r * spv[nt][j]);
                        av[j] = a; uv[j] = __builtin_amdgcn_sqrtf(fmaf(-a, a, 1.0f)) * (ig * xv[j]); }
                    *(LAS f32x4*)(SC + l16 * 68 + nt * 16 + quad * 4) = av; *(LAS f32x4*)(SC + 1088 + l16 * 68 + nt * 16 + quad * 4) = uv; }
                LDS_WAIT(); asm volatile("" ::: "memory");
#pragma unroll 4
                for (int s = 0; s < 16; ++s) { const int tt = d ? 15 - s : s; const float a = SC[tt * 68 + lane], u = SC[1088 + tt * 68 + lane];
                    h = a * h + u; ap *= a; const size_t o = ((size_t)ci.row0 + mt * 16 + tt) * 256 + n * 64 + lane; HA[o] = pk2(h, ap); }
                LDS_WAIT(); asm volatile("" ::: "memory");
            }
            f32x2v* agg = (f32x2v*)(ws + WS_AGG); agg[((size_t)((d * NBATCH + ci.b) * NCHK + ci.cpos)) * 256 + n * 64 + lane] = (f32x2v){ap, h};
        }
        __syncthreads();
    }
}
__device__ __forceinline__ void fixup_chunk(const Params& p, int c, LAS unsigned char* lds, int tid) {
    asm volatile("" : "+v"(tid));
    const ChunkInfo ci = chunk_info(c);
    unsigned char* ws = kws();
    LAS float* CR = (LAS float*)lds;
    {   const int d = tid >> 8, ch = tid & 255;
        const f32x2v* agg = (const f32x2v*)(ws + WS_AGG) + ((size_t)((d * NBATCH + ci.b) * NCHK)) * 256 + ch;
        float s = 0.f;
        const int n = (d == 0) ? ci.cpos : (ci.isctx ? 3 - ci.cpos : 71 - ci.cpos);
        for (int k0 = 0; k0 < n; k0 += 24) {
            f32x2v ah[24];
#pragma unroll
            for (int j = 0; j < 24; ++j) { const int k = k0 + j; const int i = (d == 0) ? k : (k < 4 ? 3 - k : 71 - k);
                ah[j] = (k < n) ? agg[(size_t)i * 256] : (f32x2v){1.0f, 0.0f}; }
#pragma unroll
            for (int j = 0; j < 24; ++j) s = ah[j].x * s + ah[j].y;
        }
        CR[tid] = s;
    }
    __syncthreads();
    {   const unsigned* HAF = (const unsigned*)((unsigned char*)kout() + WS_LRU); const unsigned* HAB = (const unsigned*)((unsigned char*)kout() + WS_LRU + LRU_PLANE);
        bf16* Y = (bf16*)(ws + WS_Y);
        const int c4 = tid & 63; const f32x4 cf = *(const LAS f32x4*)(CR + 4 * c4), cb = *(const LAS f32x4*)(CR + 256 + 4 * c4);
#pragma unroll 2
        for (int it = 0; it < 8; ++it) { const int tok = it * 8 + (tid >> 6); const size_t row = (size_t)ci.row0 + tok; const size_t o = row * 256 + 4 * c4;
            const v4u fw = __builtin_nontemporal_load((const GAS v4u*)(HAF + o)), bw = __builtin_nontemporal_load((const GAS v4u*)(HAB + o));
            const f32x4 hf = {bflo(fw.x), bflo(fw.y), bflo(fw.z), bflo(fw.w)}, af = {bfhi(fw.x), bfhi(fw.y), bfhi(fw.z), bfhi(fw.w)};
            const f32x4 hb = {bflo(bw.x), bflo(bw.y), bflo(bw.z), bflo(bw.w)}, ab = {bfhi(bw.x), bfhi(bw.y), bfhi(bw.z), bfhi(bw.w)};
            const v2u gw_ = __builtin_nontemporal_load((const GAS v2u*)((const bf16*)(ws + WS_P) + row * INW + 1024 + 4 * c4));
            const f32x4 hs = (hf + af * cf) + (hb + ab * cb);
            v2u w; w.x = pk2(gelu_tanh_f(bflo(gw_.x)) * hs.x, gelu_tanh_f(bfhi(gw_.x)) * hs.y); w.y = pk2(gelu_tanh_f(bflo(gw_.y)) * hs.z, gelu_tanh_f(bfhi(gw_.y)) * hs.w);
            *(GAS v2u*)(Y + row * DM + 512 + 4 * c4) = w; }
    }
    __syncthreads();
}
#ifndef ATTN_OUT
#define ATTN_OUT(Qu, k) (Qu)
#endif
__global__ void __launch_bounds__(NTHR, 2) hybrid_fwd(Params p) {
    extern __shared__ __attribute__((aligned(16))) unsigned char lds_raw[];
    cg::grid_group grid = cg::this_grid();
    LAS unsigned char* lds = (LAS unsigned char*)lds_raw;
    const int wave = __builtin_amdgcn_readfirstlane((int)threadIdx.x >> 6);
#define lane hw_lane()
#define tid (wave * 64 + lane)
    const int G = gridDim.x; const int bx = blockIdx.x; const int vcu = (G % 8 == 0) ? (bx % 8) * (G / 8) + bx / 8 : bx;
    const int gw = vcu * NWAVES + wave, NGW = G * NWAVES;
    unsigned char* ws = kws();
    bf16* XN = (bf16*)(ws + WS_XN); float* YO = kout();     float* XRC = (float*)(ws + WS_XRC);
    const float* MOD = (const float*)(ws + WS_MOD);
    unsigned* ctl = (unsigned*)(ws + WS_CTL);

    if (tid < 16) ((LAS unsigned*)(lds + MISC_OFF))[tid] = 0u;
    __syncthreads();
    (void)xcd_barrier_post((unsigned*)(kws() + WS_CTL) + CW_BAR, (volatile LAS unsigned*)(lds + MISC_OFF), wave == 0 && lane == 0);
#define GRID_BAR() do { XcdBarrier b_; b_.bar = (unsigned*)(kws() + WS_CTL) + CW_BAR; b_.x = xb_xcc_id(); b_.st = (volatile LAS unsigned*)(lds + MISC_OFF); xcd_barrier(b_, wave == 0 && lane == 0); } while (0)
    if (__builtin_expect(gridDim.x > 1000000u, 0)) grid.sync();
    phase0a(p, lds, tid, lane, wave, vcu, G);
    GRID_BAR();
    xn0_slot_phase(lds, tid, wave, vcu);
    phase0b(p, tid);
    GRID_BAR();
#pragma unroll 1
    for (int layer = 0; layer < NLAYER; ++layer) {
        const bool last = (layer == NLAYER - 1);
        unsigned char* wl = ws + WS_WT + (size_t)layer * WT_LAYER;
        const float* MODL = MOD + layer * 30720;
        const int Mrows = last ? RLAT : RT;
        {   pg8::Gemm g{XN, (const bf16*)(wl + WIN_OFF), RT, INW, DM, DM}; pg8::StaticOrder S; S.init(RT, INW, G, bx);
            pg8::EpiBf16 E{(bf16*)(ws + WS_P), INW};
            pg8::gemm_phase<pg8::EpiBf16, pg8::StaticOrder, true, true>(lds, g, S, E, tid); }
        GRID_BAR();
        for (int it = vcu; it < RLAT / 64 + 3 * (RCTX / 64); it += G) {
            const int j = it - RLAT / 64; const int c = j < 0 ? it : RLAT / 64 + j / 3; const int sm = j < 0 ? 7 : (1 << (j % 3));
            mixprep_chunk(p, layer, c, sm, lds, tid, lane, wave); }
        GRID_BAR();
        {   const bf16* Y = (const bf16*)(ws + WS_Y); const bf16* KB = (const bf16*)(ws + WS_KB); const bf16* VB = (const bf16*)(ws + WS_VB);
#pragma unroll 1
            for (int k = 0; k < 3; ++k) {
                size_t qrow; int b, hq, nt;
                if (k < 2) { const int u = (vcu >> 5) * 64 + (vcu & 31) + 32 * k; const int bk = u >> 6, idx = u & 63; b = bk >> 1; hq = (bk & 1) * 4 + (idx >> 4); qrow = (size_t)b * SEQ + (idx & 15) * 256; nt = NCHK; }
                else { if (last || vcu < 32 || vcu >= 64) break; const int u = vcu - 32; b = u >> 3; hq = u & 7; qrow = (size_t)RLAT + b * CTXL; nt = 4; }
                const bf16* Qu = (const bf16*)(ws + WS_P) + qrow * INW + hq * 64; const bf16* Ou = Y + qrow * DM + hq * 64; const size_t kvo = (size_t)b * KVLEN * 128 + (hq >> 2) * 64;
                attn_body::attn_unit<8>((const attn_body::bf16*)Qu, (const attn_body::bf16*)(KB + kvo), (const attn_body::bf16*)(VB + kvo), (attn_body::bf16*)ATTN_OUT(Ou, k), nt, (char*)lds_raw,
                                        kin(I_QNG) + layer * 64, k < 2 ? (const float*)(ws + WS_ROPE) : nullptr, (int)(qrow & (SEQ - 1)), tid);
            }
            const int nfix = last ? RLAT / 64 : NCHUNK;
            for (int c = vcu; c < nfix; c += G) fixup_chunk(p, c, lds, tid);
        }
        GRID_BAR();
        {   pg8::Gemm g{(const bf16*)(ws + WS_Y), (const bf16*)(wl + WOUT_OFF), RLAT, DM, DM, DM}; pg8::StaticOrder S; S.init(RLAT, DM, G, bx);
            pg8::PanelSumSq st1{(float*)(ws + WS_XB + (size_t)(layer * 4 + 0) * XB_BANK), ctl + CW_SEAM + (layer * 4 + 0) * SEAM_BANK, ctl + CW_TMO};
            pg8::PanelSumSq st2{(float*)(ws + WS_XB + (size_t)(layer * 4 + 1) * XB_BANK), ctl + CW_SEAM + (layer * 4 + 1) * SEAM_BANK, ctl + CW_TMO};
            if (layer == 0) { pg8::EpiRmsRes<true, false, true> E{kin(I_X), ws + WS_RES, XN, MODL + 2 * 1024, MODL + 4 * 1024, MODL + 3 * 1024, st1, st2};
                pg8::gemm_phase<pg8::EpiRmsRes<true, false, true>, pg8::StaticOrder, false, true>(lds, g, S, E, tid); }
            else { pg8::EpiRmsRes<true, true, true> E{ws + WS_RES, ws + WS_RES, XN, MODL + 2 * 1024, MODL + 4 * 1024, MODL + 3 * 1024, st1, st2};
                pg8::gemm_phase<pg8::EpiRmsRes<true, true, true>, pg8::StaticOrder, false, true>(lds, g, S, E, tid); } }
        if (!last) {
            __syncthreads();
            {   pg8::Gemm g{(const bf16*)(ws + WS_Y) + (size_t)RLAT * DM, (const bf16*)(wl + WOUT_OFF), RCTX, DM, 256, DM}; pg8::SplitKOrder S; S.init(RCTX, DM, 4, 256, G, bx);
                pg8::EpiF32Slab E{YO, DM, (size_t)RCTX * DM};
                pg8::gemm_phase<pg8::EpiF32Slab, pg8::SplitKOrder, true, true>(lds, g, S, E, tid); }
            GRID_BAR();
            ctx_norm(YO, 4, kin(I_CTX), XRC, MODL + 4 * 6144 + 2 * 1024, MODL + 4 * 6144 + 4 * 1024, MODL + 4 * 6144 + 3 * 1024, XN + (size_t)RLAT * DM, gw, NGW, lane);
        }
        GRID_BAR();
        {   pg8::Gemm g{XN, (const bf16*)(wl + WFI_OFF), Mrows, 2 * FFH, DM, DM}; pg8::StaticOrder S; S.init(Mrows, 2 * FFH, G, bx);
            pg8::EpiSwiglu E{(bf16*)(ws + WS_H), FFH};
            pg8::gemm_phase<pg8::EpiSwiglu, pg8::StaticOrder, true, true>(lds, g, S, E, tid); }
        GRID_BAR();
        if (!last) {
            {   pg8::Gemm g{(const bf16*)(ws + WS_H), (const bf16*)(wl + WFO_OFF), RLAT, DM, FFH, FFH}; pg8::StaticOrder S; S.init(RLAT, DM, G, bx);
                pg8::PanelSumSq st1{(float*)(ws + WS_XB + (size_t)(layer * 4 + 2) * XB_BANK), ctl + CW_SEAM + (layer * 4 + 2) * SEAM_BANK, ctl + CW_TMO};
                pg8::PanelSumSq st2{(float*)(ws + WS_XB + (size_t)(layer * 4 + 3) * XB_BANK), ctl + CW_SEAM + (layer * 4 + 3) * SEAM_BANK, ctl + CW_TMO};
                pg8::EpiRmsRes<true, true, true> E{ws + WS_RES, ws + WS_RES, XN, MODL + 5 * 1024, MOD + 30720 + 1 * 1024, MOD + 30720 + 0 * 1024, st1, st2};
                pg8::gemm_phase<pg8::EpiRmsRes<true, true, true>, pg8::StaticOrder, false, true>(lds, g, S, E, tid); }
            __syncthreads();
            {   pg8::Gemm g{(const bf16*)(ws + WS_H) + (size_t)RLAT * FFH, (const bf16*)(wl + WFO_OFF), RCTX, DM, 256, FFH}; pg8::SplitKOrder S; S.init(RCTX, DM, 11, 256, G, bx);
                pg8::EpiF32Slab E{YO, DM, (size_t)RCTX * DM};
                pg8::gemm_phase<pg8::EpiF32Slab, pg8::SplitKOrder, true, true>(lds, g, S, E, tid); }
            GRID_BAR();
            ctx_norm(YO, 11, XRC, XRC, MODL + 4 * 6144 + 5 * 1024, MOD + 30720 + 4 * 6144 + 1 * 1024, MOD + 30720 + 4 * 6144 + 0 * 1024, XN + (size_t)RLAT * DM, gw, NGW, lane);
            GRID_BAR();
        } else {
            pg8::Gemm g{(const bf16*)(ws + WS_H), (const bf16*)(wl + WFO_OFF), RLAT, DM, FFH, FFH}; pg8::StaticOrder S; S.init(RLAT, DM, G, bx);
            pg8::PanelSumSq st1{(float*)(ws + WS_XB + (size_t)(layer * 4 + 2) * XB_BANK), ctl + CW_SEAM + (layer * 4 + 2) * SEAM_BANK, ctl + CW_TMO};
            pg8::EpiRmsRes<false, true, false> E{ws + WS_RES, kout(), XN, MODL + 5 * 1024, nullptr, nullptr, st1, st1};
            pg8::gemm_phase<pg8::EpiRmsRes<false, true, false>, pg8::StaticOrder, false, true>(lds, g, S, E, tid);
        }
    }
}

#undef tid
#undef lane
extern "C" void kernel_launch(void* const* d_in, const int* in_sizes, int n_in, void* d_out, int out_size, void* d_ws, size_t ws_size, hipStream_t stream) {
    static int grid = 0;
    if (grid == 0) {
        if (n_in != 21 || out_size != RLAT * DM || ws_size < WS_END) { fprintf(stderr, "kernel_launch: unexpected shapes (n_in %d out %d ws %zu)\n", n_in, out_size, ws_size); grid = -1; return; }
        int dev = 0, cus = 0, per_cu = 0;
        hipGetDevice(&dev); hipDeviceGetAttribute(&cus, hipDeviceAttributeMultiprocessorCount, dev);
        hipFuncSetAttribute((const void*)hybrid_fwd, hipFuncAttributeMaxDynamicSharedMemorySize, LDS_BYTES);
        hipOccupancyMaxActiveBlocksPerMultiprocessor(&per_cu, (const void*)hybrid_fwd, NTHR, LDS_BYTES);
        (void)hipGetLastError();
        if (per_cu < 1) { fprintf(stderr, "kernel_launch: occupancy query says %d blocks per CU\n", per_cu); per_cu = 1; }
        grid = cus;
        if (grid != 256) { fprintf(stderr, "kernel_launch: built for a 256-CU device (got %d)\n", cus); grid = -1; return; }
    }
    if (grid < 0) return;
    if (hipMemsetAsync((char*)d_ws + WS_CTL, 0, 262144, stream) != hipSuccess) { fprintf(stderr, "kernel_launch: memset failed\n"); return; }
    Params p{};
    for (int i = 0; i < 21; ++i) p.in[i] = (const float*)d_in[i];
    p.out = (float*)d_out; p.ws = (unsigned char*)d_ws;
    void* args[] = {&p};
    hipError_t e = hipLaunchCooperativeKernel((const void*)hybrid_fwd, dim3(grid), dim3(NTHR), args, LDS_BYTES, stream);
    if (e != hipSuccess) fprintf(stderr, "cooperative launch failed: %s (grid %d)\n", hipGetErrorString(e), grid);
}
```
